# Optimizing an MI355X kernel written in HIP

```python
import jax
import jax.numpy as jnp
from jax import lax
import numpy as np

D_MODEL = 1024
BATCH = 2
SEQ = 16384
DEPTH = 4

GRID_W = 64
CTX_LEN = 256
HEAD_DIM = 64
ROPE_THETA = 10000.0
EPS = 1e-6
NEG = -1e30
N_MOD = 6

A_HEADS = 8
A_KV_HEADS = 2
A_BLOCK = 128
A_WINDOW = 128
B_HEADS = 8
NA_ROWS = 8
NA_COLS = 16
C_HEADS = 4
C_DK = 128
C_DV = 256
C_GATE_RANK = 16
C_GATE_TAU = 16.0
C_CHUNK = 64
PEER_HEADS = 8
PEER_NKEYS = 128
PEER_EXPERTS = PEER_NKEYS * PEER_NKEYS
PEER_QDIM = 256
PEER_HALF = PEER_QDIM // 2
PEER_TOPK = 16
PEER_BLOCK = 128

A_Q = A_HEADS * HEAD_DIM
A_KV = A_KV_HEADS * HEAD_DIM
B_W = B_HEADS * HEAD_DIM
C_K = C_HEADS * C_DK
C_V = C_HEADS * C_DV
KV_SPLITS = (A_KV, A_KV, B_W, B_W, C_K, C_V, 2 * C_GATE_RANK)
Q_SPLITS = (A_Q, B_W, C_K, C_V, 3 * D_MODEL)
N_KV_COLS = sum(KV_SPLITS)
IN_WIDTH = N_KV_COLS + sum(Q_SPLITS)

kernel_name = 'hybrid_dit_parallel_mixers_peer'


def _rmsnorm(x, g):
    xf = x.astype(jnp.float32)
    y = xf * lax.rsqrt(jnp.mean(xf * xf, axis=-1, keepdims=True) + EPS)
    return (y * g.astype(jnp.float32)).astype(x.dtype)


def _modulate(x, g, shift, scale):
    return _rmsnorm(x, g) * (1.0 + scale) + shift


def _split(t, sizes):
    return jnp.split(t, np.cumsum(sizes)[:-1].tolist(), axis=-1)


def _heads(t, n):
    return t.reshape(t.shape[:-1] + (n, t.shape[-1] // n))


def _axial_rope(S):
    t = jnp.arange(S)
    row = (t // GRID_W).astype(jnp.float32)[:, None]
    col = (t % GRID_W).astype(jnp.float32)[:, None]
    nf = HEAD_DIM // 4
    inv = ROPE_THETA ** (-jnp.arange(nf, dtype=jnp.float32) / nf)
    ang = jnp.concatenate([row * inv, row * inv, col * inv, col * inv], axis=-1)
    return jnp.cos(ang), jnp.sin(ang)


def _rope(x, cos, sin):
    x1, x2, x3, x4 = jnp.split(x, 4, axis=-1)
    rot = jnp.concatenate([-x2, x1, -x4, x3], axis=-1)
    return (x * cos[:, None] + rot * sin[:, None]).astype(x.dtype)


def _dense_attention(q, k, v, sink):
    B, L, H, dh = q.shape
    G = k.shape[2]
    R = H // G
    s = jnp.einsum('bqgrd,bkgd->bgrqk', q.reshape(B, L, G, R, dh), k).astype(jnp.float32) * dh ** -0.5
    if sink is not None:
        s_sink = jnp.broadcast_to(sink.reshape(G, R, 1, 1).astype(jnp.float32), s.shape[:-1] + (1,))
        s = jnp.concatenate([s, s_sink], axis=-1)
    p = jax.nn.softmax(s, axis=-1)[..., :L].astype(v.dtype)
    return jnp.einsum('bgrqk,bkgd->bqgrd', p, v).reshape(B, L, H * dh)


def _window_attention(q, k, v, kc, vc, sink):
    B, S, H, dh = q.shape
    G = k.shape[2]
    R = H // G
    L = kc.shape[1]
    nb = S // A_BLOCK
    qb = q.reshape(B, nb, A_BLOCK, G, R, dh)
    pad = ((0, 0), (A_BLOCK, A_BLOCK), (0, 0), (0, 0))

    def band(t):
        tb = jnp.pad(t, pad).reshape(B, nb + 2, A_BLOCK, G, dh)
        return jnp.concatenate([tb[:, :-2], tb[:, 1:-1], tb[:, 2:]], axis=2)

    kw, vw = band(k), band(v)
    qi = jnp.arange(nb)[:, None, None] * A_BLOCK + jnp.arange(A_BLOCK)[None, :, None]
    kj = (jnp.arange(nb)[:, None, None] - 1) * A_BLOCK + jnp.arange(3 * A_BLOCK)[None, None, :]
    valid = (jnp.abs(kj - qi) <= A_WINDOW) & (kj >= 0) & (kj < S)
    scale = dh ** -0.5
    s_loc = jnp.einsum('bnqgrd,bnkgd->bngrqk', qb, kw).astype(jnp.float32) * scale
    s_loc = jnp.where(valid[None, :, None, None], s_loc, NEG)
    s_ctx = jnp.einsum('bnqgrd,bcgd->bngrqc', qb, kc).astype(jnp.float32) * scale
    s_sink = jnp.broadcast_to(sink.reshape(G, R, 1, 1).astype(jnp.float32), s_loc.shape[:-1] + (1,))
    p = jax.nn.softmax(jnp.concatenate([s_loc, s_ctx, s_sink], axis=-1), axis=-1).astype(v.dtype)
    nk = 3 * A_BLOCK
    o = (jnp.einsum('bngrqk,bnkgd->bnqgrd', p[..., :nk], vw)
         + jnp.einsum('bngrqc,bcgd->bnqgrd', p[..., nk:nk + L], vc))
    return o.reshape(B, S, H * dh)


def _neighbourhood_attention(q, k, v, kc, vc, rpb):
    B, S, H, dh = q.shape
    rows = S // GRID_W
    kh = min(NA_ROWS, rows)
    r = jnp.arange(rows)
    row_idx = jnp.clip(r - kh // 2, 0, rows - kh)[:, None] + jnp.arange(kh)[None, :]
    c = jnp.arange(GRID_W)
    col_start = jnp.clip(c - NA_COLS // 2, 0, GRID_W - NA_COLS)
    col_valid = (c[None, :] >= col_start[:, None]) & (c[None, :] < col_start[:, None] + NA_COLS)
    qg = q.reshape(B, rows, GRID_W, H, dh)
    kg = k.reshape(B, rows, GRID_W, H, dh)[:, row_idx]
    vg = v.reshape(B, rows, GRID_W, H, dh)[:, row_idx]
    scale = dh ** -0.5
    s = jnp.einsum('brqhd,brjkhd->bhrqjk', qg, kg).astype(jnp.float32) * scale
    dr = row_idx - r[:, None] + (NA_ROWS - 1)
    dc = jnp.clip(c[None, :] - c[:, None], -(NA_COLS - 1), NA_COLS - 1) + (NA_COLS - 1)
    bias = rpb[:, dr[:, None, :, None], dc[None, :, None, :]]
    s = jnp.where(col_valid[:, None, :], s + bias[None].astype(jnp.float32), NEG)
    s = s.reshape(B, H, rows, GRID_W, kh * GRID_W)
    s_ctx = jnp.einsum('brqhd,bchd->bhrqc', qg, kc).astype(jnp.float32) * scale
    p = jax.nn.softmax(jnp.concatenate([s, s_ctx], axis=-1), axis=-1).astype(v.dtype)
    nk = kh * GRID_W
    p_loc = p[..., :nk].reshape(B, H, rows, GRID_W, kh, GRID_W)
    o = (jnp.einsum('bhrqjk,brjkhd->brqhd', p_loc, vg)
         + jnp.einsum('bhrqc,bchd->brqhd', p[..., nk:], vc))
    return o.reshape(B, S, H * dh)


def _gla_decay(a, w2, b):
    z = (a @ w2 + b).astype(jnp.float32)
    return _heads(jax.nn.log_sigmoid(z) / C_GATE_TAU, C_HEADS)


def _gla_scan(q, k, v, la, s0):
    q, k, v = q.astype(jnp.float32), k.astype(jnp.float32), v.astype(jnp.float32)
    B, T, H, dk = q.shape
    dv = v.shape[-1]
    n = T // C_CHUNK

    def chunks(t):
        return t.reshape(B, n, C_CHUNK, H, t.shape[-1]).transpose(1, 0, 3, 2, 4)

    causal = jnp.tril(jnp.ones((C_CHUNK, C_CHUNK), bool))[:, :, None]

    def step(s, inp):
        qc, kc, vc, lac = inp
        b = jnp.cumsum(lac, axis=2)
        diff = jnp.where(causal, b[:, :, :, None, :] - b[:, :, None, :, :], 0.0)
        decay = jnp.where(causal, jnp.exp(diff), 0.0)
        att = jnp.einsum('bhid,bhjd,bhijd->bhij', qc, kc, decay)
        o = jnp.einsum('bhij,bhjv->bhiv', att, vc) + jnp.einsum('bhid,bhdv->bhiv', qc * jnp.exp(b), s)
        b_last = b[:, :, -1:]
        s_new = (jnp.exp(b_last[:, :, 0])[..., None] * s
                 + jnp.einsum('bhjd,bhjv->bhdv', kc * jnp.exp(b_last - b), vc))
        return s_new, o

    s_fin, o = lax.scan(step, s0, (chunks(q), chunks(k), chunks(v), chunks(la)))
    return o.transpose(1, 0, 3, 2, 4).reshape(B, T, H, dv), s_fin


def _gla_final_state(k, v, la):
    b = jnp.cumsum(la, axis=1)
    return jnp.einsum('bthd,bthv->bhdv', k.astype(jnp.float32) * jnp.exp(b[:, -1:] - b), v.astype(jnp.float32))


def _gla_out(o, r, g):
    y = _rmsnorm(o, g).astype(r.dtype) * jax.nn.silu(_heads(r, C_HEADS))
    return y.reshape(y.shape[:-2] + (C_V,))


def _flip(t):
    return jnp.flip(t, axis=1)


def _merge(oA, oB, oC, gates, p):
    gA, gB, gC = jnp.split(gates, 3, axis=-1)
    y = (jax.nn.sigmoid(gA) * (oA @ p['w_oa'])
         + jax.nn.sigmoid(gB) * (oB @ p['w_ob'])
         + jax.nn.sigmoid(gC) * (oC @ p['w_oc']))
    return y @ p['w_out']


def _token_mixers(h, hc, p, cos, sin, last):
    B = h.shape[0]
    w_in = p['w_in']
    proj = h @ w_in
    kA, vA, kB, vB, kC, vC, aC = _split(proj[..., :N_KV_COLS], KV_SPLITS)
    qA, qB, qC, rC, gates = _split(proj[..., N_KV_COLS:], Q_SPLITS)
    cproj = hc @ (w_in[:, :N_KV_COLS] if last else w_in)
    ckA, cvA, ckB, cvB, ckC, cvC, caC = _split(cproj[..., :N_KV_COLS], KV_SPLITS)
    if not last:
        cqA, cqB, cqC, crC, cgates = _split(cproj[..., N_KV_COLS:], Q_SPLITS)

    qa = _rope(_rmsnorm(_heads(qA, A_HEADS), p['qn_a']), cos, sin)
    ka = _rope(_rmsnorm(_heads(kA, A_KV_HEADS), p['kn_a']), cos, sin)
    cka = _rmsnorm(_heads(ckA, A_KV_HEADS), p['kn_a'])
    cva = _heads(cvA, A_KV_HEADS)
    oA = _window_attention(qa, ka, _heads(vA, A_KV_HEADS), cka, cva, p['sink_a'])

    qb = _rmsnorm(_heads(qB, B_HEADS), p['qn_b'])
    kb = _rmsnorm(_heads(kB, B_HEADS), p['kn_b'])
    ckb = _rmsnorm(_heads(ckB, B_HEADS), p['kn_b'])
    cvb = _heads(cvB, B_HEADS)
    oB = _neighbourhood_attention(qb, kb, _heads(vB, B_HEADS), ckb, cvb, p['rpb_b'])

    ckc, cvc = _heads(ckC, C_HEADS), _heads(cvC, C_HEADS)
    caf, cab = jnp.split(caC, 2, axis=-1)
    cla_f = _gla_decay(caf, p['wa2_f'], p['ba_f'])
    cla_b = _gla_decay(cab, p['wa2_b'], p['ba_b'])
    if last:
        s_f = _gla_final_state(ckc, cvc, cla_f)
        s_b = _gla_final_state(_flip(ckc), _flip(cvc), _flip(cla_b))
    else:
        cqc = _heads(cqC, C_HEADS) * C_DK ** -0.5
        zeros = jnp.zeros((B, C_HEADS, C_DK, C_DV), jnp.float32)
        co_f, s_f = _gla_scan(cqc, ckc, cvc, cla_f, zeros)
        co_b, s_b = _gla_scan(_flip(cqc), _flip(ckc), _flip(cvc), _flip(cla_b), zeros)
        coC = _gla_out(co_f + _flip(co_b), crC, p['gn_c'])
    qc_ = _heads(qC, C_HEADS) * C_DK ** -0.5
    kc_, vc_ = _heads(kC, C_HEADS), _heads(vC, C_HEADS)
    af, ab = jnp.split(aC, 2, axis=-1)
    la_f = _gla_decay(af, p['wa2_f'], p['ba_f'])
    la_b = _gla_decay(ab, p['wa2_b'], p['ba_b'])
    o_f, _ = _gla_scan(qc_, kc_, vc_, la_f, s_f)
    o_b, _ = _gla_scan(_flip(qc_), _flip(kc_), _flip(vc_), _flip(la_b), s_b)
    oC = _gla_out(o_f + _flip(o_b), rC, p['gn_c'])

    y = _merge(oA, oB, oC, gates, p)
    if last:
        return y, None
    coA = _dense_attention(_rmsnorm(_heads(cqA, A_HEADS), p['qn_a']), cka, cva, p['sink_a'])
    coB = _dense_attention(_rmsnorm(_heads(cqB, B_HEADS), p['qn_b']), ckb, cvb, None)
    yc = _merge(coA, coB, coC, cgates, p)
    return y, yc


def _peer(h, p):
    T, D = h.shape
    u_tab, v_tab = p['peer_u'], p['peer_v']

    def block(xb):
        q = _rmsnorm((xb @ p['w_pq']).reshape(PEER_BLOCK, PEER_HEADS, 2, PEER_HALF), p['pq_g'])
        s = jnp.einsum('tphd,phnd->tphn', q, p['sub_keys']).astype(jnp.float32)
        s1, i1 = lax.top_k(s[:, :, 0], PEER_TOPK)
        s2, i2 = lax.top_k(s[:, :, 1], PEER_TOPK)
        cand = (s1[..., :, None] + s2[..., None, :]).reshape(PEER_BLOCK, PEER_HEADS, PEER_TOPK * PEER_TOPK)
        cidx = (i1[..., :, None] * PEER_NKEYS + i2[..., None, :]).reshape(PEER_BLOCK, PEER_HEADS, PEER_TOPK * PEER_TOPK)
        top, pos = lax.top_k(cand, PEER_TOPK)
        idx = jnp.take_along_axis(cidx, pos, axis=-1)
        g = jax.nn.softmax(top, axis=-1).astype(xb.dtype)
        u = u_tab[idx]
        v = v_tab[idx]
        act = jax.nn.gelu(jnp.einsum('td,tpkd->tpk', xb, u), approximate=False)
        return jnp.einsum('tpk,tpkd->td', g * act, v)

    return lax.map(block, h.reshape(T // PEER_BLOCK, PEER_BLOCK, D)).reshape(T, D)


def _layer(x, ctx, c_act, cctx_act, p, cos, sin, last):
    B, S, D = x.shape
    L = ctx.shape[1]
    sh1, sc1, g1, sh2, sc2, g2 = jnp.split((c_act @ p['w_mod'] + p['b_mod'])[:, None, :], N_MOD, axis=-1)
    csh1, csc1, cg1, csh2, csc2, cg2 = jnp.split(cctx_act @ p['w_mod'] + p['b_mod'], N_MOD, axis=-1)
    h = _modulate(x, p['norm1'], sh1, sc1)
    hc = _modulate(ctx, p['norm1'], csh1, csc1)
    y, yc = _token_mixers(h, hc, p, cos, sin, last)
    x = x + g1 * y
    h2 = _modulate(x, p['norm2'], sh2, sc2)
    if last:
        return x + g2 * _peer(h2.reshape(B * S, D), p).reshape(B, S, D), ctx
    ctx = ctx + cg1 * yc
    hc2 = _modulate(ctx, p['norm2'], csh2, csc2)
    out = _peer(jnp.concatenate([h2.reshape(B * S, D), hc2.reshape(B * L, D)], axis=0), p)
    x = x + g2 * out[:B * S].reshape(B, S, D)
    ctx = ctx + cg2 * out[B * S:].reshape(B, L, D)
    return x, ctx


def setup_inputs(seed: int = 0) -> dict:
    key = jax.random.key(seed)
    ks = iter(jax.random.split(key, 40))

    def nrm(shape, scale):
        return jax.random.normal(next(ks), shape, jnp.float32) * scale

    D, Ly = D_MODEL, DEPTH
    return {
        'x': nrm((BATCH, SEQ, D), 1.0),
        'c': nrm((BATCH, D), 1.0),
        'ctx': nrm((BATCH, CTX_LEN, D), 1.0),
        'c_ctx': nrm((D,), 1.0),
        'w_mod': nrm((Ly, D, N_MOD * D), 0.5 * D ** -0.5),
        'b_mod': nrm((Ly, N_MOD * D), 0.02),
        'norm1': 1.0 + nrm((Ly, D), 0.05),
        'norm2': 1.0 + nrm((Ly, D), 0.05),
        'w_in': nrm((Ly, D, IN_WIDTH), D ** -0.5),
        'qn_a': 1.0 + nrm((Ly, HEAD_DIM), 0.05),
        'kn_a': 1.0 + nrm((Ly, HEAD_DIM), 0.05),
        'sink_a': nrm((Ly, A_HEADS), 0.5),
        'qn_b': 1.0 + nrm((Ly, HEAD_DIM), 0.05),
        'kn_b': 1.0 + nrm((Ly, HEAD_DIM), 0.05),
        'rpb_b': nrm((Ly, B_HEADS, 2 * NA_ROWS - 1, 2 * NA_COLS - 1), 0.1),
        'wa2_f': nrm((Ly, C_GATE_RANK, C_K), C_GATE_RANK ** -0.5),
        'ba_f': nrm((Ly, C_K), 0.1),
        'wa2_b': nrm((Ly, C_GATE_RANK, C_K), C_GATE_RANK ** -0.5),
        'ba_b': nrm((Ly, C_K), 0.1),
        'gn_c': 1.0 + nrm((Ly, C_DV), 0.05),
        'w_oa': nrm((Ly, A_Q, D), A_Q ** -0.5),
        'w_ob': nrm((Ly, B_W, D), B_W ** -0.5),
        'w_oc': nrm((Ly, C_V, D), C_V ** -0.5),
        'w_out': nrm((Ly, D, D), D ** -0.5),
        'w_pq': nrm((Ly, D, PEER_HEADS * PEER_QDIM), D ** -0.5),
        'pq_g': 1.0 + nrm((Ly, PEER_HALF), 0.05),
        'sub_keys': nrm((Ly, PEER_HEADS, 2, PEER_NKEYS, PEER_HALF), PEER_HALF ** -0.5),
        'peer_u': nrm((Ly, PEER_EXPERTS, D), D ** -0.5),
        'peer_v': nrm((Ly, PEER_EXPERTS, D), 0.5),
    }


def reference(x, c, ctx, c_ctx, w_mod, b_mod, norm1, norm2, w_in, qn_a, kn_a, sink_a, qn_b, kn_b, rpb_b,
              wa2_f, ba_f, wa2_b, ba_b, gn_c, w_oa, w_ob, w_oc, w_out, w_pq, pq_g, sub_keys, peer_u, peer_v):
    c_act = jax.nn.silu(c)
    cctx_act = jax.nn.silu(c_ctx)
    cos, sin = _axial_rope(x.shape[1])
    for i in range(DEPTH):
        p = {
            'w_mod': w_mod[i], 'b_mod': b_mod[i], 'norm1': norm1[i], 'norm2': norm2[i], 'w_in': w_in[i],
            'qn_a': qn_a[i], 'kn_a': kn_a[i], 'sink_a': sink_a[i], 'qn_b': qn_b[i], 'kn_b': kn_b[i],
            'rpb_b': rpb_b[i], 'wa2_f': wa2_f[i], 'ba_f': ba_f[i], 'wa2_b': wa2_b[i], 'ba_b': ba_b[i],
            'gn_c': gn_c[i], 'w_oa': w_oa[i], 'w_ob': w_ob[i], 'w_oc': w_oc[i], 'w_out': w_out[i],
            'w_pq': w_pq[i], 'pq_g': pq_g[i], 'sub_keys': sub_keys[i], 'peer_u': peer_u[i], 'peer_v': peer_v[i],
        }
        x, ctx = _layer(x, ctx, c_act, cctx_act, p, cos, sin, i == DEPTH - 1)
    return x
```

```cpp
#include <hip/hip_runtime.h>
#include <stdint.h>
#include <stdio.h>

#define DBG_ZERO 0
#define LAS __attribute__((address_space(3)))
#define DI __device__ __forceinline__
typedef unsigned short bf16_t;
typedef short bf16x8 __attribute__((ext_vector_type(8)));
typedef float f32x4 __attribute__((ext_vector_type(4)));
typedef float f32x16 __attribute__((ext_vector_type(16)));
typedef unsigned u32x4 __attribute__((ext_vector_type(4)));
typedef unsigned u32x2 __attribute__((ext_vector_type(2)));

constexpr int D = 1024, NB = 2, S = 16384, LC = 256, DEPTH = 4;
constexpr int NLAT = NB * S;
constexpr int NROW = NLAT + NB * LC;
constexpr int PW = 8480;
constexpr int C_KA = 0, C_VA = 128, C_KB = 256, C_VB = 768, C_KC = 1280, C_VC = 1792, C_AC = 2816, C_QA = 2848, C_QB = 3360, C_QC = 3872, C_RC = 4384, C_GT = 5408;
constexpr int TOKB = S + LC;
constexpr int VTR = 1664;
constexpr int NCH = 260;
constexpr float EPS = 1e-6f;
constexpr float LOG2E = 1.4426950408889634f;
constexpr int NPH = 12;
constexpr int NGPH = 1 + DEPTH * NPH;

constexpr size_t WS_CTL = 0;
constexpr size_t WS_MOD = 65536;
constexpr size_t WS_CTX = WS_MOD + 512 * 1024;
constexpr size_t WS_WIN = WS_CTX + 2 * 1024 * 1024;
constexpr size_t WS_WO = WS_WIN + (size_t)8704 * 1024 * 2;
constexpr size_t WS_WOUT = WS_WO + (size_t)4 * 1024 * 512 * 2;
constexpr size_t WS_WPQ = WS_WOUT + (size_t)1024 * 1024 * 2;
constexpr size_t WS_SUBK = WS_WPQ + (size_t)2048 * 1024 * 2;
constexpr size_t WS_PU = WS_SUBK + 512 * 1024;
constexpr size_t WS_PV = WS_PU + (size_t)16384 * 1024 * 2;
constexpr size_t WS_PROJ = WS_PV + (size_t)16384 * 1024 * 2;
constexpr size_t WS_VT = WS_PROJ + (size_t)NROW * PW * 2;
constexpr size_t WS_DEC = WS_VT + (size_t)NB * VTR * TOKB * 2;
constexpr size_t WS_ST = WS_DEC + (size_t)16 * NCH * 128 * 4;
constexpr size_t WS_END = WS_ST + (size_t)16 * NCH * 32768 * 2;
constexpr size_t WS_H = WS_ST;
constexpr size_t WS_M32 = WS_ST;
constexpr size_t WS_M = WS_ST + (size_t)NROW * 1024 * 4;
constexpr size_t WS_H2 = WS_VT;
constexpr size_t WS_PQ = WS_ST;
constexpr size_t WS_PIDX = WS_PROJ;
constexpr size_t WS_PG = WS_PROJ + (size_t)NROW * 128 * 4;
static_assert(WS_M + (size_t)NROW * 1024 * 2 <= WS_END && (size_t)NROW * 1024 * 2 <= (size_t)NB * VTR * TOKB * 2 && WS_END <= ((size_t)1 << 30), "workspace map");

constexpr int LDS_BYTES = 147456;
constexpr int LDS_BARW = 131072;

DI float bf_lo(unsigned w) { return __uint_as_float(w << 16); }
DI float bf_hi(unsigned w) { return __uint_as_float(w & 0xffff0000u); }
DI float bf2f(bf16_t b) { return __uint_as_float((unsigned)b << 16); }
typedef __bf16 bf16v2 __attribute__((ext_vector_type(2)));
DI unsigned pack2(float lo, float hi) { bf16v2 v; v.x = (__bf16)lo; v.y = (__bf16)hi; return __builtin_bit_cast(unsigned, v); }
DI bf16_t f2bf(float f) { return (bf16_t)(pack2(f, 0.f) & 0xffffu); }
DI float wave_sum(float v) {
#pragma unroll
    for (int o = 32; o > 0; o >>= 1) v += __shfl_xor(v, o);
    return v;
}
DI int otid() { int t = threadIdx.x; asm volatile("" : "+v"(t)); return t; }
DI float sigmoidf_(float x) { return 1.0f / (1.0f + __expf(-x)); }
DI f32x16 zero16() { f32x16 z; for (int i = 0; i < 16; ++i) z[i] = 0.f; return z; }
#define MFMA32(a, b, c) __builtin_amdgcn_mfma_f32_32x32x16_bf16((a), (b), (c), 0, 0, 0)
DI int pi32(int i) { return (i & 0x13) | ((i & 8) >> 1) | ((i & 4) << 1); }

#define XB_TMO      128
#define XB_XCNT(j)  (256  + 64 * (j))
#define XB_XSUB(j)  (1280 + 64 * (j))
#define XB_XGEN(j)  (2304 + 64 * (j))
#define XB_TOP      3328
#define XB_TOPGEN   3392
#define XCD_BAR_WORDS 3456
#define XB_SPIN_CAP (1u << 22)
DI unsigned xb_ld(unsigned* p)              { return __hip_atomic_load(p, __ATOMIC_RELAXED, __HIP_MEMORY_SCOPE_AGENT); }
DI unsigned xb_add(unsigned* p, unsigned v) { return __hip_atomic_fetch_add(p, v, __ATOMIC_RELAXED, __HIP_MEMORY_SCOPE_AGENT); }
DI unsigned xb_xcc_id() { return (unsigned)__builtin_amdgcn_s_getreg((3 << 11) | 20) & 0xFu; }
#define XB_SPIN(cond, bar) do { unsigned _sp = 0; while (cond) { __builtin_amdgcn_s_sleep(1); \
    if ((++_sp & 255u) == 0u) { if (xb_ld(&(bar)[XB_TMO])) break; if (_sp > XB_SPIN_CAP) { atomicAdd(&(bar)[XB_TMO], 1u); break; } } } } while (0)
struct XcdBarrier { unsigned* bar; unsigned x; volatile LAS unsigned* st; };
DI XcdBarrier xcd_barrier_post(unsigned* bar, volatile LAS unsigned* st) {
    XcdBarrier b; b.bar = bar; b.x = xb_xcc_id(); b.st = st;
    if (threadIdx.x == 0) (void)xb_add(&bar[XB_XCNT(b.x)], 1u);
    return b;
}
DI void xcd_barrier_complete(unsigned* bar, unsigned x, unsigned& nloc, unsigned& nx) {
    const unsigned G = gridDim.x * gridDim.y * gridDim.z;
    unsigned sum, cnt, mine, sp = 0u;
    for (;;) {
        sum = 0u; cnt = 0u; mine = 0u;
#pragma unroll
        for (unsigned j = 0; j < 16; ++j) { const unsigned c = xb_ld(&bar[XB_XCNT(j)]); sum += c; cnt += (c > 0u) ? 1u : 0u; mine = (j == x) ? c : mine; }
        if (sum == G) break;
        __builtin_amdgcn_s_sleep(1);
        if ((++sp & 255u) == 0u) { if (xb_ld(&bar[XB_TMO])) break; if (sp > XB_SPIN_CAP) { atomicAdd(&bar[XB_TMO], 1u); break; } }
    }
    nloc = mine > 0u ? mine : 1u; nx = cnt > 0u ? cnt : 1u;
}
DI void xcd_barrier(const XcdBarrier& b) {
    asm volatile("s_waitcnt vmcnt(0)" ::: "memory");
    __syncthreads();
    if (threadIdx.x == 0) {
        unsigned* bar = b.bar;
        __builtin_amdgcn_s_waitcnt(0);
        unsigned nloc = b.st[0], nx = b.st[1];
        if (nloc == 0u) { xcd_barrier_complete(bar, b.x, nloc, nx); b.st[0] = nloc; b.st[1] = nx; }
        const unsigned old = xb_add(&bar[XB_XSUB(b.x)], 1u);
        const unsigned gen = old / nloc;
        if (old + 1u == (gen + 1u) * nloc) {
            __builtin_amdgcn_fence(__ATOMIC_RELEASE, "agent");
            asm volatile("s_waitcnt vmcnt(0)" ::: "memory");
            const unsigned og = xb_add(&bar[XB_TOP], 1u);
            const unsigned tg = og / nx;
            if (og + 1u == (tg + 1u) * nx) xb_add(&bar[XB_TOPGEN], 1u);
            else XB_SPIN(xb_ld(&bar[XB_TOPGEN]) == tg, bar);
            __builtin_amdgcn_fence(__ATOMIC_ACQUIRE, "agent");
            xb_add(&bar[XB_XGEN(b.x)], 1u);
            asm volatile("s_waitcnt vmcnt(0)" ::: "memory");
        } else {
            XB_SPIN(xb_ld(&bar[XB_XGEN(b.x)]) == gen, bar);
            __builtin_amdgcn_fence(__ATOMIC_ACQUIRE, "agent");
            asm volatile("s_waitcnt vmcnt(0)" ::: "memory");
        }
    }
    __syncthreads();
}

struct Params {
    const float* in[29];
    float* out;
    unsigned char* ws;
    int gp_lo, gp_hi;
    int use_bar, pad0;
};
enum { I_X = 0, I_C, I_CTX, I_CCTX, I_WMOD, I_BMOD, I_NORM1, I_NORM2, I_WIN, I_QNA, I_KNA, I_SINKA, I_QNB, I_KNB, I_RPB, I_WA2F, I_BAF, I_WA2B, I_BAB, I_GNC, I_WOA, I_WOB, I_WOC, I_WOUT, I_WPQ, I_PQG, I_SUBK, I_PU, I_PV };

namespace pg8 {
constexpr int BM = 256, BK = 64, HALF = 128, HTB = HALF * BK * 2, STAGE_BYTES = 8 * HTB, NXCD = 8, WGM = 8;
DI int lds_byte(int r, int c) { const int st = (r >> 4) * 2 + (c >> 5), rr = r & 15, cc = c & 31, ob = rr * 64 + cc * 2; return st * 1024 + (ob ^ (((ob >> 9) & 1) << 5)); }
DI void stage_rc(int b, int& R, int& C) { const int st = b / 1024, sb = b % 1024, swz = sb ^ (((sb >> 9) & 1) << 5); R = (st >> 1) * 16 + swz / 64; C = (st & 1) * 32 + (swz % 64) / 2; }
DI int perm32(int rho) { const int n = rho >> 4, i = rho & 15; return 8 * (i >> 2) + 4 * n + (i & 3); }
struct Unit { int pm, pn, seg; };
struct Gemm { const bf16_t* A; const bf16_t* Bt; int lda, ldb, K; int ac0, ac1, ac2, ac3; size_t bseg; };
DI int gemm_acol(const Gemm& g, int seg) { return seg == 0 ? g.ac0 : (seg == 1 ? g.ac1 : (seg == 2 ? g.ac2 : g.ac3)); }
template <int NSEG> struct Order {
    int nM, nN, nwg, G, c;
    DI void init(int M, int N, int G_, int c_) { nM = M / BM; nN = N / BM; nwg = nM * nN; G = G_; c = c_; }
    DI bool next(int i, Unit& u) const {
        const int t = i / NSEG; u.seg = i - t * NSEG;
        const long L = (long)t * G + c; if (L >= nwg) return false;
        int wgid = (int)L; { const int q = nwg / NXCD, r = nwg % NXCD, xcd = wgid % NXCD, off = wgid / NXCD; wgid = (xcd < r ? xcd * (q + 1) : r * (q + 1) + (xcd - r) * q) + off; }
        const int nig = WGM * nN, gid = wgid / nig, fm = gid * WGM, gsz = (nM - fm) < WGM ? (nM - fm) : WGM;
        u.pm = fm + ((wgid % nig) % gsz); u.pn = (wgid % nig) / gsz; return true;
    }
};
DI unsigned cvt_pk_bf16(float lo, float hi) { unsigned r; asm volatile("v_cvt_pk_bf16_f32 %0, %1, %2" : "=v"(r) : "v"(lo), "v"(hi)); return r; }

template <class Epi, class Sched>
DI void gemm_phase(LAS unsigned char* lds, const Gemm g, const Sched& S, const Epi& E) {
    const int tid = otid(), wid = __builtin_amdgcn_readfirstlane(tid >> 6), lane = tid & 63, wr = wid >> 2, wc = wid & 3, fr = lane & 15, fq = lane >> 4;
    const int K = g.K, nt = K / BK;
    unsigned voffA[2], voffB[2];
#pragma unroll
    for (int i = 0; i < 2; ++i) { int R, C; stage_rc(tid * 16 + i * 8192, R, C); const int Rb = Epi::PERM ? ((R & ~31) + perm32(R & 31)) : R;
        voffA[i] = (unsigned)(R * g.lda + C) * 2u; voffB[i] = (unsigned)(Rb * g.ldb + C) * 2u; }
    const size_t kstep = (size_t)(BK * 2);
    const size_t hstepA = (size_t)HALF * g.lda * 2, hstepB = (size_t)HALF * g.ldb * 2;
    const unsigned ldsw = (unsigned)wid * 1024u;
    const int aoff = lds_byte(wr * 64 + fr, fq * 8), boff = lds_byte(wc * 32 + fr, fq * 8);
#define PG8_SA(b, h) (((b) * 2 + (h)) * HTB)
#define PG8_SB(b, h) ((4 + (b) * 2 + (h)) * HTB)
#define PG8_STAGE(bufoff, gbase, voff) do { _Pragma("unroll") for (int _i = 0; _i < 2; ++_i) \
        __builtin_amdgcn_global_load_lds((const unsigned*)((const char*)(gbase) + (voff)[_i]), (LAS unsigned*)(lds + (bufoff) + ldsw + _i * 8192), 16, 0, 0); } while (0)
#define PG8_LDA(dst, b, h) do { _Pragma("unroll") for (int m = 0; m < 4; ++m) _Pragma("unroll") for (int k = 0; k < 2; ++k) dst[m][k] = *(const LAS bf16x8*)(lds + PG8_SA(b, h) + aoff + m * 2048 + k * 1024); } while (0)
#define PG8_LDB(dst, b, h) do { _Pragma("unroll") for (int n = 0; n < 2; ++n) _Pragma("unroll") for (int k = 0; k < 2; ++k) dst[n][k] = *(const LAS bf16x8*)(lds + PG8_SB(b, h) + boff + n * 2048 + k * 1024); } while (0)
#define PG8_MMA(ai, bj, At, Bt) do { __builtin_amdgcn_s_setprio(1); _Pragma("unroll") for (int m = 0; m < 4; ++m) _Pragma("unroll") for (int n = 0; n < 2; ++n) _Pragma("unroll") for (int k = 0; k < 2; ++k) \
        acc[ai][bj][m][n] = __builtin_amdgcn_mfma_f32_16x16x32_bf16(Bt[n][k], At[m][k], acc[ai][bj][m][n], 0, 0, 0); __builtin_amdgcn_s_setprio(0); } while (0)
#define PG8_WAIT_V(n) asm volatile("s_waitcnt vmcnt(" #n ")" ::: "memory")
#define PG8_WAIT_L(n) asm volatile("s_waitcnt lgkmcnt(" #n ")" ::: "memory")
#define PG8_BAR __builtin_amdgcn_s_barrier()
#define PG8_SCHED __builtin_amdgcn_sched_barrier(0)
#define PG8_APTR(u) ((const char*)g.A + ((size_t)(u).pm * BM * g.lda + (size_t)gemm_acol(g, (u).seg)) * 2)
#define PG8_BPTR(u) ((const char*)g.Bt + ((size_t)(u).seg * g.bseg + (size_t)(u).pn * BM * g.ldb) * 2)
    Unit cur, nxt; int ui = 0;
    if (!S.next(0, cur)) return;
    f32x4 acc[2][2][4][2];
#pragma unroll
    for (int a = 0; a < 2; ++a)
#pragma unroll
        for (int b = 0; b < 2; ++b)
#pragma unroll
            for (int m = 0; m < 4; ++m)
#pragma unroll
                for (int n = 0; n < 2; ++n) acc[a][b][m][n] = (f32x4){0.f, 0.f, 0.f, 0.f};
    bf16x8 At[4][2], B0[2][2], B1[2][2];
    const char* cA = PG8_APTR(cur); const char* cB = PG8_BPTR(cur);
    PG8_STAGE(PG8_SB(0, 0), cB, voffB); PG8_STAGE(PG8_SA(0, 0), cA, voffA); PG8_STAGE(PG8_SB(0, 1), cB + hstepB, voffB); PG8_STAGE(PG8_SA(0, 1), cA + hstepA, voffA);
    if (wr == 1) PG8_BAR;
    PG8_WAIT_V(4); PG8_BAR;
    PG8_STAGE(PG8_SB(1, 0), cB + kstep, voffB); PG8_STAGE(PG8_SA(1, 0), cA + kstep, voffA); PG8_STAGE(PG8_SB(1, 1), cB + hstepB + kstep, voffB);
    PG8_WAIT_V(6); PG8_BAR;
    for (;;) {
        const bool has_next = S.next(ui + 1, nxt);
        const char* nA = has_next ? PG8_APTR(nxt) : cA; const char* nB = has_next ? PG8_BPTR(nxt) : cB;
        for (int t = 0; t < nt; t += 2) {
            const bool last = (t == nt - 2);
            const char* a1 = cA + (size_t)(t + 1) * kstep;
            const char* a2 = last ? nA : cA + (size_t)(t + 2) * kstep; const char* b2 = last ? nB : cB + (size_t)(t + 2) * kstep;
            const char* a3 = a2 + kstep; const char* b3 = b2 + kstep;
            PG8_LDB(B0, 0, 0); PG8_SCHED; PG8_LDA(At, 0, 0); PG8_STAGE(PG8_SA(1, 1), a1 + hstepA, voffA);
            PG8_WAIT_L(8); PG8_BAR; PG8_WAIT_L(0); PG8_MMA(0, 0, At, B0); PG8_BAR; PG8_SCHED;
            PG8_LDB(B1, 0, 1); PG8_STAGE(PG8_SB(0, 0), b2, voffB);
            PG8_BAR; PG8_WAIT_L(0); PG8_MMA(0, 1, At, B1); PG8_BAR;
            PG8_LDA(At, 0, 1); PG8_STAGE(PG8_SA(0, 0), a2, voffA);
            PG8_BAR; PG8_WAIT_L(0); PG8_MMA(1, 0, At, B0); PG8_BAR; PG8_SCHED;
            PG8_STAGE(PG8_SB(0, 1), b2 + hstepB, voffB);
            PG8_WAIT_V(6); PG8_BAR; PG8_MMA(1, 1, At, B1); PG8_BAR;
            PG8_LDB(B0, 1, 0); PG8_SCHED; PG8_LDA(At, 1, 0); PG8_STAGE(PG8_SA(0, 1), a2 + hstepA, voffA);
            PG8_WAIT_L(8); PG8_BAR; PG8_WAIT_L(0); PG8_MMA(0, 0, At, B0); PG8_BAR; PG8_SCHED;
            PG8_LDB(B1, 1, 1); PG8_STAGE(PG8_SB(1, 0), b3, voffB);
            PG8_BAR; PG8_WAIT_L(0); PG8_MMA(0, 1, At, B1); PG8_BAR;
            PG8_LDA(At, 1, 1); PG8_STAGE(PG8_SA(1, 0), a3, voffA);
            PG8_BAR; PG8_WAIT_L(0); PG8_MMA(1, 0, At, B0); PG8_BAR; PG8_SCHED;
            PG8_STAGE(PG8_SB(1, 1), b3 + hstepB, voffB);
            PG8_WAIT_V(6); PG8_BAR; PG8_MMA(1, 1, At, B1); PG8_BAR;
        }
        E(acc, cur, wr, wc, fr, fq);
        if (!has_next) break;
#pragma unroll
        for (int a = 0; a < 2; ++a)
#pragma unroll
            for (int b = 0; b < 2; ++b)
#pragma unroll
                for (int m = 0; m < 4; ++m)
#pragma unroll
                    for (int n = 0; n < 2; ++n) acc[a][b][m][n] = (f32x4){0.f, 0.f, 0.f, 0.f};
        cur = nxt; cA = nA; cB = nB; ++ui;
    }
    PG8_WAIT_V(0);
    if (wr == 0) PG8_BAR;
    PG8_BAR;
#undef PG8_SA
#undef PG8_SB
#undef PG8_STAGE
#undef PG8_LDA
#undef PG8_LDB
#undef PG8_MMA
#undef PG8_WAIT_V
#undef PG8_WAIT_L
#undef PG8_BAR
#undef PG8_SCHED
#undef PG8_APTR
#undef PG8_BPTR
}

struct EpiBf16 {
    static constexpr bool PERM = true;
    bf16_t* O; int ldc, ncols;
    DI void operator()(const f32x4 (&acc)[2][2][4][2], const Unit& u, int wr, int wc, int fr, int fq) const {
        const int row0 = u.pm * BM + wr * 64 + fr, col0 = u.pn * BM + wc * 32 + 8 * fq;
#pragma unroll
        for (int ai = 0; ai < 2; ++ai)
#pragma unroll
            for (int m = 0; m < 4; ++m) { bf16_t* rowp = O + (size_t)(row0 + ai * HALF + m * 16) * ldc + col0;
#pragma unroll
                for (int bj = 0; bj < 2; ++bj) { const f32x4 v0 = acc[ai][bj][m][0], v1 = acc[ai][bj][m][1];
                    u32x4 w; w.x = cvt_pk_bf16(v0[0], v0[1]); w.y = cvt_pk_bf16(v0[2], v0[3]); w.z = cvt_pk_bf16(v1[0], v1[1]); w.w = cvt_pk_bf16(v1[2], v1[3]);
                    if (col0 + bj * HALF < ncols) *(u32x4*)(rowp + bj * HALF) = w; } }
    }
};
struct EpiMerge {
    static constexpr bool PERM = true;
    const bf16_t* proj; float* M32; bf16_t* Mo;
    DI void operator()(const f32x4 (&acc)[2][2][4][2], const Unit& u, int wr, int wc, int fr, int fq) const {
        const int row0 = u.pm * BM + wr * 64 + fr, col0 = u.pn * BM + wc * 32 + 8 * fq;
        const int gsel = u.seg < 2 ? u.seg : 2;
#pragma unroll
        for (int ai = 0; ai < 2; ++ai)
#pragma unroll
            for (int m = 0; m < 4; ++m) {
                const size_t row = (size_t)(row0 + ai * HALF + m * 16);
#pragma unroll
                for (int bj = 0; bj < 2; ++bj) {
                    const int col = col0 + bj * HALF;
                    const u32x4 gw = *(const u32x4*)(proj + row * PW + C_GT + gsel * 1024 + col);
                    f32x4 v0 = acc[ai][bj][m][0], v1 = acc[ai][bj][m][1];
                    v0[0] *= sigmoidf_(bf_lo(gw.x)); v0[1] *= sigmoidf_(bf_hi(gw.x)); v0[2] *= sigmoidf_(bf_lo(gw.y)); v0[3] *= sigmoidf_(bf_hi(gw.y));
                    v1[0] *= sigmoidf_(bf_lo(gw.z)); v1[1] *= sigmoidf_(bf_hi(gw.z)); v1[2] *= sigmoidf_(bf_lo(gw.w)); v1[3] *= sigmoidf_(bf_hi(gw.w));
                    if (DBG_ZERO & (1 << gsel)) { v0 *= 0.f; v1 *= 0.f; }
                    float* mp = M32 + row * 1024 + col;
                    if (u.seg > 0) { v0 += *(const f32x4*)mp; v1 += *(const f32x4*)(mp + 4); }
                    if (u.seg < 3) { *(f32x4*)mp = v0; *(f32x4*)(mp + 4) = v1; }
                    else { u32x4 w; w.x = cvt_pk_bf16(v0[0], v0[1]); w.y = cvt_pk_bf16(v0[2], v0[3]); w.z = cvt_pk_bf16(v1[0], v1[1]); w.w = cvt_pk_bf16(v1[2], v1[3]);
                        *(u32x4*)(Mo + row * 1024 + col) = w; }
                }
            }
    }
};
struct EpiResid {
    static constexpr bool PERM = false;
    const float* xin_lat; const float* xin_ctx; float* xout_lat; float* xout_ctx; const float* gate;
    DI void operator()(const f32x4 (&acc)[2][2][4][2], const Unit& u, int wr, int wc, int fr, int fq) const {
        const int rowt = u.pm * BM;
        const bool lat = rowt < NLAT;
        const int mv = lat ? (rowt >> 14) : 2;
        const float* xin = lat ? xin_lat + (size_t)rowt * 1024 : xin_ctx + (size_t)(rowt - NLAT) * 1024;
        float* xo = lat ? xout_lat + (size_t)rowt * 1024 : xout_ctx + (size_t)(rowt - NLAT) * 1024;
        const int r0 = wr * 64 + fr, col0 = u.pn * BM + wc * 32 + 4 * fq;
        const float* gp = gate + mv * 6144 + col0;
#pragma unroll
        for (int ai = 0; ai < 2; ++ai)
#pragma unroll
            for (int m = 0; m < 4; ++m) {
                const unsigned ro = (unsigned)(r0 + ai * HALF + m * 16) * 1024u + (unsigned)col0;
#pragma unroll
                for (int bj = 0; bj < 2; ++bj)
#pragma unroll
                    for (int n = 0; n < 2; ++n) {
                        const f32x4 gv = *(const f32x4*)(gp + bj * HALF + n * 16);
                        const f32x4 xv = *(const f32x4*)(xin + ro + bj * HALF + n * 16);
                        *(f32x4*)(xo + ro + bj * HALF + n * 16) = xv + gv * acc[ai][bj][m][n]; }
            }
    }
};
}

DI void phase_mod(const Params& p, LAS float* lds) {
    const int tid = otid();
    LAS float* act = lds;
    LAS float* red = lds + 3072;
    for (int i = tid; i < 3072; i += 512) { const int v = i >> 10, k = i & 1023; const float x = v < 2 ? p.in[I_C][v * 1024 + k] : p.in[I_CCTX][k]; act[i] = x / (1.0f + __expf(-x)); }
    __syncthreads();
    float* mod = (float*)(p.ws + WS_MOD);
    const int c = tid & 31, kg = tid >> 5;
    for (int cb = blockIdx.x; cb < 256; cb += gridDim.x) {
        const int l = cb >> 6, col0 = (cb & 63) * 96;
        const float* W = p.in[I_WMOD] + (size_t)l * 1024 * 6144;
        for (int sub = 0; sub < 3; ++sub) {
            const int col = col0 + sub * 32 + c;
            float a0 = 0.f, a1 = 0.f, a2 = 0.f;
#pragma unroll 8
            for (int k = kg; k < 1024; k += 16) { const float w = W[(size_t)k * 6144 + col]; a0 += act[k] * w; a1 += act[1024 + k] * w; a2 += act[2048 + k] * w; }
            red[(kg * 3 + 0) * 32 + c] = a0; red[(kg * 3 + 1) * 32 + c] = a1; red[(kg * 3 + 2) * 32 + c] = a2;
            __syncthreads();
            if (tid < 96) { const int v = tid >> 5, cc = tid & 31; float s = 0.f;
#pragma unroll
                for (int q = 0; q < 16; ++q) s += red[(q * 3 + v) * 32 + cc];
                const int cj = col0 + sub * 32 + cc;
                mod[((size_t)l * 3 + v) * 6144 + cj] = s + p.in[I_BMOD][l * 6144 + cj]; }
            __syncthreads();
        }
    }
}

DI void tcvt_tile(const float* src, int K, int N, bf16_t* dst, int kt, int nt, LAS float* tile) {
    const int tid = otid();
    { const int r = tid >> 4, c4 = (tid & 15) * 4;
#pragma unroll
        for (int i = 0; i < 2; ++i) { const int kk = kt * 64 + r + 32 * i, nn = nt * 64 + c4;
            f32x4 v = (f32x4){0.f, 0.f, 0.f, 0.f};
            if (nn < N) v = *(const f32x4*)(src + (size_t)kk * N + nn);
            LAS float* t = tile + (r + 32 * i) * 65 + c4; t[0] = v[0]; t[1] = v[1]; t[2] = v[2]; t[3] = v[3]; } }
    __syncthreads();
    { const int n = tid >> 3, kc = (tid & 7) * 8; float v[8];
#pragma unroll
        for (int j = 0; j < 8; ++j) v[j] = tile[(kc + j) * 65 + n];
        u32x4 w; w.x = pack2(v[0], v[1]); w.y = pack2(v[2], v[3]); w.z = pack2(v[4], v[5]); w.w = pack2(v[6], v[7]);
        *(u32x4*)(dst + (size_t)(nt * 64 + n) * K + kt * 64 + kc) = w; }
    __syncthreads();
}
DI void tcvt_job(const float* src, int K, int N, int Npad, bf16_t* dst, LAS float* tile, int& base) {
    const int nkt = K / 64, nnt = Npad / 64, ntl = nkt * nnt, G = gridDim.x;
    int first = ((int)blockIdx.x - (base % G) + G) % G;
    for (int t = first; t < ntl; t += G) tcvt_tile(src, K, N, dst, t % nkt, t / nkt, tile);
    base += ntl;
}
DI void cvt_copy(const float* src, bf16_t* dst, size_t n) {
    const size_t nth = (size_t)gridDim.x * 512;
    for (size_t i = ((size_t)blockIdx.x * 512 + otid()) * 8; i < n; i += nth * 8) {
        const f32x4 a = *(const f32x4*)(src + i), b = *(const f32x4*)(src + i + 4);
        u32x4 w; w.x = pack2(a[0], a[1]); w.y = pack2(a[2], a[3]); w.z = pack2(b[0], b[1]); w.w = pack2(b[2], b[3]);
        *(u32x4*)(dst + i) = w;
    }
}
DI void phase_convert(const Params& p, int l, LAS float* lds) {
    int base = 0;
    tcvt_job(p.in[I_WIN] + (size_t)l * 1024 * PW, 1024, PW, 8704, (bf16_t*)(p.ws + WS_WIN), lds, base);
    tcvt_job(p.in[I_WOA] + (size_t)l * 512 * 1024, 512, 1024, 1024, (bf16_t*)(p.ws + WS_WO), lds, base);
    tcvt_job(p.in[I_WOB] + (size_t)l * 512 * 1024, 512, 1024, 1024, (bf16_t*)(p.ws + WS_WO) + (size_t)1 * 1024 * 512, lds, base);
    tcvt_job(p.in[I_WOC] + (size_t)l * 1024 * 1024, 512, 1024, 1024, (bf16_t*)(p.ws + WS_WO) + (size_t)2 * 1024 * 512, lds, base);
    tcvt_job(p.in[I_WOC] + (size_t)l * 1024 * 1024 + (size_t)512 * 1024, 512, 1024, 1024, (bf16_t*)(p.ws + WS_WO) + (size_t)3 * 1024 * 512, lds, base);
    tcvt_job(p.in[I_WOUT] + (size_t)l * 1024 * 1024, 1024, 1024, 1024, (bf16_t*)(p.ws + WS_WOUT), lds, base);
    tcvt_job(p.in[I_WPQ] + (size_t)l * 1024 * 2048, 1024, 2048, 2048, (bf16_t*)(p.ws + WS_WPQ), lds, base);
    { const float* sk = p.in[I_SUBK] + (size_t)l * 262144; const float* pg = p.in[I_PQG] + l * 128; bf16_t* dst = (bf16_t*)(p.ws + WS_SUBK);
        for (int i = (blockIdx.x * 512 + otid()) * 2; i < 262144; i += gridDim.x * 1024) {
            const int d = i & 127; *(unsigned*)(dst + i) = pack2(sk[i] * pg[d], sk[i + 1] * pg[d + 1]); } }
    cvt_copy(p.in[I_PU] + (size_t)l * 16384 * 1024, (bf16_t*)(p.ws + WS_PU), (size_t)16384 * 1024);
    cvt_copy(p.in[I_PV] + (size_t)l * 16384 * 1024, (bf16_t*)(p.ws + WS_PV), (size_t)16384 * 1024);
}

DI void phase_norm(const Params& p, int l, int which, const float* xlat, const float* xctx, bf16_t* dst) {
    const int tid = otid(), lane = tid & 63, wid = tid >> 6;
    const float* gain = p.in[which ? I_NORM2 : I_NORM1] + l * 1024;
    const float* mod = (const float*)(p.ws + WS_MOD) + (size_t)l * 3 * 6144;
    for (int r = blockIdx.x * 8 + wid; r < NROW; r += gridDim.x * 8) {
        const float* x = r < NLAT ? xlat + (size_t)r * 1024 : xctx + (size_t)(r - NLAT) * 1024;
        const int mv = r < NLAT ? (r >> 14) : 2;
        const float* sh = mod + mv * 6144 + (which ? 3 : 0) * 1024; const float* sc = sh + 1024;
        f32x4 v[4]; float ss = 0.f;
#pragma unroll
        for (int i = 0; i < 4; ++i) { v[i] = *(const f32x4*)(x + i * 256 + lane * 4); ss += v[i][0] * v[i][0] + v[i][1] * v[i][1] + v[i][2] * v[i][2] + v[i][3] * v[i][3]; }
        ss = wave_sum(ss);
        const float rstd = rsqrtf(ss * (1.0f / 1024.0f) + EPS);
#pragma unroll
        for (int i = 0; i < 4; ++i) { const int c = i * 256 + lane * 4;
            const f32x4 g4 = *(const f32x4*)(gain + c), s4 = *(const f32x4*)(sc + c), h4 = *(const f32x4*)(sh + c);
            float y[4];
#pragma unroll
            for (int j = 0; j < 4; ++j) y[j] = v[i][j] * rstd * g4[j] * (1.0f + s4[j]) + h4[j];
            u32x2 w; w.x = pack2(y[0], y[1]); w.y = pack2(y[2], y[3]);
            *(u32x2*)(dst + (size_t)r * 1024 + c) = w; }
    }
}

DI void phase_post(const Params& p, int l, LAS unsigned char* lds) {
    const int tid = otid(), lane = tid & 63, wid = tid >> 6;
    bf16_t* proj = (bf16_t*)(p.ws + WS_PROJ);
    {
        const float gqa = p.in[I_QNA][l * 64 + lane], gka = p.in[I_KNA][l * 64 + lane], gqb = p.in[I_QNB][l * 64 + lane], gkb = p.in[I_KNB][l * 64 + lane];
        const int f = lane & 15; const bool use_col = (lane >= 32);
        const float inv = exp2f(-(float)f * (13.287712379549449f / 16.0f));
        const float sgn = (lane & 16) ? 1.0f : -1.0f;
        for (int r = blockIdx.x * 8 + wid; r < NROW; r += gridDim.x * 8) {
            bf16_t* row = proj + (size_t)r * PW;
            float cs = 1.0f, sn = 0.0f;
            const bool lat = r < NLAT;
            if (lat) { const int t = r & (S - 1); const float pos = (float)(use_col ? (t & 63) : (t >> 6)); const float ang = pos * inv;
                const float n = rintf(ang * 0.15915494309189535f); float rr = fmaf(-n, 6.28125f, ang); rr = fmaf(-n, 1.9353071795864769e-3f, rr);
                cs = __cosf(rr); sn = __sinf(rr); }
#pragma unroll 2
            for (int hd = 0; hd < 26; ++hd) {
                int col; float g; bool rope;
                if (hd < 8) { col = C_QA + hd * 64; g = gqa; rope = lat; }
                else if (hd < 10) { col = C_KA + (hd - 8) * 64; g = gka; rope = lat; }
                else if (hd < 18) { col = C_QB + (hd - 10) * 64; g = gqb; rope = false; }
                else { col = C_KB + (hd - 18) * 64; g = gkb; rope = false; }
                const float v = bf2f(row[col + lane]);
                const float ss = wave_sum(v * v);
                float y = v * rsqrtf(ss * (1.0f / 64.0f) + EPS) * g;
                if (rope) { const float yp = __shfl_xor(y, 16); y = y * cs + sgn * yp * sn; }
                row[col + lane] = f2bf(y);
            }
        }
    }
    {
        LAS bf16_t* tile = (LAS bf16_t*)lds;
        bf16_t* vt = (bf16_t*)(p.ws + WS_VT);
        const int ntl = (NROW / 64) * 26;
        for (int t = blockIdx.x; t < ntl; t += gridDim.x) {
            const int tt = t / 26, ct = t - tt * 26;
            int b, tok0, row0;
            if (tt < 512) { b = tt >> 8; tok0 = (tt & 255) * 64; row0 = b * S + tok0; }
            else { b = (tt - 512) >> 2; const int cc = (tt - 512) & 3; tok0 = S + cc * 64; row0 = NLAT + b * LC + cc * 64; }
            const int vr0 = ct * 64;
            const int scol = vr0 < 128 ? C_VA + vr0 : (vr0 < 640 ? C_VB + (vr0 - 128) : C_VC + (vr0 - 640));
            { const int rr = tid >> 3, ch = (tid & 7) * 8;
                const u32x4 w = *(const u32x4*)(proj + (size_t)(row0 + rr) * PW + scol + ch);
                *(LAS u32x4*)(tile + rr * 72 + ch) = w; }
            __syncthreads();
            { const int cc = tid >> 3, tk = (tid & 7) * 8; unsigned short v[8];
#pragma unroll
                for (int j = 0; j < 8; ++j) v[j] = tile[(tk + j) * 72 + cc];
                u32x4 w; w.x = v[0] | ((unsigned)v[1] << 16); w.y = v[2] | ((unsigned)v[3] << 16); w.z = v[4] | ((unsigned)v[5] << 16); w.w = v[6] | ((unsigned)v[7] << 16);
                *(u32x4*)(vt + ((size_t)b * VTR + vr0 + cc) * TOKB + tok0 + tk) = w; }
            __syncthreads();
        }
    }
}

struct AttnState { bf16x8 Q[2][4]; f32x16 O[2][2]; float m[2], l[2]; };
template <int MODE>
DI void attn_tile(AttnState& st, const bf16_t* krow, const bf16_t* vt0, int kpos0, int qpos0, const LAS float* brow, int g) {
    f32x16 sc[2];
    {
        bf16x8 Kf[4];
#pragma unroll
        for (int s = 0; s < 4; ++s) Kf[s] = *(const bf16x8*)(krow + 8 * s);
#pragma unroll
        for (int u = 0; u < 2; ++u) {
            sc[u] = zero16();
#pragma unroll
            for (int s = 0; s < 4; ++s) sc[u] = MFMA32(Kf[s], st.Q[u][s], sc[u]);
        }
    }
    bf16x8 Vf[2][2];
#pragma unroll
    for (int dt = 0; dt < 2; ++dt)
#pragma unroll
        for (int s = 0; s < 2; ++s) Vf[dt][s] = *(const bf16x8*)(vt0 + (size_t)dt * 32 * TOKB + 16 * s);
#pragma unroll
    for (int u = 0; u < 2; ++u) {
        const int qp = qpos0 + 32 * u;
        if (MODE == 1) {
#pragma unroll
            for (int r = 0; r < 16; ++r) { const int d = kpos0 + 16 * (r >> 3) + 8 * g + (r & 7) - qp; sc[u][r] = (d <= 128 && d >= -128) ? sc[u][r] : -INFINITY; }
        } else if (MODE == 2) {
            int cs = qp - 8; cs = cs < 0 ? 0 : (cs > 48 ? 48 : cs);
#pragma unroll
            for (int r = 0; r < 16; ++r) { const int ck = kpos0 + 16 * (r >> 3) + 8 * g + (r & 7); int di = ck - qp + 15; di = di < 0 ? 0 : (di > 30 ? 30 : di);
                const float bv = brow[di]; sc[u][r] = (ck >= cs && ck < cs + 16) ? sc[u][r] + bv : -INFINITY; }
        }
        float mx = sc[u][0];
#pragma unroll
        for (int r = 1; r < 16; ++r) mx = fmaxf(mx, sc[u][r]);
        mx = fmaxf(mx, __shfl_xor(mx, 32));
        const float mn = fmaxf(st.m[u], mx);
        const float alpha = exp2f(st.m[u] - mn);
        st.m[u] = mn;
        float rs = 0.f;
#pragma unroll
        for (int r = 0; r < 16; ++r) { const float pv = exp2f(sc[u][r] - mn); rs += pv; sc[u][r] = pv; }
        st.l[u] = st.l[u] * alpha + rs;
#pragma unroll
        for (int r = 0; r < 16; ++r) { st.O[0][u][r] *= alpha; st.O[1][u][r] *= alpha; }
        bf16x8 P[2];
#pragma unroll
        for (int s = 0; s < 2; ++s) { u32x4 w; w.x = pack2(sc[u][8 * s], sc[u][8 * s + 1]); w.y = pack2(sc[u][8 * s + 2], sc[u][8 * s + 3]); w.z = pack2(sc[u][8 * s + 4], sc[u][8 * s + 5]); w.w = pack2(sc[u][8 * s + 6], sc[u][8 * s + 7]);
            P[s] = __builtin_bit_cast(bf16x8, w); }
#pragma unroll
        for (int dt = 0; dt < 2; ++dt)
#pragma unroll
            for (int s = 0; s < 2; ++s) st.O[dt][u] = MFMA32(Vf[dt][s], P[s], st.O[dt][u]);
    }
}
DI void attn_load_q(AttnState& st, const bf16_t* proj, int qrow0, int qcol, int j, int g) {
    const float qs = 0.125f * LOG2E;
#pragma unroll
    for (int u = 0; u < 2; ++u) {
        const bf16_t* qp = proj + (size_t)(qrow0 + 32 * u + j) * PW + qcol + 32 * g;
#pragma unroll
        for (int s = 0; s < 4; ++s) { const u32x4 w = *(const u32x4*)(qp + 8 * s); u32x4 o;
            o.x = pack2(bf_lo(w.x) * qs, bf_hi(w.x) * qs); o.y = pack2(bf_lo(w.y) * qs, bf_hi(w.y) * qs); o.z = pack2(bf_lo(w.z) * qs, bf_hi(w.z) * qs); o.w = pack2(bf_lo(w.w) * qs, bf_hi(w.w) * qs);
            st.Q[u][s] = __builtin_bit_cast(bf16x8, o); }
        st.O[0][u] = zero16(); st.O[1][u] = zero16();
    }
}
DI void attn_store(const AttnState& st, bf16_t* proj, int qrow0, int ocol, int j, int g) {
#pragma unroll
    for (int u = 0; u < 2; ++u) {
        const float lt = st.l[u] + __shfl_xor(st.l[u], 32);
        const float inv = 1.0f / lt;
        bf16_t* op = proj + (size_t)(qrow0 + 32 * u + j) * PW + ocol + 4 * g;
#pragma unroll
        for (int dt = 0; dt < 2; ++dt)
#pragma unroll
            for (int q = 0; q < 4; ++q) { u32x2 w; w.x = pack2(st.O[dt][u][4 * q] * inv, st.O[dt][u][4 * q + 1] * inv); w.y = pack2(st.O[dt][u][4 * q + 2] * inv, st.O[dt][u][4 * q + 3] * inv);
                *(u32x2*)(op + 32 * dt + 8 * q) = w; }
    }
}
DI void attn_ctx_tiles(AttnState& st, const bf16_t* proj, const bf16_t* vt, int b, int kcol, int vr0, int j, int g) {
#pragma unroll 1
    for (int t = 0; t < 8; ++t) {
        const bf16_t* krow = proj + (size_t)(NLAT + b * LC + 32 * t + pi32(j)) * PW + kcol + 32 * g;
        const bf16_t* vt0 = vt + ((size_t)b * VTR + vr0 + j) * TOKB + S + 32 * t + 8 * g;
        attn_tile<0>(st, krow, vt0, 0, 0, nullptr, g);
    }
}
DI void phase_attn(const Params& p, int l, LAS unsigned char* lds) {
    const int tid = otid(), lane = tid & 63, wid = tid >> 6, j = lane & 31, g = lane >> 5;
    bf16_t* proj = (bf16_t*)(p.ws + WS_PROJ);
    const bf16_t* vt = (const bf16_t*)(p.ws + WS_VT);
    LAS float* rpb = (LAS float*)lds;
    for (int i = tid; i < 8 * 15 * 31; i += 512) rpb[i] = p.in[I_RPB][l * 3720 + i] * LOG2E;
    __syncthreads();
    const bool last = (l == DEPTH - 1);
    const int nitems = 8192 + (last ? 0 : 128);
    for (int it = blockIdx.x * 8 + wid; it < nitems; it += gridDim.x * 8) {
        AttnState st;
        if (it < 4096) {
            const int half = it & 1, hh = (it >> 1) & 7, n = (it >> 4) & 127, b = it >> 11;
            const int q0 = n * 128 + half * 64, qrow0 = b * S + q0, g2 = hh >> 2;
            attn_load_q(st, proj, qrow0, C_QA + hh * 64, j, g);
            const float sk = p.in[I_SINKA][l * 8 + hh] * LOG2E;
            st.m[0] = st.m[1] = sk; st.l[0] = st.l[1] = (g == 0) ? 1.0f : 0.0f;
            attn_ctx_tiles(st, proj, vt, b, C_KA + g2 * 64, g2 * 64, j, g);
            const int t_lo = half ? 2 : 0, t_hi = half ? 12 : 10;
#pragma unroll 1
            for (int t = t_lo; t < t_hi; ++t) {
                const int kp0 = (n - 1) * 128 + 32 * t;
                if (kp0 < 0 || kp0 >= S) continue;
                const bf16_t* krow = proj + (size_t)(b * S + kp0 + pi32(j)) * PW + C_KA + g2 * 64 + 32 * g;
                const bf16_t* vt0 = vt + ((size_t)b * VTR + g2 * 64 + j) * TOKB + kp0 + 8 * g;
                attn_tile<1>(st, krow, vt0, kp0, q0 + j, nullptr, g);
            }
            attn_store(st, proj, qrow0, C_QA + hh * 64, j, g);
        } else if (it < 8192) {
            const int i2 = it - 4096, h = i2 & 7, r = (i2 >> 3) & 255, b = i2 >> 11;
            const int qrow0 = b * S + r * 64;
            attn_load_q(st, proj, qrow0, C_QB + h * 64, j, g);
            st.m[0] = st.m[1] = -INFINITY; st.l[0] = st.l[1] = 0.f;
            attn_ctx_tiles(st, proj, vt, b, C_KB + h * 64, 128 + h * 64, j, g);
            int rs = r - 4; rs = rs < 0 ? 0 : (rs > 248 ? 248 : rs);
#pragma unroll 1
            for (int t = 0; t < 16; ++t) {
                const int kr = rs + (t >> 1), c0 = (t & 1) * 32;
                const bf16_t* krow = proj + (size_t)(b * S + kr * 64 + c0 + pi32(j)) * PW + C_KB + h * 64 + 32 * g;
                const bf16_t* vt0 = vt + ((size_t)b * VTR + 128 + h * 64 + j) * TOKB + kr * 64 + c0 + 8 * g;
                attn_tile<2>(st, krow, vt0, c0, j, rpb + (h * 15 + (kr - r + 7)) * 31, g);
            }
            attn_store(st, proj, qrow0, C_QB + h * 64, j, g);
        } else {
            const int i2 = it - 8192, qt = i2 & 3, h = (i2 >> 2) & 7, b = (i2 >> 5) & 1, mixer = i2 >> 6;
            const int qrow0 = NLAT + b * LC + qt * 64;
            if (mixer == 0) {
                attn_load_q(st, proj, qrow0, C_QA + h * 64, j, g);
                const float sk = p.in[I_SINKA][l * 8 + h] * LOG2E;
                st.m[0] = st.m[1] = sk; st.l[0] = st.l[1] = (g == 0) ? 1.0f : 0.0f;
                attn_ctx_tiles(st, proj, vt, b, C_KA + (h >> 2) * 64, (h >> 2) * 64, j, g);
                attn_store(st, proj, qrow0, C_QA + h * 64, j, g);
            } else {
                attn_load_q(st, proj, qrow0, C_QB + h * 64, j, g);
                st.m[0] = st.m[1] = -INFINITY; st.l[0] = st.l[1] = 0.f;
                attn_ctx_tiles(st, proj, vt, b, C_KB + h * 64, 128 + h * 64, j, g);
                attn_store(st, proj, qrow0, C_QB + h * 64, j, g);
            }
        }
    }
}

DI void gla_chunk_rows(int b, int ci, int& row0, int& tok0) {
    if (ci < 256) { tok0 = ci * 64; row0 = b * S + tok0; } else { const int cc = ci - 256; tok0 = S + cc * 64; row0 = NLAT + b * LC + cc * 64; }
}
constexpr int GL_A = 0;
constexpr int GL_W = 8192;
constexpr int GL_B = 24576;
constexpr int GL_SSQ = 25600;
constexpr int GL_LA = 32768;
constexpr int GL_QH = 65536;
constexpr int GL_KT = 81920;
constexpr int GL_ATT = GL_LA;
DI void gla_stage_gate(const Params& p, int l, const bf16_t* proj, int row0, int h, LAS unsigned char* lds) {
    const int tid = otid();
    LAS float* a_s = (LAS float*)(lds + GL_A); LAS float* w_s = (LAS float*)(lds + GL_W); LAS float* b_s = (LAS float*)(lds + GL_B);
    if (tid < 256) { const int tok = tid >> 2, c8 = (tid & 3) * 8; const u32x4 w = *(const u32x4*)(proj + (size_t)(row0 + tok) * PW + C_AC + c8);
        LAS float* d = a_s + tok * 32 + c8; d[0] = bf_lo(w.x); d[1] = bf_hi(w.x); d[2] = bf_lo(w.y); d[3] = bf_hi(w.y); d[4] = bf_lo(w.z); d[5] = bf_hi(w.z); d[6] = bf_lo(w.w); d[7] = bf_hi(w.w); }
#pragma unroll
    for (int q = 0; q < 8; ++q) { const int i = tid + q * 512, dir = i >> 11, rr = (i >> 7) & 15, ch = i & 127;
        w_s[i] = p.in[dir ? I_WA2B : I_WA2F][(size_t)l * 16 * 512 + rr * 512 + h * 128 + ch]; }
    if (tid < 256) { const int dir = tid >> 7, ch = tid & 127; b_s[tid] = p.in[dir ? I_BAB : I_BAF][l * 512 + h * 128 + ch]; }
}
DI void gla_logdecay(int dir, LAS unsigned char* lds) {
    const int tid = otid();
    const LAS float* a_s = (const LAS float*)(lds + GL_A); const LAS float* w_s = (const LAS float*)(lds + GL_W) + dir * 2048; const LAS float* b_s = (const LAS float*)(lds + GL_B) + dir * 128;
    LAS float* la = (LAS float*)(lds + GL_LA);
    { const int ch = tid & 127, tq = tid >> 7; float w[16];
#pragma unroll
        for (int i = 0; i < 16; ++i) w[i] = w_s[i * 128 + ch];
        const float bb = b_s[ch];
        for (int t = 0; t < 16; ++t) { const int tok = tq * 16 + t; float z = bb;
#pragma unroll
            for (int i = 0; i < 16; ++i) z += a_s[tok * 32 + dir * 16 + i] * w[i];
            la[tok * 128 + ch] = (fminf(z, 0.f) - __logf(1.0f + __expf(-fabsf(z)))) * (1.0f / 16.0f); } }
    __syncthreads();
    if (tid < 128) { float run = 0.f;
        if (dir == 0) { for (int t = 0; t < 64; ++t) { run += la[t * 128 + tid]; la[t * 128 + tid] = run; } }
        else { for (int t = 63; t >= 0; --t) { run += la[t * 128 + tid]; la[t * 128 + tid] = run; } } }
    __syncthreads();
}
DI void phase_gla1(const Params& p, int l, LAS unsigned char* lds) {
    const int tid = otid(), lane = tid & 63, wid = tid >> 6, j = lane & 31, g = lane >> 5;
    const bf16_t* proj = (const bf16_t*)(p.ws + WS_PROJ);
    const bf16_t* vt = (const bf16_t*)(p.ws + WS_VT);
    bf16_t* stt = (bf16_t*)(p.ws + WS_ST); float* dec = (float*)(p.ws + WS_DEC);
    const LAS float* la = (const LAS float*)(lds + GL_LA);
    LAS bf16_t* ktT = (LAS bf16_t*)(lds + GL_QH);
    for (int un = blockIdx.x; un < NB * NCH * 4; un += gridDim.x) {
        const int h = un & 3, ci = (un >> 2) % NCH, b = (un >> 2) / NCH;
        int row0, tok0; gla_chunk_rows(b, ci, row0, tok0);
        gla_stage_gate(p, l, proj, row0, h, lds);
        bf16x8 Vf[4];
#pragma unroll
        for (int s = 0; s < 4; ++s) Vf[s] = *(const bf16x8*)(vt + ((size_t)b * VTR + 640 + h * 256 + 32 * wid + j) * TOKB + tok0 + 16 * s + 8 * g);
        __syncthreads();
        for (int dir = 0; dir < 2; ++dir) {
            gla_logdecay(dir, lds);
            const int chain = (b * 4 + h) * 2 + dir;
            { const int tok = tid >> 3, cc = (tid & 7) * 16;
                const u32x4 k0 = *(const u32x4*)(proj + (size_t)(row0 + tok) * PW + C_KC + h * 128 + cc), k1 = *(const u32x4*)(proj + (size_t)(row0 + tok) * PW + C_KC + h * 128 + cc + 8);
                const unsigned kw[8] = {k0.x, k0.y, k0.z, k0.w, k1.x, k1.y, k1.z, k1.w};
                const int te = dir ? 0 : 63;
#pragma unroll
                for (int q = 0; q < 8; ++q) { const int ch = cc + 2 * q;
                    const float w0 = __expf(la[te * 128 + ch] - la[tok * 128 + ch]), w1 = __expf(la[te * 128 + ch + 1] - la[tok * 128 + ch + 1]);
                    ktT[ch * 72 + tok] = f2bf(bf_lo(kw[q]) * w0); ktT[(ch + 1) * 72 + tok] = f2bf(bf_hi(kw[q]) * w1); } }
            if (tid < 128) dec[((size_t)chain * NCH + ci) * 128 + tid] = __expf(la[(dir ? 0 : 63) * 128 + tid]);
            __syncthreads();
            bf16_t* so = stt + ((size_t)chain * NCH + ci) * 32768 + (size_t)(32 * wid + j) * 128 + 4 * g;
#pragma unroll
            for (int dk = 0; dk < 4; ++dk) {
                f32x16 acc = zero16();
#pragma unroll
                for (int s = 0; s < 4; ++s) { const bf16x8 Af = *(const LAS bf16x8*)(ktT + (32 * dk + j) * 72 + 16 * s + 8 * g); acc = MFMA32(Af, Vf[s], acc); }
#pragma unroll
                for (int q = 0; q < 4; ++q) { u32x2 w; w.x = pack2(acc[4 * q], acc[4 * q + 1]); w.y = pack2(acc[4 * q + 2], acc[4 * q + 3]); *(u32x2*)(so + 32 * dk + 8 * q) = w; }
            }
            __syncthreads();
        }
    }
}
DI void phase_gla2(const Params& p) {
    bf16_t* stt = (bf16_t*)(p.ws + WS_ST); const float* dec = (const float*)(p.ws + WS_DEC);
    for (int gt = blockIdx.x * 512 + otid(); gt < 16 * 8192; gt += gridDim.x * 512) {
        const int chain = gt >> 13, e = gt & 8191, dv = e >> 5, dk0 = (e & 31) * 4, dir = chain & 1;
        bf16_t* base = stt + (size_t)chain * NCH * 32768 + dv * 128 + dk0;
        const float* dbase = dec + (size_t)chain * NCH * 128 + dk0;
        float s0 = 0.f, s1 = 0.f, s2 = 0.f, s3 = 0.f;
        for (int st = 0; st < NCH; st += 4) {
            u32x2 dS[4]; f32x4 dd[4]; int ci[4];
#pragma unroll
            for (int q = 0; q < 4; ++q) { const int step = st + q; ci[q] = dir ? (NCH - 1 - step) : (step < 4 ? 256 + step : step - 4);
                dS[q] = *(const u32x2*)(base + (size_t)ci[q] * 32768); dd[q] = *(const f32x4*)(dbase + (size_t)ci[q] * 128); }
#pragma unroll
            for (int q = 0; q < 4; ++q) {
                u32x2 w; w.x = pack2(s0, s1); w.y = pack2(s2, s3);
                *(u32x2*)(base + (size_t)ci[q] * 32768) = w;
                s0 = dd[q][0] * s0 + bf_lo(dS[q].x); s1 = dd[q][1] * s1 + bf_hi(dS[q].x); s2 = dd[q][2] * s2 + bf_lo(dS[q].y); s3 = dd[q][3] * s3 + bf_hi(dS[q].y);
            }
        }
    }
}
DI int gl_swz(int tok, int chunk) { return tok * 256 + ((chunk ^ (tok & 15)) << 4); }
template <int DIR>
DI void gla3_dir(const Params& p, LAS unsigned char* lds, const bf16_t* proj, int row0, int h, const bf16_t* state, const bf16x8 (&Vf)[2][2], f32x16 (&O)[2]) {
    const int tid = otid(), lane = tid & 63, wid = tid >> 6, j = lane & 31, g = lane >> 5;
    gla_logdecay(DIR, lds);
    const LAS float* la = (const LAS float*)(lds + GL_LA);
    { const int tok = tid >> 3, cc = (tid & 7) * 16;
        const bf16_t* rp = proj + (size_t)(row0 + tok) * PW + h * 128 + cc;
        const u32x4 q0 = *(const u32x4*)(rp + C_QC), q1 = *(const u32x4*)(rp + C_QC + 8), k0 = *(const u32x4*)(rp + C_KC), k1 = *(const u32x4*)(rp + C_KC + 8);
        const unsigned qw[8] = {q0.x, q0.y, q0.z, q0.w, q1.x, q1.y, q1.z, q1.w}, kw[8] = {k0.x, k0.y, k0.z, k0.w, k1.x, k1.y, k1.z, k1.w};
        unsigned qo[8], ko[8];
#pragma unroll
        for (int q = 0; q < 8; ++q) { const float b0 = la[tok * 128 + cc + 2 * q], b1 = la[tok * 128 + cc + 2 * q + 1];
            qo[q] = pack2(bf_lo(qw[q]) * 0.08838834764831845f * __expf(b0), bf_hi(qw[q]) * 0.08838834764831845f * __expf(b1));
            ko[q] = pack2(bf_lo(kw[q]) * __expf(-b0), bf_hi(kw[q]) * __expf(-b1)); }
        const int c0 = (tid & 7) * 2;
        *(LAS u32x4*)(lds + GL_QH + gl_swz(tok, c0)) = (u32x4){qo[0], qo[1], qo[2], qo[3]}; *(LAS u32x4*)(lds + GL_QH + gl_swz(tok, c0 + 1)) = (u32x4){qo[4], qo[5], qo[6], qo[7]};
        *(LAS u32x4*)(lds + GL_KT + gl_swz(tok, c0)) = (u32x4){ko[0], ko[1], ko[2], ko[3]}; *(LAS u32x4*)(lds + GL_KT + gl_swz(tok, c0 + 1)) = (u32x4){ko[4], ko[5], ko[6], ko[7]}; }
    __syncthreads();
    if (wid < 4) {
        const int tj = wid >> 1, ti = wid & 1;
        const bool skip = DIR == 0 ? (tj > ti) : (tj < ti);
        if (!skip) {
            f32x16 acc = zero16();
            const int ktok = 32 * tj + pi32(j), qtok = 32 * ti + j;
#pragma unroll
            for (int s = 0; s < 8; ++s) { const bf16x8 Af = *(const LAS bf16x8*)(lds + GL_KT + gl_swz(ktok, 2 * s + g)), Bf = *(const LAS bf16x8*)(lds + GL_QH + gl_swz(qtok, 2 * s + g)); acc = MFMA32(Af, Bf, acc); }
#pragma unroll
            for (int r = 0; r < 16; ++r) { const int kt = 32 * tj + 16 * (r >> 3) + 8 * g + (r & 7); const bool keep = DIR == 0 ? (kt <= qtok) : (kt >= qtok); acc[r] = keep ? acc[r] : 0.f; }
            asm volatile("s_waitcnt lgkmcnt(0)" ::: "memory");
#pragma unroll
            for (int s = 0; s < 2; ++s) { u32x4 w; w.x = pack2(acc[8 * s], acc[8 * s + 1]); w.y = pack2(acc[8 * s + 2], acc[8 * s + 3]); w.z = pack2(acc[8 * s + 4], acc[8 * s + 5]); w.w = pack2(acc[8 * s + 6], acc[8 * s + 7]);
                *(LAS u32x4*)(lds + GL_ATT + ((wid * 2 + s) * 64 + lane) * 16) = w; }
        }
    }
    bf16x8 Sf[8];
#pragma unroll
    for (int s = 0; s < 8; ++s) Sf[s] = *(const bf16x8*)(state + (size_t)(32 * wid + j) * 128 + 16 * s + 8 * g);
    __syncthreads();
#pragma unroll
    for (int ti = 0; ti < 2; ++ti) {
#pragma unroll
        for (int tj = 0; tj < 2; ++tj) {
            const bool skip = DIR == 0 ? (tj > ti) : (tj < ti);
            if (!skip) {
#pragma unroll
                for (int s = 0; s < 2; ++s) { const bf16x8 Bf = *(const LAS bf16x8*)(lds + GL_ATT + (((tj * 2 + ti) * 2 + s) * 64 + lane) * 16); O[ti] = MFMA32(Vf[tj][s], Bf, O[ti]); }
            }
        }
#pragma unroll
        for (int s = 0; s < 8; ++s) { const bf16x8 Bf = *(const LAS bf16x8*)(lds + GL_QH + gl_swz(32 * ti + j, 2 * s + g)); O[ti] = MFMA32(Sf[s], Bf, O[ti]); }
    }
    __syncthreads();
}
DI void phase_gla3(const Params& p, int l, LAS unsigned char* lds) {
    const int tid = otid(), lane = tid & 63, wid = tid >> 6, j = lane & 31, g = lane >> 5;
    bf16_t* proj = (bf16_t*)(p.ws + WS_PROJ);
    const bf16_t* vt = (const bf16_t*)(p.ws + WS_VT);
    const bf16_t* stt = (const bf16_t*)(p.ws + WS_ST);
    LAS float* ssq = (LAS float*)(lds + GL_SSQ);
    const bool last = (l == DEPTH - 1);
    for (int un = blockIdx.x; un < NB * NCH * 4; un += gridDim.x) {
        const int h = un & 3, ci = (un >> 2) % NCH, b = (un >> 2) / NCH;
        if (last && ci >= 256) continue;
        int row0, tok0; gla_chunk_rows(b, ci, row0, tok0);
        gla_stage_gate(p, l, proj, row0, h, lds);
        bf16x8 Vf[2][2];
#pragma unroll
        for (int tj = 0; tj < 2; ++tj)
#pragma unroll
            for (int s = 0; s < 2; ++s) Vf[tj][s] = *(const bf16x8*)(vt + ((size_t)b * VTR + 640 + h * 256 + 32 * wid + j) * TOKB + tok0 + 32 * tj + 16 * s + 8 * g);
        f32x16 O[2]; O[0] = zero16(); O[1] = zero16();
        __syncthreads();
        const size_t chain0 = (size_t)(b * 4 + h) * 2;
        gla3_dir<0>(p, lds, proj, row0, h, stt + ((chain0 + 0) * NCH + ci) * 32768, Vf, O);
        gla3_dir<1>(p, lds, proj, row0, h, stt + ((chain0 + 1) * NCH + ci) * 32768, Vf, O);
#pragma unroll
        for (int ti = 0; ti < 2; ++ti) { float s = 0.f;
#pragma unroll
            for (int r = 0; r < 16; ++r) s += O[ti][r] * O[ti][r];
            s += __shfl_xor(s, 32);
            if (g == 0) ssq[(32 * ti + j) * 8 + wid] = s; }
        __syncthreads();
        const float* gn = p.in[I_GNC] + l * 256;
#pragma unroll
        for (int ti = 0; ti < 2; ++ti) {
            float tot = 0.f;
#pragma unroll
            for (int w = 0; w < 8; ++w) tot += ssq[(32 * ti + j) * 8 + w];
            const float rstd = rsqrtf(tot * (1.0f / 256.0f) + EPS);
            bf16_t* rp = proj + (size_t)(row0 + 32 * ti + j) * PW + C_RC + h * 256 + 32 * wid + 4 * g;
#pragma unroll
            for (int q = 0; q < 4; ++q) {
                const u32x2 rw = *(const u32x2*)(rp + 8 * q);
                const f32x4 gv = *(const f32x4*)(gn + 32 * wid + 8 * q + 4 * g);
                const float r0 = bf_lo(rw.x), r1 = bf_hi(rw.x), r2 = bf_lo(rw.y), r3 = bf_hi(rw.y);
                const float y0 = O[ti][4 * q] * rstd * gv[0] * r0 * sigmoidf_(r0), y1 = O[ti][4 * q + 1] * rstd * gv[1] * r1 * sigmoidf_(r1);
                const float y2 = O[ti][4 * q + 2] * rstd * gv[2] * r2 * sigmoidf_(r2), y3 = O[ti][4 * q + 3] * rstd * gv[3] * r3 * sigmoidf_(r3);
                u32x2 w; w.x = pack2(y0, y1); w.y = pack2(y2, y3);
                *(u32x2*)(rp + 8 * q) = w;
            }
        }
        __syncthreads();
    }
}

#define CE_DESC(a, b) do { const float _hi = fmaxf(a, b), _lo = fminf(a, b); a = _hi; b = _lo; } while (0)
template <int N> DI void sort_desc(float (&v)[N]) {
#pragma unroll
    for (int k = 2; k <= N; k <<= 1)
#pragma unroll
        for (int jj = k >> 1; jj > 0; jj >>= 1)
#pragma unroll
            for (int i = 0; i < N; ++i) { const int x = i ^ jj; if (x > i) { if ((i & k) == 0) CE_DESC(v[i], v[x]); else CE_DESC(v[x], v[i]); } }
}
DI void merge_top16(float (&a)[16], const float (&b)[16]) {
#pragma unroll
    for (int i = 0; i < 16; ++i) a[i] = fmaxf(a[i], b[15 - i]);
#pragma unroll
    for (int jj = 8; jj > 0; jj >>= 1)
#pragma unroll
        for (int i = 0; i < 16; ++i) { const int x = i ^ jj; if (x > i) CE_DESC(a[i], a[x]); }
}
DI void merge_partner16(float (&a)[16]) {
    float b[16];
#pragma unroll
    for (int i = 0; i < 16; ++i) b[i] = __shfl_xor(a[i], 32);
    merge_top16(a, b);
}
DI void top16_of_64(float (&v)[64], float (&o)[16]) {
    float a[16], b[16];
#pragma unroll
    for (int i = 0; i < 16; ++i) { a[i] = v[i]; b[i] = v[16 + i]; }
    sort_desc<16>(a); sort_desc<16>(b); merge_top16(a, b);
#pragma unroll
    for (int i = 0; i < 16; ++i) { o[i] = v[32 + i]; b[i] = v[48 + i]; }
    sort_desc<16>(o); sort_desc<16>(b); merge_top16(o, b);
    merge_top16(o, a);
}
DI float bsel(int c, float a, float b) { const unsigned m = (unsigned)-(c != 0); return __uint_as_float((__float_as_uint(a) & m) | (__float_as_uint(b) & ~m)); }
DI float set_low(float f, unsigned mask, unsigned val) { return __uint_as_float((__float_as_uint(f) & ~mask) | val); }

DI void phase_peer_select(const Params& p, LAS unsigned char* lds) {
    const int tid = otid(), lane = tid & 63, wid = tid >> 6, j = lane & 31, g = lane >> 5;
    const bf16_t* pq = (const bf16_t*)(p.ws + WS_PQ);
    const bf16_t* subk = (const bf16_t*)(p.ws + WS_SUBK);
    int* pidx = (int*)(p.ws + WS_PIDX); float* pgw = (float*)(p.ws + WS_PG);
    LAS unsigned* tab = (LAS unsigned*)lds + wid * 2048;
    for (int it = blockIdx.x * 8 + wid; it < (NROW / 32) * 8; it += gridDim.x * 8) {
        const int ph = it & 7, r0 = (it >> 3) * 32;
        float top[2][16];
#pragma unroll
        for (int half = 0; half < 2; ++half) {
            bf16x8 Bq[8]; float ss = 0.f;
            const bf16_t* qp = pq + (size_t)(r0 + j) * 2048 + ph * 256 + half * 128 + 8 * g;
#pragma unroll
            for (int s = 0; s < 8; ++s) { const u32x4 w = *(const u32x4*)(qp + 16 * s); Bq[s] = __builtin_bit_cast(bf16x8, w);
                const float e0 = bf_lo(w.x), e1 = bf_hi(w.x), e2 = bf_lo(w.y), e3 = bf_hi(w.y), e4 = bf_lo(w.z), e5 = bf_hi(w.z), e6 = bf_lo(w.w), e7 = bf_hi(w.w);
                ss += e0 * e0 + e1 * e1 + e2 * e2 + e3 * e3 + e4 * e4 + e5 * e5 + e6 * e6 + e7 * e7; }
            ss += __shfl_xor(ss, 32);
            const float rstd = rsqrtf(ss * (1.0f / 128.0f) + EPS);
            const bf16_t* kp = subk + (size_t)((ph * 2 + half) * 128 + j) * 128 + 8 * g;
#pragma unroll
            for (int r = 0; r < 16; ++r) top[half][r] = -INFINITY;
#pragma unroll 1
            for (int kt = 0; kt < 4; ++kt) {
                f32x16 acc = zero16();
#pragma unroll
                for (int s = 0; s < 8; ++s) { const bf16x8 Af = *(const bf16x8*)(kp + (size_t)kt * 32 * 128 + 16 * s); acc = MFMA32(Af, Bq[s], acc); }
                float sc[16];
#pragma unroll
                for (int r = 0; r < 16; ++r) sc[r] = set_low(acc[r] * rstd, 127u, (unsigned)(32 * kt + (r & 3) + 8 * (r >> 2) + 4 * g));
                sort_desc<16>(sc);
                merge_top16(top[half], sc);
            }
            __builtin_amdgcn_sched_barrier(0);
            merge_partner16(top[half]);
        }
        float va[16], vb[16];
#pragma unroll
        for (int i = 0; i < 16; ++i) { va[i] = set_low(top[0][i], 127u, 0u); vb[i] = set_low(top[1][i], 127u, 0u);
            tab[i * 64 + lane] = __float_as_uint(top[0][i]) & 127u; tab[(16 + i) * 64 + lane] = __float_as_uint(top[1][i]) & 127u; }
        float cand[32];
#pragma unroll
        for (int i = 0; i < 27; ++i) {
            const int a = i < 16 ? 0 : (i < 23 ? 1 : (i < 26 ? 2 : 3));
            const int bb = i < 16 ? i : (i < 23 ? i - 15 : (i < 26 ? i - 21 : 3));
            const float s0 = va[a] + vb[bb], s1 = va[bb] + vb[a];
            float c = g ? s1 : s0;
            c = set_low(c, 255u, g ? (unsigned)(bb * 16 + a) : (unsigned)(a * 16 + bb));
            if (a == bb) c = g ? -INFINITY : c;
            cand[i] = c;
        }
#pragma unroll
        for (int i = 27; i < 32; ++i) cand[i] = -INFINITY;
        float ca[16], cb[16];
#pragma unroll
        for (int i = 0; i < 16; ++i) { ca[i] = cand[i]; cb[i] = cand[16 + i]; }
        sort_desc<16>(ca); sort_desc<16>(cb); merge_top16(ca, cb);
        merge_partner16(ca);
        const float mx = set_low(ca[0], 255u, 0u);
        float ev[16], sum = 0.f;
#pragma unroll
        for (int i = 0; i < 16; ++i) { ev[i] = __expf(set_low(ca[i], 255u, 0u) - mx); sum += ev[i]; }
        const float inv = 1.0f / sum;
        const size_t ob = (size_t)(r0 + j) * 128 + ph * 16 + 8 * g;
#pragma unroll
        for (int k = 0; k < 8; ++k) {
            const float cv = bsel(g, ca[8 + k], ca[k]); const float e = bsel(g, ev[8 + k], ev[k]);
            const unsigned pos = __float_as_uint(cv) & 255u;
            const unsigned i1 = tab[(pos >> 4) * 64 + lane], i2 = tab[(16 + (pos & 15)) * 64 + lane];
            pidx[ob + k] = (int)(i1 * 128u + i2); pgw[ob + k] = e * inv;
        }
    }
}

DI void phase_peer_gather(const Params& p, int l, const float* xin_lat, const float* xin_ctx, float* xo_lat, float* xo_ctx) {
    const int tid = otid(), lane = tid & 63, wid = tid >> 6;
    const bf16_t* h2 = (const bf16_t*)(p.ws + WS_H2);
    const bf16_t* pu = (const bf16_t*)(p.ws + WS_PU); const bf16_t* pv = (const bf16_t*)(p.ws + WS_PV);
    const int* pidx = (const int*)(p.ws + WS_PIDX); const float* pgw = (const float*)(p.ws + WS_PG);
    const float* mod = (const float*)(p.ws + WS_MOD) + (size_t)l * 3 * 6144;
    const bool last = (l == DEPTH - 1);
    const int nrows = last ? NLAT : NROW;
    const int kL = ((lane >> 5) & 1) * 8 + ((lane >> 4) & 1) * 4 + ((lane >> 3) & 1) * 2 + ((lane >> 2) & 1);
    for (int r = blockIdx.x * 8 + wid; r < nrows; r += gridDim.x * 8) {
        const u32x4 ha = *(const u32x4*)(h2 + (size_t)r * 1024 + 8 * lane), hb = *(const u32x4*)(h2 + (size_t)r * 1024 + 512 + 8 * lane);
        float hv[16];
        hv[0] = bf_lo(ha.x); hv[1] = bf_hi(ha.x); hv[2] = bf_lo(ha.y); hv[3] = bf_hi(ha.y); hv[4] = bf_lo(ha.z); hv[5] = bf_hi(ha.z); hv[6] = bf_lo(ha.w); hv[7] = bf_hi(ha.w);
        hv[8] = bf_lo(hb.x); hv[9] = bf_hi(hb.x); hv[10] = bf_lo(hb.y); hv[11] = bf_hi(hb.y); hv[12] = bf_lo(hb.z); hv[13] = bf_hi(hb.z); hv[14] = bf_lo(hb.w); hv[15] = bf_hi(hb.w);
        float out[16];
#pragma unroll
        for (int i = 0; i < 16; ++i) out[i] = 0.f;
        for (int ph = 0; ph < 8; ++ph) {
            const int my_idx = pidx[(size_t)r * 128 + ph * 16 + (lane & 15)];
            const float my_g = pgw[(size_t)r * 128 + ph * 16 + (lane & 15)];
            float d[16];
#pragma unroll
            for (int k = 0; k < 16; ++k) {
                const int e = __builtin_amdgcn_readlane(my_idx, k);
                const bf16_t* ub = pu + (size_t)e * 1024 + 8 * lane;
                const u32x4 ua = *(const u32x4*)ub, uc = *(const u32x4*)(ub + 512);
                float s = bf_lo(ua.x) * hv[0];
                s = fmaf(bf_hi(ua.x), hv[1], s); s = fmaf(bf_lo(ua.y), hv[2], s); s = fmaf(bf_hi(ua.y), hv[3], s); s = fmaf(bf_lo(ua.z), hv[4], s); s = fmaf(bf_hi(ua.z), hv[5], s);
                s = fmaf(bf_lo(ua.w), hv[6], s); s = fmaf(bf_hi(ua.w), hv[7], s); s = fmaf(bf_lo(uc.x), hv[8], s); s = fmaf(bf_hi(uc.x), hv[9], s); s = fmaf(bf_lo(uc.y), hv[10], s);
                s = fmaf(bf_hi(uc.y), hv[11], s); s = fmaf(bf_lo(uc.z), hv[12], s); s = fmaf(bf_hi(uc.z), hv[13], s); s = fmaf(bf_lo(uc.w), hv[14], s); s = fmaf(bf_hi(uc.w), hv[15], s);
                d[k] = s;
            }
            float t8[8], t4[4], t2[2], t1;
            { const bool up = (lane & 32) != 0;
#pragma unroll
                for (int k = 0; k < 8; ++k) { const float keep = up ? d[k + 8] : d[k], send = up ? d[k] : d[k + 8]; t8[k] = keep + __shfl_xor(send, 32); } }
            { const bool up = (lane & 16) != 0;
#pragma unroll
                for (int k = 0; k < 4; ++k) { const float keep = up ? t8[k + 4] : t8[k], send = up ? t8[k] : t8[k + 4]; t4[k] = keep + __shfl_xor(send, 16); } }
            { const bool up = (lane & 8) != 0;
#pragma unroll
                for (int k = 0; k < 2; ++k) { const float keep = up ? t4[k + 2] : t4[k], send = up ? t4[k] : t4[k + 2]; t2[k] = keep + __shfl_xor(send, 8); } }
            { const bool up = (lane & 4) != 0; const float keep = up ? t2[1] : t2[0], send = up ? t2[0] : t2[1]; t1 = keep + __shfl_xor(send, 4); }
            t1 += __shfl_xor(t1, 2); t1 += __shfl_xor(t1, 1);
            const float gk = __shfl(my_g, kL);
            const float wv = gk * 0.5f * t1 * (1.0f + erff(t1 * 0.70710678118654752f));
#pragma unroll
            for (int k = 0; k < 16; ++k) {
                const int e = __builtin_amdgcn_readlane(my_idx, k);
                const int src = ((k >> 3) & 1) * 32 + ((k >> 2) & 1) * 16 + ((k >> 1) & 1) * 8 + (k & 1) * 4;
                const float w = __uint_as_float((unsigned)__builtin_amdgcn_readlane((int)__float_as_uint(wv), src));
                const bf16_t* vb = pv + (size_t)e * 1024 + 8 * lane;
                const u32x4 ua = *(const u32x4*)vb, uc = *(const u32x4*)(vb + 512);
                out[0] = fmaf(w, bf_lo(ua.x), out[0]); out[1] = fmaf(w, bf_hi(ua.x), out[1]); out[2] = fmaf(w, bf_lo(ua.y), out[2]); out[3] = fmaf(w, bf_hi(ua.y), out[3]);
                out[4] = fmaf(w, bf_lo(ua.z), out[4]); out[5] = fmaf(w, bf_hi(ua.z), out[5]); out[6] = fmaf(w, bf_lo(ua.w), out[6]); out[7] = fmaf(w, bf_hi(ua.w), out[7]);
                out[8] = fmaf(w, bf_lo(uc.x), out[8]); out[9] = fmaf(w, bf_hi(uc.x), out[9]); out[10] = fmaf(w, bf_lo(uc.y), out[10]); out[11] = fmaf(w, bf_hi(uc.y), out[11]);
                out[12] = fmaf(w, bf_lo(uc.z), out[12]); out[13] = fmaf(w, bf_hi(uc.z), out[13]); out[14] = fmaf(w, bf_lo(uc.w), out[14]); out[15] = fmaf(w, bf_hi(uc.w), out[15]);
            }
        }
        if (DBG_ZERO & 8) {
#pragma unroll
            for (int i = 0; i < 16; ++i) out[i] = 0.f; }
        const bool lat = r < NLAT;
        const int mv = lat ? (r >> 14) : 2;
        const float* g2 = mod + mv * 6144 + 5 * 1024;
        const float* xi = lat ? xin_lat + (size_t)r * 1024 : xin_ctx + (size_t)(r - NLAT) * 1024;
        float* xo = lat ? xo_lat + (size_t)r * 1024 : xo_ctx + (size_t)(r - NLAT) * 1024;
#pragma unroll
        for (int hf = 0; hf < 2; ++hf)
#pragma unroll
            for (int q = 0; q < 2; ++q) { const int c = hf * 512 + 8 * lane + 4 * q;
                const f32x4 xv = *(const f32x4*)(xi + c), gv = *(const f32x4*)(g2 + c);
                f32x4 o; o[0] = xv[0] + gv[0] * out[hf * 8 + 4 * q]; o[1] = xv[1] + gv[1] * out[hf * 8 + 4 * q + 1]; o[2] = xv[2] + gv[2] * out[hf * 8 + 4 * q + 2]; o[3] = xv[3] + gv[3] * out[hf * 8 + 4 * q + 3];
                *(f32x4*)(xo + c) = o; }
    }
}

__global__ void __launch_bounds__(512, 2) hybrid_fwd(Params p) {
    extern __shared__ __attribute__((aligned(16))) unsigned char lds_raw[];
    LAS unsigned char* lds = (LAS unsigned char*)lds_raw;
    if (threadIdx.x == 0) *(LAS u32x4*)(lds + LDS_BARW) = (u32x4){0u, 0u, 0u, 0u};
    __syncthreads();
    XcdBarrier bar; bar.bar = (unsigned*)(p.ws + WS_CTL); bar.x = 0; bar.st = (volatile LAS unsigned*)(lds + LDS_BARW);
    if (p.use_bar) bar = xcd_barrier_post((unsigned*)(p.ws + WS_CTL), (volatile LAS unsigned*)(lds + LDS_BARW));
#define IN(ph) ((ph) >= p.gp_lo && (ph) < p.gp_hi)
#define SEAM() do { if (p.use_bar) xcd_barrier(bar); else __syncthreads(); } while (0)
    bf16_t* proj = (bf16_t*)(p.ws + WS_PROJ);
    float* ctxr = (float*)(p.ws + WS_CTX);
    if (IN(0)) { phase_mod(p, (LAS float*)lds); SEAM(); }
    for (int l = 0; l < DEPTH; ++l) {
        const int gb = 1 + l * NPH;
        const float* xin_lat = l == 0 ? p.in[I_X] : p.out;
        const float* xin_ctx = l == 0 ? p.in[I_CTX] : ctxr;
        if (IN(gb + 0)) { phase_convert(p, l, (LAS float*)lds); phase_norm(p, l, 0, xin_lat, xin_ctx, (bf16_t*)(p.ws + WS_H)); SEAM(); }
        if (IN(gb + 1)) {
            pg8::Gemm g{}; g.A = (const bf16_t*)(p.ws + WS_H); g.Bt = (const bf16_t*)(p.ws + WS_WIN); g.lda = 1024; g.ldb = 1024; g.K = 1024; g.bseg = 0;
            pg8::Order<1> so; so.init(NROW, 8704, gridDim.x, blockIdx.x);
            pg8::EpiBf16 e; e.O = proj; e.ldc = PW; e.ncols = PW;
            pg8::gemm_phase(lds, g, so, e); SEAM();
        }
        if (IN(gb + 2)) { phase_post(p, l, lds); SEAM(); }
        if (IN(gb + 3)) { phase_attn(p, l, lds); __syncthreads(); phase_gla1(p, l, lds); SEAM(); }
        if (IN(gb + 4)) { phase_gla2(p); SEAM(); }
        if (IN(gb + 5)) { phase_gla3(p, l, lds); SEAM(); }
        if (IN(gb + 6)) {
            pg8::Gemm g{}; g.A = proj; g.Bt = (const bf16_t*)(p.ws + WS_WO); g.lda = PW; g.ldb = 512; g.K = 512; g.bseg = (size_t)1024 * 512;
            g.ac0 = C_QA; g.ac1 = C_QB; g.ac2 = C_RC; g.ac3 = C_RC + 512;
            pg8::Order<4> so; so.init(NROW, 1024, gridDim.x, blockIdx.x);
            pg8::EpiMerge e; e.proj = proj; e.M32 = (float*)(p.ws + WS_M32); e.Mo = (bf16_t*)(p.ws + WS_M);
            pg8::gemm_phase(lds, g, so, e); SEAM();
        }
        if (IN(gb + 7)) {
            pg8::Gemm g{}; g.A = (const bf16_t*)(p.ws + WS_M); g.Bt = (const bf16_t*)(p.ws + WS_WOUT); g.lda = 1024; g.ldb = 1024; g.K = 1024; g.bseg = 0;
            pg8::Order<1> so; so.init(NROW, 1024, gridDim.x, blockIdx.x);
            pg8::EpiResid e; e.xin_lat = xin_lat; e.xin_ctx = xin_ctx; e.xout_lat = p.out; e.xout_ctx = ctxr; e.gate = (const float*)(p.ws + WS_MOD) + (size_t)l * 3 * 6144 + 2 * 1024;
            pg8::gemm_phase(lds, g, so, e); SEAM();
        }
        if (IN(gb + 8)) { phase_norm(p, l, 1, p.out, ctxr, (bf16_t*)(p.ws + WS_H2)); SEAM(); }
        if (IN(gb + 9)) {
            pg8::Gemm g{}; g.A = (const bf16_t*)(p.ws + WS_H2); g.Bt = (const bf16_t*)(p.ws + WS_WPQ); g.lda = 1024; g.ldb = 1024; g.K = 1024; g.bseg = 0;
            pg8::Order<1> so; so.init(NROW, 2048, gridDim.x, blockIdx.x);
            pg8::EpiBf16 e; e.O = (bf16_t*)(p.ws + WS_PQ); e.ldc = 2048; e.ncols = 2048;
            pg8::gemm_phase(lds, g, so, e); SEAM();
        }
        if (IN(gb + 10)) { phase_peer_select(p, lds); SEAM(); }
        if (IN(gb + 11)) { phase_peer_gather(p, l, p.out, ctxr, p.out, ctxr); SEAM(); }
    }
#undef IN
#undef SEAM
}

#ifndef MK_LAUNCHES
#define MK_LAUNCHES 1
#endif
extern "C" void kernel_launch(void* const* d_in, const int* in_sizes, int n_in, void* d_out, int out_size, void* d_ws, size_t ws_size, hipStream_t stream) {
    static int grid = 0;
    if (grid == 0) {
        if (n_in != 29 || in_sizes[0] != NLAT * D || out_size != NLAT * D || ws_size < WS_END) {
            fprintf(stderr, "kernel_launch: unexpected problem (n_in %d, in0 %d, out %d, ws %zu, need %zu); nothing launched\n", n_in, n_in > 0 ? in_sizes[0] : -1, out_size, ws_size, (size_t)WS_END); grid = -1; return; }
        int dev = 0, cus = 0, per_cu = 0;
        if (hipGetDevice(&dev) != hipSuccess || hipDeviceGetAttribute(&cus, hipDeviceAttributeMultiprocessorCount, dev) != hipSuccess) { grid = -1; return; }
        if (hipFuncSetAttribute((const void*)hybrid_fwd, hipFuncAttributeMaxDynamicSharedMemorySize, LDS_BYTES) != hipSuccess) { fprintf(stderr, "kernel_launch: hipFuncSetAttribute failed\n"); grid = -1; return; }
        if (hipOccupancyMaxActiveBlocksPerMultiprocessor(&per_cu, (const void*)hybrid_fwd, 512, LDS_BYTES) != hipSuccess || per_cu < 1) { fprintf(stderr, "kernel_launch: occupancy query says %d\n", per_cu); grid = -1; return; }
        (void)hipGetLastError();
        grid = cus;
    }
    if (grid < 0) return;
    (void)hipMemsetAsync((char*)d_ws + WS_CTL, 0, 65536, stream);
    Params p{};
    for (int i = 0; i < 29; ++i) p.in[i] = (const float*)d_in[i];
    p.out = (float*)d_out; p.ws = (unsigned char*)d_ws; p.pad0 = 0;
#if MK_LAUNCHES == 0
    p.gp_lo = 0; p.gp_hi = NGPH; p.use_bar = 1;
    hipLaunchKernelGGL(hybrid_fwd, dim3(grid), dim3(512), LDS_BYTES, stream, p);
#else
    p.use_bar = 0;
    for (int gp = 0; gp < NGPH; ++gp) { p.gp_lo = gp; p.gp_hi = gp + 1; hipLaunchKernelGGL(hybrid_fwd, dim3(grid), dim3(512), LDS_BYTES, stream, p); }
#endif
}
```

```cpp
#include <hip/hip_runtime.h>
#include <stdint.h>
#include <stdio.h>

#define DBG_ZERO 0
#define LAS __attribute__((address_space(3)))
#define DI __device__ __forceinline__
typedef unsigned short bf16_t;
typedef short bf16x8 __attribute__((ext_vector_type(8)));
typedef float f32x4 __attribute__((ext_vector_type(4)));
typedef float f32x16 __attribute__((ext_vector_type(16)));
typedef unsigned u32x4 __attribute__((ext_vector_type(4)));
typedef unsigned u32x2 __attribute__((ext_vector_type(2)));

constexpr int D = 1024, NB = 2, S = 16384, LC = 256, DEPTH = 4;
constexpr int NLAT = NB * S;
constexpr int NROW = NLAT + NB * LC;
constexpr int PW = 8480;
constexpr int C_KA = 0, C_VA = 128, C_KB = 256, C_VB = 768, C_KC = 1280, C_VC = 1792, C_AC = 2816, C_QA = 2848, C_QB = 3360, C_QC = 3872, C_RC = 4384, C_GT = 5408;
constexpr int TOKB = S + LC;
constexpr int VTR = 1664;
constexpr int NCH = 260;
constexpr float EPS = 1e-6f;
constexpr float LOG2E = 1.4426950408889634f;
constexpr int NPH = 12;
constexpr int NGPH = 1 + DEPTH * NPH;

constexpr size_t WS_CTL = 0;
constexpr size_t WS_MOD = 65536;
constexpr size_t WS_CTX = WS_MOD + 512 * 1024;
constexpr size_t WS_WIN = WS_CTX + 2 * 1024 * 1024;
constexpr size_t WS_WO = WS_WIN + (size_t)8704 * 1024 * 2;
constexpr size_t WS_WOUT = WS_WO + (size_t)4 * 1024 * 512 * 2;
constexpr size_t WS_WPQ = WS_WOUT + (size_t)1024 * 1024 * 2;
constexpr size_t WS_SUBK = WS_WPQ + (size_t)2048 * 1024 * 2;
constexpr size_t WS_PU = WS_SUBK + 512 * 1024;
constexpr size_t WS_PV = WS_PU + (size_t)16384 * 1024 * 2;
constexpr size_t WS_PROJ = WS_PV + (size_t)16384 * 1024 * 2;
constexpr size_t WS_VT = WS_PROJ + (size_t)NROW * PW * 2;
constexpr size_t WS_DEC = WS_VT + (size_t)NB * VTR * TOKB * 2;
constexpr size_t WS_ST = WS_DEC + (size_t)16 * NCH * 128 * 4;
constexpr size_t WS_END = WS_ST + (size_t)16 * NCH * 32768 * 2;
constexpr size_t WS_H = WS_ST;
constexpr size_t WS_M32 = WS_ST;
constexpr size_t WS_M = WS_ST + (size_t)NROW * 1024 * 4;
constexpr size_t WS_H2 = WS_VT;
constexpr size_t WS_PQ = WS_ST;
constexpr size_t WS_PIDX = WS_PROJ;
constexpr size_t WS_PG = WS_PROJ + (size_t)NROW * 128 * 4;
static_assert(WS_M + (size_t)NROW * 1024 * 2 <= WS_END && (size_t)NROW * 1024 * 2 <= (size_t)NB * VTR * TOKB * 2 && WS_END <= ((size_t)1 << 30), "workspace map");

constexpr int LDS_BYTES = 147456;
constexpr int LDS_BARW = 131072;

DI float bf_lo(unsigned w) { return __uint_as_float(w << 16); }
DI float bf_hi(unsigned w) { return __uint_as_float(w & 0xffff0000u); }
DI float bf2f(bf16_t b) { return __uint_as_float((unsigned)b << 16); }
typedef __bf16 bf16v2 __attribute__((ext_vector_type(2)));
DI unsigned pack2(float lo, float hi) { bf16v2 v; v.x = (__bf16)lo; v.y = (__bf16)hi; return __builtin_bit_cast(unsigned, v); }
DI bf16_t f2bf(float f) { return (bf16_t)(pack2(f, 0.f) & 0xffffu); }
DI float wave_sum(float v) {
#pragma unroll
    for (int o = 32; o > 0; o >>= 1) v += __shfl_xor(v, o);
    return v;
}
DI int otid() { int t = threadIdx.x; asm volatile("" : "+v"(t)); return t; }
DI float sigmoidf_(float x) { return 1.0f / (1.0f + __expf(-x)); }
DI f32x16 zero16() { f32x16 z; for (int i = 0; i < 16; ++i) z[i] = 0.f; return z; }
#define MFMA32(a, b, c) __builtin_amdgcn_mfma_f32_32x32x16_bf16((a), (b), (c), 0, 0, 0)
DI int pi32(int i) { return (i & 0x13) | ((i & 8) >> 1) | ((i & 4) << 1); }

#define XB_TMO      128
#define XB_XCNT(j)  (256  + 64 * (j))
#define XB_XSUB(j)  (1280 + 64 * (j))
#define XB_XGEN(j)  (2304 + 64 * (j))
#define XB_TOP      3328
#define XB_TOPGEN   3392
#define XCD_BAR_WORDS 3456
#define XB_SPIN_CAP (1u << 22)
DI unsigned xb_ld(unsigned* p)              { return __hip_atomic_load(p, __ATOMIC_RELAXED, __HIP_MEMORY_SCOPE_AGENT); }
DI unsigned xb_add(unsigned* p, unsigned v) { return __hip_atomic_fetch_add(p, v, __ATOMIC_RELAXED, __HIP_MEMORY_SCOPE_AGENT); }
DI unsigned xb_xcc_id() { return (unsigned)__builtin_amdgcn_s_getreg((3 << 11) | 20) & 0xFu; }
#define XB_SPIN(cond, bar) do { unsigned _sp = 0; while (cond) { __builtin_amdgcn_s_sleep(1); \
    if ((++_sp & 255u) == 0u) { if (xb_ld(&(bar)[XB_TMO])) break; if (_sp > XB_SPIN_CAP) { atomicAdd(&(bar)[XB_TMO], 1u); break; } } } } while (0)
struct XcdBarrier { unsigned* bar; unsigned x; volatile LAS unsigned* st; };
DI XcdBarrier xcd_barrier_post(unsigned* bar, volatile LAS unsigned* st) {
    XcdBarrier b; b.bar = bar; b.x = xb_xcc_id(); b.st = st;
    if (threadIdx.x == 0) (void)xb_add(&bar[XB_XCNT(b.x)], 1u);
    return b;
}
DI void xcd_barrier_complete(unsigned* bar, unsigned x, unsigned& nloc, unsigned& nx) {
    const unsigned G = gridDim.x * gridDim.y * gridDim.z;
    unsigned sum, cnt, mine, sp = 0u;
    for (;;) {
        sum = 0u; cnt = 0u; mine = 0u;
#pragma unroll
        for (unsigned j = 0; j < 16; ++j) { const unsigned c = xb_ld(&bar[XB_XCNT(j)]); sum += c; cnt += (c > 0u) ? 1u : 0u; mine = (j == x) ? c : mine; }
        if (sum == G) break;
        __builtin_amdgcn_s_sleep(1);
        if ((++sp & 255u) == 0u) { if (xb_ld(&bar[XB_TMO])) break; if (sp > XB_SPIN_CAP) { atomicAdd(&bar[XB_TMO], 1u); break; } }
    }
    nloc = mine > 0u ? mine : 1u; nx = cnt > 0u ? cnt : 1u;
}
DI void xcd_barrier(const XcdBarrier& b) {
    asm volatile("s_waitcnt vmcnt(0)" ::: "memory");
    __syncthreads();
    if (threadIdx.x == 0) {
        unsigned* bar = b.bar;
        __builtin_amdgcn_s_waitcnt(0);
        unsigned nloc = b.st[0], nx = b.st[1];
        if (nloc == 0u) { xcd_barrier_complete(bar, b.x, nloc, nx); b.st[0] = nloc; b.st[1] = nx; }
        const unsigned old = xb_add(&bar[XB_XSUB(b.x)], 1u);
        const unsigned gen = old / nloc;
        if (old + 1u == (gen + 1u) * nloc) {
            __builtin_amdgcn_fence(__ATOMIC_RELEASE, "agent");
            asm volatile("s_waitcnt vmcnt(0)" ::: "memory");
            const unsigned og = xb_add(&bar[XB_TOP], 1u);
            const unsigned tg = og / nx;
            if (og + 1u == (tg + 1u) * nx) xb_add(&bar[XB_TOPGEN], 1u);
            else XB_SPIN(xb_ld(&bar[XB_TOPGEN]) == tg, bar);
            __builtin_amdgcn_fence(__ATOMIC_ACQUIRE, "agent");
            xb_add(&bar[XB_XGEN(b.x)], 1u);
            asm volatile("s_waitcnt vmcnt(0)" ::: "memory");
        } else {
            XB_SPIN(xb_ld(&bar[XB_XGEN(b.x)]) == gen, bar);
            __builtin_amdgcn_fence(__ATOMIC_ACQUIRE, "agent");
            asm volatile("s_waitcnt vmcnt(0)" ::: "memory");
        }
    }
    __syncthreads();
}

struct Params {
    const float* in[29];
    float* out;
    unsigned char* ws;
    int gp_lo, gp_hi;
    int use_bar, pad0;
};
enum { I_X = 0, I_C, I_CTX, I_CCTX, I_WMOD, I_BMOD, I_NORM1, I_NORM2, I_WIN, I_QNA, I_KNA, I_SINKA, I_QNB, I_KNB, I_RPB, I_WA2F, I_BAF, I_WA2B, I_BAB, I_GNC, I_WOA, I_WOB, I_WOC, I_WOUT, I_WPQ, I_PQG, I_SUBK, I_PU, I_PV };

namespace pg8 {
constexpr int BM = 256, BK = 64, HALF = 128, HTB = HALF * BK * 2, STAGE_BYTES = 8 * HTB, NXCD = 8, WGM = 8;
DI int lds_byte(int r, int c) { const int st = (r >> 4) * 2 + (c >> 5), rr = r & 15, cc = c & 31, ob = rr * 64 + cc * 2; return st * 1024 + (ob ^ (((ob >> 9) & 1) << 5)); }
DI void stage_rc(int b, int& R, int& C) { const int st = b / 1024, sb = b % 1024, swz = sb ^ (((sb >> 9) & 1) << 5); R = (st >> 1) * 16 + swz / 64; C = (st & 1) * 32 + (swz % 64) / 2; }
DI int perm32(int rho) { const int n = rho >> 4, i = rho & 15; return 8 * (i >> 2) + 4 * n + (i & 3); }
struct Unit { int pm, pn, seg; };
struct Gemm { const bf16_t* A; const bf16_t* Bt; int lda, ldb, K; int ac0, ac1, ac2, ac3; size_t bseg; };
DI int gemm_acol(const Gemm& g, int seg) { return seg == 0 ? g.ac0 : (seg == 1 ? g.ac1 : (seg == 2 ? g.ac2 : g.ac3)); }
template <int NSEG> struct Order {
    int nM, nN, nwg, G, c;
    DI void init(int M, int N, int G_, int c_) { nM = M / BM; nN = N / BM; nwg = nM * nN; G = G_; c = c_; }
    DI bool next(int i, Unit& u) const {
        const int t = i / NSEG; u.seg = i - t * NSEG;
        const long L = (long)t * G + c; if (L >= nwg) return false;
        int wgid = (int)L; { const int q = nwg / NXCD, r = nwg % NXCD, xcd = wgid % NXCD, off = wgid / NXCD; wgid = (xcd < r ? xcd * (q + 1) : r * (q + 1) + (xcd - r) * q) + off; }
        const int nig = WGM * nN, gid = wgid / nig, fm = gid * WGM, gsz = (nM - fm) < WGM ? (nM - fm) : WGM;
        u.pm = fm + ((wgid % nig) % gsz); u.pn = (wgid % nig) / gsz; return true;
    }
};
DI unsigned cvt_pk_bf16(float lo, float hi) { unsigned r; asm volatile("v_cvt_pk_bf16_f32 %0, %1, %2" : "=v"(r) : "v"(lo), "v"(hi)); return r; }

template <class Epi, class Sched>
DI void gemm_phase(LAS unsigned char* lds, const Gemm g, const Sched& S, const Epi& E) {
    const int tid = otid(), wid = __builtin_amdgcn_readfirstlane(tid >> 6), lane = tid & 63, wr = wid >> 2, wc = wid & 3, fr = lane & 15, fq = lane >> 4;
    const int K = g.K, nt = K / BK;
    unsigned voffA[2], voffB[2];
#pragma unroll
    for (int i = 0; i < 2; ++i) { int R, C; stage_rc(tid * 16 + i * 8192, R, C); const int Rb = Epi::PERM ? ((R & ~31) + perm32(R & 31)) : R;
        voffA[i] = (unsigned)(R * g.lda + C) * 2u; voffB[i] = (unsigned)(Rb * g.ldb + C) * 2u; }
    const size_t kstep = (size_t)(BK * 2);
    const size_t hstepA = (size_t)HALF * g.lda * 2, hstepB = (size_t)HALF * g.ldb * 2;
    const unsigned ldsw = (unsigned)wid * 1024u;
    const int aoff = lds_byte(wr * 64 + fr, fq * 8), boff = lds_byte(wc * 32 + fr, fq * 8);
#define PG8_SA(b, h) (((b) * 2 + (h)) * HTB)
#define PG8_SB(b, h) ((4 + (b) * 2 + (h)) * HTB)
#define PG8_STAGE(bufoff, gbase, voff) do { _Pragma("unroll") for (int _i = 0; _i < 2; ++_i) \
        __builtin_amdgcn_global_load_lds((const unsigned*)((const char*)(gbase) + (voff)[_i]), (LAS unsigned*)(lds + (bufoff) + ldsw + _i * 8192), 16, 0, 0); } while (0)
#define PG8_LDA(dst, b, h) do { _Pragma("unroll") for (int m = 0; m < 4; ++m) _Pragma("unroll") for (int k = 0; k < 2; ++k) dst[m][k] = *(const LAS bf16x8*)(lds + PG8_SA(b, h) + aoff + m * 2048 + k * 1024); } while (0)
#define PG8_LDB(dst, b, h) do { _Pragma("unroll") for (int n = 0; n < 2; ++n) _Pragma("unroll") for (int k = 0; k < 2; ++k) dst[n][k] = *(const LAS bf16x8*)(lds + PG8_SB(b, h) + boff + n * 2048 + k * 1024); } while (0)
#define PG8_MMA(ai, bj, At, Bt) do { __builtin_amdgcn_s_setprio(1); _Pragma("unroll") for (int m = 0; m < 4; ++m) _Pragma("unroll") for (int n = 0; n < 2; ++n) _Pragma("unroll") for (int k = 0; k < 2; ++k) \
        acc[ai][bj][m][n] = __builtin_amdgcn_mfma_f32_16x16x32_bf16(Bt[n][k], At[m][k], acc[ai][bj][m][n], 0, 0, 0); __builtin_amdgcn_s_setprio(0); } while (0)
#define PG8_WAIT_V(n) asm volatile("s_waitcnt vmcnt(" #n ")" ::: "memory")
#define PG8_WAIT_L(n) asm volatile("s_waitcnt lgkmcnt(" #n ")" ::: "memory")
#define PG8_BAR __builtin_amdgcn_s_barrier()
#define PG8_SCHED __builtin_amdgcn_sched_barrier(0)
#define PG8_APTR(u) ((const char*)g.A + ((size_t)(u).pm * BM * g.lda + (size_t)gemm_acol(g, (u).seg)) * 2)
#define PG8_BPTR(u) ((const char*)g.Bt + ((size_t)(u).seg * g.bseg + (size_t)(u).pn * BM * g.ldb) * 2)
    Unit cur, nxt; int ui = 0;
    if (!S.next(0, cur)) return;
    f32x4 acc[2][2][4][2];
#pragma unroll
    for (int a = 0; a < 2; ++a)
#pragma unroll
        for (int b = 0; b < 2; ++b)
#pragma unroll
            for (int m = 0; m < 4; ++m)
#pragma unroll
                for (int n = 0; n < 2; ++n) acc[a][b][m][n] = (f32x4){0.f, 0.f, 0.f, 0.f};
    bf16x8 At[4][2], B0[2][2], B1[2][2];
    const char* cA = PG8_APTR(cur); const char* cB = PG8_BPTR(cur);
    PG8_STAGE(PG8_SB(0, 0), cB, voffB); PG8_STAGE(PG8_SA(0, 0), cA, voffA); PG8_STAGE(PG8_SB(0, 1), cB + hstepB, voffB); PG8_STAGE(PG8_SA(0, 1), cA + hstepA, voffA);
    if (wr == 1) PG8_BAR;
    PG8_WAIT_V(4); PG8_BAR;
    PG8_STAGE(PG8_SB(1, 0), cB + kstep, voffB); PG8_STAGE(PG8_SA(1, 0), cA + kstep, voffA); PG8_STAGE(PG8_SB(1, 1), cB + hstepB + kstep, voffB);
    PG8_WAIT_V(6); PG8_BAR;
    for (;;) {
        const bool has_next = S.next(ui + 1, nxt);
        const char* nA = has_next ? PG8_APTR(nxt) : cA; const char* nB = has_next ? PG8_BPTR(nxt) : cB;
        for (int t = 0; t < nt; t += 2) {
            const bool last = (t == nt - 2);
            const char* a1 = cA + (size_t)(t + 1) * kstep;
            const char* a2 = last ? nA : cA + (size_t)(t + 2) * kstep; const char* b2 = last ? nB : cB + (size_t)(t + 2) * kstep;
            const char* a3 = a2 + kstep; const char* b3 = b2 + kstep;
            PG8_LDB(B0, 0, 0); PG8_SCHED; PG8_LDA(At, 0, 0); PG8_STAGE(PG8_SA(1, 1), a1 + hstepA, voffA);
            PG8_WAIT_L(8); PG8_BAR; PG8_WAIT_L(0); PG8_MMA(0, 0, At, B0); PG8_BAR; PG8_SCHED;
            PG8_LDB(B1, 0, 1); PG8_STAGE(PG8_SB(0, 0), b2, voffB);
            PG8_BAR; PG8_WAIT_L(0); PG8_MMA(0, 1, At, B1); PG8_BAR;
            PG8_LDA(At, 0, 1); PG8_STAGE(PG8_SA(0, 0), a2, voffA);
            PG8_BAR; PG8_WAIT_L(0); PG8_MMA(1, 0, At, B0); PG8_BAR; PG8_SCHED;
            PG8_STAGE(PG8_SB(0, 1), b2 + hstepB, voffB);
            PG8_WAIT_V(6); PG8_BAR; PG8_MMA(1, 1, At, B1); PG8_BAR;
            PG8_LDB(B0, 1, 0); PG8_SCHED; PG8_LDA(At, 1, 0); PG8_STAGE(PG8_SA(0, 1), a2 + hstepA, voffA);
            PG8_WAIT_L(8); PG8_BAR; PG8_WAIT_L(0); PG8_MMA(0, 0, At, B0); PG8_BAR; PG8_SCHED;
            PG8_LDB(B1, 1, 1); PG8_STAGE(PG8_SB(1, 0), b3, voffB);
            PG8_BAR; PG8_WAIT_L(0); PG8_MMA(0, 1, At, B1); PG8_BAR;
            PG8_LDA(At, 1, 1); PG8_STAGE(PG8_SA(1, 0), a3, voffA);
            PG8_BAR; PG8_WAIT_L(0); PG8_MMA(1, 0, At, B0); PG8_BAR; PG8_SCHED;
            PG8_STAGE(PG8_SB(1, 1), b3 + hstepB, voffB);
            PG8_WAIT_V(6); PG8_BAR; PG8_MMA(1, 1, At, B1); PG8_BAR;
        }
        E(acc, cur, wr, wc, fr, fq);
        if (!has_next) break;
#pragma unroll
        for (int a = 0; a < 2; ++a)
#pragma unroll
            for (int b = 0; b < 2; ++b)
#pragma unroll
                for (int m = 0; m < 4; ++m)
#pragma unroll
                    for (int n = 0; n < 2; ++n) acc[a][b][m][n] = (f32x4){0.f, 0.f, 0.f, 0.f};
        cur = nxt; cA = nA; cB = nB; ++ui;
    }
    PG8_WAIT_V(0);
    if (wr == 0) PG8_BAR;
    PG8_BAR;
#undef PG8_SA
#undef PG8_SB
#undef PG8_STAGE
#undef PG8_LDA
#undef PG8_LDB
#undef PG8_MMA
#undef PG8_WAIT_V
#undef PG8_WAIT_L
#undef PG8_BAR
#undef PG8_SCHED
#undef PG8_APTR
#undef PG8_BPTR
}

struct EpiBf16 {
    static constexpr bool PERM = true;
    bf16_t* O; int ldc, ncols;
    DI void operator()(const f32x4 (&acc)[2][2][4][2], const Unit& u, int wr, int wc, int fr, int fq) const {
        const int row0 = u.pm * BM + wr * 64 + fr, col0 = u.pn * BM + wc * 32 + 8 * fq;
#pragma unroll
        for (int ai = 0; ai < 2; ++ai)
#pragma unroll
            for (int m = 0; m < 4; ++m) { bf16_t* rowp = O + (size_t)(row0 + ai * HALF + m * 16) * ldc + col0;
#pragma unroll
                for (int bj = 0; bj < 2; ++bj) { const f32x4 v0 = acc[ai][bj][m][0], v1 = acc[ai][bj][m][1];
                    u32x4 w; w.x = cvt_pk_bf16(v0[0], v0[1]); w.y = cvt_pk_bf16(v0[2], v0[3]); w.z = cvt_pk_bf16(v1[0], v1[1]); w.w = cvt_pk_bf16(v1[2], v1[3]);
                    if (col0 + bj * HALF < ncols) *(u32x4*)(rowp + bj * HALF) = w; } }
    }
};
struct EpiMerge {
    static constexpr bool PERM = true;
    const bf16_t* proj; float* M32; bf16_t* Mo;
    DI void operator()(const f32x4 (&acc)[2][2][4][2], const Unit& u, int wr, int wc, int fr, int fq) const {
        const int row0 = u.pm * BM + wr * 64 + fr, col0 = u.pn * BM + wc * 32 + 8 * fq;
        const int gsel = u.seg < 2 ? u.seg : 2;
#pragma unroll
        for (int ai = 0; ai < 2; ++ai)
#pragma unroll
            for (int m = 0; m < 4; ++m) {
                const size_t row = (size_t)(row0 + ai * HALF + m * 16);
#pragma unroll
                for (int bj = 0; bj < 2; ++bj) {
                    const int col = col0 + bj * HALF;
                    const u32x4 gw = *(const u32x4*)(proj + row * PW + C_GT + gsel * 1024 + col);
                    f32x4 v0 = acc[ai][bj][m][0], v1 = acc[ai][bj][m][1];
                    v0[0] *= sigmoidf_(bf_lo(gw.x)); v0[1] *= sigmoidf_(bf_hi(gw.x)); v0[2] *= sigmoidf_(bf_lo(gw.y)); v0[3] *= sigmoidf_(bf_hi(gw.y));
                    v1[0] *= sigmoidf_(bf_lo(gw.z)); v1[1] *= sigmoidf_(bf_hi(gw.z)); v1[2] *= sigmoidf_(bf_lo(gw.w)); v1[3] *= sigmoidf_(bf_hi(gw.w));
                    if (DBG_ZERO & (1 << gsel)) { v0 *= 0.f; v1 *= 0.f; }
                    float* mp = M32 + row * 1024 + col;
                    if (u.seg > 0) { v0 += *(const f32x4*)mp; v1 += *(const f32x4*)(mp + 4); }
                    if (u.seg < 3) { *(f32x4*)mp = v0; *(f32x4*)(mp + 4) = v1; }
                    else { u32x4 w; w.x = cvt_pk_bf16(v0[0], v0[1]); w.y = cvt_pk_bf16(v0[2], v0[3]); w.z = cvt_pk_bf16(v1[0], v1[1]); w.w = cvt_pk_bf16(v1[2], v1[3]);
                        *(u32x4*)(Mo + row * 1024 + col) = w; }
                }
            }
    }
};
struct EpiResid {
    static constexpr bool PERM = false;
    const float* xin_lat; const float* xin_ctx; float* xout_lat; float* xout_ctx; const float* gate;
    DI void operator()(const f32x4 (&acc)[2][2][4][2], const Unit& u, int wr, int wc, int fr, int fq) const {
        const int rowt = u.pm * BM;
        const bool lat = rowt < NLAT;
        const int mv = lat ? (rowt >> 14) : 2;
        const float* xin = lat ? xin_lat + (size_t)rowt * 1024 : xin_ctx + (size_t)(rowt - NLAT) * 1024;
        float* xo = lat ? xout_lat + (size_t)rowt * 1024 : xout_ctx + (size_t)(rowt - NLAT) * 1024;
        const int r0 = wr * 64 + fr, col0 = u.pn * BM + wc * 32 + 4 * fq;
        const float* gp = gate + mv * 6144 + col0;
#pragma unroll
        for (int ai = 0; ai < 2; ++ai)
#pragma unroll
            for (int m = 0; m < 4; ++m) {
                const unsigned ro = (unsigned)(r0 + ai * HALF + m * 16) * 1024u + (unsigned)col0;
#pragma unroll
                for (int bj = 0; bj < 2; ++bj)
#pragma unroll
                    for (int n = 0; n < 2; ++n) {
                        const f32x4 gv = *(const f32x4*)(gp + bj * HALF + n * 16);
                        const f32x4 xv = *(const f32x4*)(xin + ro + bj * HALF + n * 16);
                        *(f32x4*)(xo + ro + bj * HALF + n * 16) = xv + gv * acc[ai][bj][m][n]; }
            }
    }
};
}

DI void phase_mod(const Params& p, LAS float* lds) {
    const int tid = otid();
    LAS float* act = lds;
    LAS float* red = lds + 3072;
    for (int i = tid; i < 3072; i += 512) { const int v = i >> 10, k = i & 1023; const float x = v < 2 ? p.in[I_C][v * 1024 + k] : p.in[I_CCTX][k]; act[i] = x / (1.0f + __expf(-x)); }
    __syncthreads();
    float* mod = (float*)(p.ws + WS_MOD);
    const int c = tid & 31, kg = tid >> 5;
    for (int cb = blockIdx.x; cb < 256; cb += gridDim.x) {
        const int l = cb >> 6, col0 = (cb & 63) * 96;
        const float* W = p.in[I_WMOD] + (size_t)l * 1024 * 6144;
        for (int sub = 0; sub < 3; ++sub) {
            const int col = col0 + sub * 32 + c;
            float a0 = 0.f, a1 = 0.f, a2 = 0.f;
#pragma unroll 8
            for (int k = kg; k < 1024; k += 16) { const float w = W[(size_t)k * 6144 + col]; a0 += act[k] * w; a1 += act[1024 + k] * w; a2 += act[2048 + k] * w; }
            red[(kg * 3 + 0) * 32 + c] = a0; red[(kg * 3 + 1) * 32 + c] = a1; red[(kg * 3 + 2) * 32 + c] = a2;
            __syncthreads();
            if (tid < 96) { const int v = tid >> 5, cc = tid & 31; float s = 0.f;
#pragma unroll
                for (int q = 0; q < 16; ++q) s += red[(q * 3 + v) * 32 + cc];
                const int cj = col0 + sub * 32 + cc;
                mod[((size_t)l * 3 + v) * 6144 + cj] = s + p.in[I_BMOD][l * 6144 + cj]; }
            __syncthreads();
        }
    }
}

DI void tcvt_tile(const float* src, int K, int N, bf16_t* dst, int kt, int nt, LAS float* tile) {
    const int tid = otid();
    { const int r = tid >> 4, c4 = (tid & 15) * 4;
#pragma unroll
        for (int i = 0; i < 2; ++i) { const int kk = kt * 64 + r + 32 * i, nn = nt * 64 + c4;
            f32x4 v = (f32x4){0.f, 0.f, 0.f, 0.f};
            if (nn < N) v = *(const f32x4*)(src + (size_t)kk * N + nn);
            LAS float* t = tile + (r + 32 * i) * 65 + c4; t[0] = v[0]; t[1] = v[1]; t[2] = v[2]; t[3] = v[3]; } }
    __syncthreads();
    { const int n = tid >> 3, kc = (tid & 7) * 8; float v[8];
#pragma unroll
        for (int j = 0; j < 8; ++j) v[j] = tile[(kc + j) * 65 + n];
        u32x4 w; w.x = pack2(v[0], v[1]); w.y = pack2(v[2], v[3]); w.z = pack2(v[4], v[5]); w.w = pack2(v[6], v[7]);
        *(u32x4*)(dst + (size_t)(nt * 64 + n) * K + kt * 64 + kc) = w; }
    __syncthreads();
}
DI void tcvt_job(const float* src, int K, int N, int Npad, bf16_t* dst, LAS float* tile, int& base) {
    const int nkt = K / 64, nnt = Npad / 64, ntl = nkt * nnt, G = gridDim.x;
    int first = ((int)blockIdx.x - (base % G) + G) % G;
    for (int t = first; t < ntl; t += G) tcvt_tile(src, K, N, dst, t % nkt, t / nkt, tile);
    base += ntl;
}
DI void cvt_copy(const float* src, bf16_t* dst, size_t n) {
    const size_t nth = (size_t)gridDim.x * 512;
    for (size_t i = ((size_t)blockIdx.x * 512 + otid()) * 8; i < n; i += nth * 8) {
        const f32x4 a = *(const f32x4*)(src + i), b = *(const f32x4*)(src + i + 4);
        u32x4 w; w.x = pack2(a[0], a[1]); w.y = pack2(a[2], a[3]); w.z = pack2(b[0], b[1]); w.w = pack2(b[2], b[3]);
        *(u32x4*)(dst + i) = w;
    }
}
DI void phase_convert(const Params& p, int l, LAS float* lds) {
    int base = 0;
    tcvt_job(p.in[I_WIN] + (size_t)l * 1024 * PW, 1024, PW, 8704, (bf16_t*)(p.ws + WS_WIN), lds, base);
    tcvt_job(p.in[I_WOA] + (size_t)l * 512 * 1024, 512, 1024, 1024, (bf16_t*)(p.ws + WS_WO), lds, base);
    tcvt_job(p.in[I_WOB] + (size_t)l * 512 * 1024, 512, 1024, 1024, (bf16_t*)(p.ws + WS_WO) + (size_t)1 * 1024 * 512, lds, base);
    tcvt_job(p.in[I_WOC] + (size_t)l * 1024 * 1024, 512, 1024, 1024, (bf16_t*)(p.ws + WS_WO) + (size_t)2 * 1024 * 512, lds, base);
    tcvt_job(p.in[I_WOC] + (size_t)l * 1024 * 1024 + (size_t)512 * 1024, 512, 1024, 1024, (bf16_t*)(p.ws + WS_WO) + (size_t)3 * 1024 * 512, lds, base);
    tcvt_job(p.in[I_WOUT] + (size_t)l * 1024 * 1024, 1024, 1024, 1024, (bf16_t*)(p.ws + WS_WOUT), lds, base);
    tcvt_job(p.in[I_WPQ] + (size_t)l * 1024 * 2048, 1024, 2048, 2048, (bf16_t*)(p.ws + WS_WPQ), lds, base);
    { const float* sk = p.in[I_SUBK] + (size_t)l * 262144; const float* pg = p.in[I_PQG] + l * 128; bf16_t* dst = (bf16_t*)(p.ws + WS_SUBK);
        for (int i = (blockIdx.x * 512 + otid()) * 2; i < 262144; i += gridDim.x * 1024) {
            const int d = i & 127; *(unsigned*)(dst + i) = pack2(sk[i] * pg[d], sk[i + 1] * pg[d + 1]); } }
    cvt_copy(p.in[I_PU] + (size_t)l * 16384 * 1024, (bf16_t*)(p.ws + WS_PU), (size_t)16384 * 1024);
    cvt_copy(p.in[I_PV] + (size_t)l * 16384 * 1024, (bf16_t*)(p.ws + WS_PV), (size_t)16384 * 1024);
}

DI void phase_norm(const Params& p, int l, int which, const float* xlat, const float* xctx, bf16_t* dst) {
    const int tid = otid(), lane = tid & 63, wid = tid >> 6;
    const float* gain = p.in[which ? I_NORM2 : I_NORM1] + l * 1024;
    const float* mod = (const float*)(p.ws + WS_MOD) + (size_t)l * 3 * 6144;
    for (int r = blockIdx.x * 8 + wid; r < NROW; r += gridDim.x * 8) {
        const float* x = r < NLAT ? xlat + (size_t)r * 1024 : xctx + (size_t)(r - NLAT) * 1024;
        const int mv = r < NLAT ? (r >> 14) : 2;
        const float* sh = mod + mv * 6144 + (which ? 3 : 0) * 1024; const float* sc = sh + 1024;
        f32x4 v[4]; float ss = 0.f;
#pragma unroll
        for (int i = 0; i < 4; ++i) { v[i] = *(const f32x4*)(x + i * 256 + lane * 4); ss += v[i][0] * v[i][0] + v[i][1] * v[i][1] + v[i][2] * v[i][2] + v[i][3] * v[i][3]; }
        ss = wave_sum(ss);
        const float rstd = rsqrtf(ss * (1.0f / 1024.0f) + EPS);
#pragma unroll
        for (int i = 0; i < 4; ++i) { const int c = i * 256 + lane * 4;
            const f32x4 g4 = *(const f32x4*)(gain + c), s4 = *(const f32x4*)(sc + c), h4 = *(const f32x4*)(sh + c);
            float y[4];
#pragma unroll
            for (int j = 0; j < 4; ++j) y[j] = v[i][j] * rstd * g4[j] * (1.0f + s4[j]) + h4[j];
            u32x2 w; w.x = pack2(y[0], y[1]); w.y = pack2(y[2], y[3]);
            *(u32x2*)(dst + (size_t)r * 1024 + c) = w; }
    }
}

DI void phase_post(const Params& p, int l, LAS unsigned char* lds) {
    const int tid = otid(), lane = tid & 63, wid = tid >> 6;
    bf16_t* proj = (bf16_t*)(p.ws + WS_PROJ);
    {
        const float gqa = p.in[I_QNA][l * 64 + lane], gka = p.in[I_KNA][l * 64 + lane], gqb = p.in[I_QNB][l * 64 + lane], gkb = p.in[I_KNB][l * 64 + lane];
        const int f = lane & 15; const bool use_col = (lane >= 32);
        const float inv = exp2f(-(float)f * (13.287712379549449f / 16.0f));
        const float sgn = (lane & 16) ? 1.0f : -1.0f;
        for (int r = blockIdx.x * 8 + wid; r < NROW; r += gridDim.x * 8) {
            bf16_t* row = proj + (size_t)r * PW;
            float cs = 1.0f, sn = 0.0f;
            const bool lat = r < NLAT;
            if (lat) { const int t = r & (S - 1); const float pos = (float)(use_col ? (t & 63) : (t >> 6)); const float ang = pos * inv;
                const float n = rintf(ang * 0.15915494309189535f); float rr = fmaf(-n, 6.28125f, ang); rr = fmaf(-n, 1.9353071795864769e-3f, rr);
                cs = __cosf(rr); sn = __sinf(rr); }
#pragma unroll 2
            for (int hd = 0; hd < 26; ++hd) {
                int col; float g; bool rope;
                if (hd < 8) { col = C_QA + hd * 64; g = gqa; rope = lat; }
                else if (hd < 10) { col = C_KA + (hd - 8) * 64; g = gka; rope = lat; }
                else if (hd < 18) { col = C_QB + (hd - 10) * 64; g = gqb; rope = false; }
                else { col = C_KB + (hd - 18) * 64; g = gkb; rope = false; }
                const float v = bf2f(row[col + lane]);
                const float ss = wave_sum(v * v);
                float y = v * rsqrtf(ss * (1.0f / 64.0f) + EPS) * g;
                if (rope) { const float yp = __shfl_xor(y, 16); y = y * cs + sgn * yp * sn; }
                row[col + lane] = f2bf(y);
            }
        }
    }
    {
        LAS bf16_t* tile = (LAS bf16_t*)lds;
        bf16_t* vt = (bf16_t*)(p.ws + WS_VT);
        const int ntl = (NROW / 64) * 26;
        for (int t = blockIdx.x; t < ntl; t += gridDim.x) {
            const int tt = t / 26, ct = t - tt * 26;
            int b, tok0, row0;
            if (tt < 512) { b = tt >> 8; tok0 = (tt & 255) * 64; row0 = b * S + tok0; }
            else { b = (tt - 512) >> 2; const int cc = (tt - 512) & 3; tok0 = S + cc * 64; row0 = NLAT + b * LC + cc * 64; }
            const int vr0 = ct * 64;
            const int scol = vr0 < 128 ? C_VA + vr0 : (vr0 < 640 ? C_VB + (vr0 - 128) : C_VC + (vr0 - 640));
            { const int rr = tid >> 3, ch = (tid & 7) * 8;
                const u32x4 w = *(const u32x4*)(proj + (size_t)(row0 + rr) * PW + scol + ch);
                *(LAS u32x4*)(tile + rr * 72 + ch) = w; }
            __syncthreads();
            { const int cc = tid >> 3, tk = (tid & 7) * 8; unsigned short v[8];
#pragma unroll
                for (int j = 0; j < 8; ++j) v[j] = tile[(tk + j) * 72 + cc];
                u32x4 w; w.x = v[0] | ((unsigned)v[1] << 16); w.y = v[2] | ((unsigned)v[3] << 16); w.z = v[4] | ((unsigned)v[5] << 16); w.w = v[6] | ((unsigned)v[7] << 16);
                *(u32x4*)(vt + ((size_t)b * VTR + vr0 + cc) * TOKB + tok0 + tk) = w; }
            __syncthreads();
        }
    }
}

struct AttnState { bf16x8 Q[2][4]; f32x16 O[2][2]; float m[2], l[2]; };
template <int MODE>
DI void attn_tile(AttnState& st, const bf16_t* krow, const bf16_t* vt0, int kpos0, int qpos0, const LAS float* brow, int g) {
    f32x16 sc[2];
    {
        bf16x8 Kf[4];
#pragma unroll
        for (int s = 0; s < 4; ++s) Kf[s] = *(const bf16x8*)(krow + 8 * s);
#pragma unroll
        for (int u = 0; u < 2; ++u) {
            sc[u] = zero16();
#pragma unroll
            for (int s = 0; s < 4; ++s) sc[u] = MFMA32(Kf[s], st.Q[u][s], sc[u]);
        }
    }
    bf16x8 Vf[2][2];
#pragma unroll
    for (int dt = 0; dt < 2; ++dt)
#pragma unroll
        for (int s = 0; s < 2; ++s) Vf[dt][s] = *(const bf16x8*)(vt0 + (size_t)dt * 32 * TOKB + 16 * s);
#pragma unroll
    for (int u = 0; u < 2; ++u) {
        const int qp = qpos0 + 32 * u;
        if (MODE == 1) {
#pragma unroll
            for (int r = 0; r < 16; ++r) { const int d = kpos0 + 16 * (r >> 3) + 8 * g + (r & 7) - qp; sc[u][r] = (d <= 128 && d >= -128) ? sc[u][r] : -INFINITY; }
        } else if (MODE == 2) {
            int cs = qp - 8; cs = cs < 0 ? 0 : (cs > 48 ? 48 : cs);
#pragma unroll
            for (int r = 0; r < 16; ++r) { const int ck = kpos0 + 16 * (r >> 3) + 8 * g + (r & 7); int di = ck - qp + 15; di = di < 0 ? 0 : (di > 30 ? 30 : di);
                const float bv = brow[di]; sc[u][r] = (ck >= cs && ck < cs + 16) ? sc[u][r] + bv : -INFINITY; }
        }
        float mx = sc[u][0];
#pragma unroll
        for (int r = 1; r < 16; ++r) mx = fmaxf(mx, sc[u][r]);
        mx = fmaxf(mx, __shfl_xor(mx, 32));
        const float mn = fmaxf(st.m[u], mx);
        const float alpha = exp2f(st.m[u] - mn);
        st.m[u] = mn;
        float rs = 0.f;
#pragma unroll
        for (int r = 0; r < 16; ++r) { const float pv = exp2f(sc[u][r] - mn); rs += pv; sc[u][r] = pv; }
        st.l[u] = st.l[u] * alpha + rs;
#pragma unroll
        for (int r = 0; r < 16; ++r) { st.O[0][u][r] *= alpha; st.O[1][u][r] *= alpha; }
        bf16x8 P[2];
#pragma unroll
        for (int s = 0; s < 2; ++s) { u32x4 w; w.x = pack2(sc[u][8 * s], sc[u][8 * s + 1]); w.y = pack2(sc[u][8 * s + 2], sc[u][8 * s + 3]); w.z = pack2(sc[u][8 * s + 4], sc[u][8 * s + 5]); w.w = pack2(sc[u][8 * s + 6], sc[u][8 * s + 7]);
            P[s] = __builtin_bit_cast(bf16x8, w); }
#pragma unroll
        for (int dt = 0; dt < 2; ++dt)
#pragma unroll
            for (int s = 0; s < 2; ++s) st.O[dt][u] = MFMA32(Vf[dt][s], P[s], st.O[dt][u]);
    }
}
DI void attn_load_q(AttnState& st, const bf16_t* proj, int qrow0, int qcol, int j, int g) {
    const float qs = 0.125f * LOG2E;
#pragma unroll
    for (int u = 0; u < 2; ++u) {
        const bf16_t* qp = proj + (size_t)(qrow0 + 32 * u + j) * PW + qcol + 32 * g;
#pragma unroll
        for (int s = 0; s < 4; ++s) { const u32x4 w = *(const u32x4*)(qp + 8 * s); u32x4 o;
            o.x = pack2(bf_lo(w.x) * qs, bf_hi(w.x) * qs); o.y = pack2(bf_lo(w.y) * qs, bf_hi(w.y) * qs); o.z = pack2(bf_lo(w.z) * qs, bf_hi(w.z) * qs); o.w = pack2(bf_lo(w.w) * qs, bf_hi(w.w) * qs);
            st.Q[u][s] = __builtin_bit_cast(bf16x8, o); }
        st.O[0][u] = zero16(); st.O[1][u] = zero16();
    }
}
DI void attn_store(const AttnState& st, bf16_t* proj, int qrow0, int ocol, int j, int g) {
#pragma unroll
    for (int u = 0; u < 2; ++u) {
        const float lt = st.l[u] + __shfl_xor(st.l[u], 32);
        const float inv = 1.0f / lt;
        bf16_t* op = proj + (size_t)(qrow0 + 32 * u + j) * PW + ocol + 4 * g;
#pragma unroll
        for (int dt = 0; dt < 2; ++dt)
#pragma unroll
            for (int q = 0; q < 4; ++q) { u32x2 w; w.x = pack2(st.O[dt][u][4 * q] * inv, st.O[dt][u][4 * q + 1] * inv); w.y = pack2(st.O[dt][u][4 * q + 2] * inv, st.O[dt][u][4 * q + 3] * inv);
                *(u32x2*)(op + 32 * dt + 8 * q) = w; }
    }
}
DI void attn_ctx_tiles(AttnState& st, const bf16_t* proj, const bf16_t* vt, int b, int kcol, int vr0, int j, int g) {
#pragma unroll 1
    for (int t = 0; t < 8; ++t) {
        const bf16_t* krow = proj + (size_t)(NLAT + b * LC + 32 * t + pi32(j)) * PW + kcol + 32 * g;
        const bf16_t* vt0 = vt + ((size_t)b * VTR + vr0 + j) * TOKB + S + 32 * t + 8 * g;
        attn_tile<0>(st, krow, vt0, 0, 0, nullptr, g);
    }
}
DI void phase_attn(const Params& p, int l, LAS unsigned char* lds) {
    const int tid = otid(), lane = tid & 63, wid = tid >> 6, j = lane & 31, g = lane >> 5;
    bf16_t* proj = (bf16_t*)(p.ws + WS_PROJ);
    const bf16_t* vt = (const bf16_t*)(p.ws + WS_VT);
    LAS float* rpb = (LAS float*)lds;
    for (int i = tid; i < 8 * 15 * 31; i += 512) rpb[i] = p.in[I_RPB][l * 3720 + i] * LOG2E;
    __syncthreads();
    const bool last = (l == DEPTH - 1);
    const int nitems = 8192 + (last ? 0 : 128);
    for (int it = blockIdx.x * 8 + wid; it < nitems; it += gridDim.x * 8) {
        AttnState st;
        if (it < 4096) {
            const int half = it & 1, hh = (it >> 1) & 7, n = (it >> 4) & 127, b = it >> 11;
            const int q0 = n * 128 + half * 64, qrow0 = b * S + q0, g2 = hh >> 2;
            attn_load_q(st, proj, qrow0, C_QA + hh * 64, j, g);
            const float sk = p.in[I_SINKA][l * 8 + hh] * LOG2E;
            st.m[0] = st.m[1] = sk; st.l[0] = st.l[1] = (g == 0) ? 1.0f : 0.0f;
            attn_ctx_tiles(st, proj, vt, b, C_KA + g2 * 64, g2 * 64, j, g);
            const int t_lo = half ? 2 : 0, t_hi = half ? 12 : 10;
#pragma unroll 1
            for (int t = t_lo; t < t_hi; ++t) {
                const int kp0 = (n - 1) * 128 + 32 * t;
                if (kp0 < 0 || kp0 >= S) continue;
                const bf16_t* krow = proj + (size_t)(b * S + kp0 + pi32(j)) * PW + C_KA + g2 * 64 + 32 * g;
                const bf16_t* vt0 = vt + ((size_t)b * VTR + g2 * 64 + j) * TOKB + kp0 + 8 * g;
                attn_tile<1>(st, krow, vt0, kp0, q0 + j, nullptr, g);
            }
            attn_store(st, proj, qrow0, C_QA + hh * 64, j, g);
        } else if (it < 8192) {
            const int i2 = it - 4096, h = i2 & 7, r = (i2 >> 3) & 255, b = i2 >> 11;
            const int qrow0 = b * S + r * 64;
            attn_load_q(st, proj, qrow0, C_QB + h * 64, j, g);
            st.m[0] = st.m[1] = -INFINITY; st.l[0] = st.l[1] = 0.f;
            attn_ctx_tiles(st, proj, vt, b, C_KB + h * 64, 128 + h * 64, j, g);
            int rs = r - 4; rs = rs < 0 ? 0 : (rs > 248 ? 248 : rs);
#pragma unroll 1
            for (int t = 0; t < 16; ++t) {
                const int kr = rs + (t >> 1), c0 = (t & 1) * 32;
                const bf16_t* krow = proj + (size_t)(b * S + kr * 64 + c0 + pi32(j)) * PW + C_KB + h * 64 + 32 * g;
                const bf16_t* vt0 = vt + ((size_t)b * VTR + 128 + h * 64 + j) * TOKB + kr * 64 + c0 + 8 * g;
                attn_tile<2>(st, krow, vt0, c0, j, rpb + (h * 15 + (kr - r + 7)) * 31, g);
            }
            attn_store(st, proj, qrow0, C_QB + h * 64, j, g);
        } else {
            const int i2 = it - 8192, qt = i2 & 3, h = (i2 >> 2) & 7, b = (i2 >> 5) & 1, mixer = i2 >> 6;
            const int qrow0 = NLAT + b * LC + qt * 64;
            if (mixer == 0) {
                attn_load_q(st, proj, qrow0, C_QA + h * 64, j, g);
                const float sk = p.in[I_SINKA][l * 8 + h] * LOG2E;
                st.m[0] = st.m[1] = sk; st.l[0] = st.l[1] = (g == 0) ? 1.0f : 0.0f;
                attn_ctx_tiles(st, proj, vt, b, C_KA + (h >> 2) * 64, (h >> 2) * 64, j, g);
                attn_store(st, proj, qrow0, C_QA + h * 64, j, g);
            } else {
                attn_load_q(st, proj, qrow0, C_QB + h * 64, j, g);
                st.m[0] = st.m[1] = -INFINITY; st.l[0] = st.l[1] = 0.f;
                attn_ctx_tiles(st, proj, vt, b, C_KB + h * 64, 128 + h * 64, j, g);
                attn_store(st, proj, qrow0, C_QB + h * 64, j, g);
            }
        }
    }
}

DI void gla_chunk_rows(int b, int ci, int& row0, int& tok0) {
    if (ci < 256) { tok0 = ci * 64; row0 = b * S + tok0; } else { const int cc = ci - 256; tok0 = S + cc * 64; row0 = NLAT + b * LC + cc * 64; }
}
constexpr int GL_A = 0;
constexpr int GL_W = 8192;
constexpr int GL_B = 24576;
constexpr int GL_SSQ = 25600;
constexpr int GL_LA = 32768;
constexpr int GL_QH = 65536;
constexpr int GL_KT = 81920;
constexpr int GL_ATT = GL_LA;
DI void gla_stage_gate(const Params& p, int l, const bf16_t* proj, int row0, int h, LAS unsigned char* lds) {
    const int tid = otid();
    LAS float* a_s = (LAS float*)(lds + GL_A); LAS float* w_s = (LAS float*)(lds + GL_W); LAS float* b_s = (LAS float*)(lds + GL_B);
    if (tid < 256) { const int tok = tid >> 2, c8 = (tid & 3) * 8; const u32x4 w = *(const u32x4*)(proj + (size_t)(row0 + tok) * PW + C_AC + c8);
        LAS float* d = a_s + tok * 32 + c8; d[0] = bf_lo(w.x); d[1] = bf_hi(w.x); d[2] = bf_lo(w.y); d[3] = bf_hi(w.y); d[4] = bf_lo(w.z); d[5] = bf_hi(w.z); d[6] = bf_lo(w.w); d[7] = bf_hi(w.w); }
#pragma unroll
    for (int q = 0; q < 8; ++q) { const int i = tid + q * 512, dir = i >> 11, rr = (i >> 7) & 15, ch = i & 127;
        w_s[i] = p.in[dir ? I_WA2B : I_WA2F][(size_t)l * 16 * 512 + rr * 512 + h * 128 + ch]; }
    if (tid < 256) { const int dir = tid >> 7, ch = tid & 127; b_s[tid] = p.in[dir ? I_BAB : I_BAF][l * 512 + h * 128 + ch]; }
}
DI void gla_logdecay(int dir, LAS unsigned char* lds) {
    const int tid = otid();
    const LAS float* a_s = (const LAS float*)(lds + GL_A); const LAS float* w_s = (const LAS float*)(lds + GL_W) + dir * 2048; const LAS float* b_s = (const LAS float*)(lds + GL_B) + dir * 128;
    LAS float* la = (LAS float*)(lds + GL_LA);
    { const int ch = tid & 127, tq = tid >> 7; float w[16];
#pragma unroll
        for (int i = 0; i < 16; ++i) w[i] = w_s[i * 128 + ch];
        const float bb = b_s[ch];
        for (int t = 0; t < 16; ++t) { const int tok = tq * 16 + t; float z = bb;
#pragma unroll
            for (int i = 0; i < 16; ++i) z += a_s[tok * 32 + dir * 16 + i] * w[i];
            la[tok * 128 + ch] = (fminf(z, 0.f) - __logf(1.0f + __expf(-fabsf(z)))) * (1.0f / 16.0f); } }
    __syncthreads();
    if (tid < 128) { float run = 0.f;
        if (dir == 0) { for (int t = 0; t < 64; ++t) { run += la[t * 128 + tid]; la[t * 128 + tid] = run; } }
        else { for (int t = 63; t >= 0; --t) { run += la[t * 128 + tid]; la[t * 128 + tid] = run; } } }
    __syncthreads();
}
DI void phase_gla1(const Params& p, int l, LAS unsigned char* lds) {
    const int tid = otid(), lane = tid & 63, wid = tid >> 6, j = lane & 31, g = lane >> 5;
    const bf16_t* proj = (const bf16_t*)(p.ws + WS_PROJ);
    const bf16_t* vt = (const bf16_t*)(p.ws + WS_VT);
    bf16_t* stt = (bf16_t*)(p.ws + WS_ST); float* dec = (float*)(p.ws + WS_DEC);
    const LAS float* la = (const LAS float*)(lds + GL_LA);
    LAS bf16_t* ktT = (LAS bf16_t*)(lds + GL_QH);
    for (int un = blockIdx.x; un < NB * NCH * 4; un += gridDim.x) {
        const int h = un & 3, ci = (un >> 2) % NCH, b = (un >> 2) / NCH;
        int row0, tok0; gla_chunk_rows(b, ci, row0, tok0);
        gla_stage_gate(p, l, proj, row0, h, lds);
        bf16x8 Vf[4];
#pragma unroll
        for (int s = 0; s < 4; ++s) Vf[s] = *(const bf16x8*)(vt + ((size_t)b * VTR + 640 + h * 256 + 32 * wid + j) * TOKB + tok0 + 16 * s + 8 * g);
        __syncthreads();
        for (int dir = 0; dir < 2; ++dir) {
            gla_logdecay(dir, lds);
            const int chain = (b * 4 + h) * 2 + dir;
            { const int tok = tid >> 3, cc = (tid & 7) * 16;
                const u32x4 k0 = *(const u32x4*)(proj + (size_t)(row0 + tok) * PW + C_KC + h * 128 + cc), k1 = *(const u32x4*)(proj + (size_t)(row0 + tok) * PW + C_KC + h * 128 + cc + 8);
                const unsigned kw[8] = {k0.x, k0.y, k0.z, k0.w, k1.x, k1.y, k1.z, k1.w};
                const int te = dir ? 0 : 63;
#pragma unroll
                for (int q = 0; q < 8; ++q) { const int ch = cc + 2 * q;
                    const float w0 = __expf(la[te * 128 + ch] - la[tok * 128 + ch]), w1 = __expf(la[te * 128 + ch + 1] - la[tok * 128 + ch + 1]);
                    ktT[ch * 72 + tok] = f2bf(bf_lo(kw[q]) * w0); ktT[(ch + 1) * 72 + tok] = f2bf(bf_hi(kw[q]) * w1); } }
            if (tid < 128) dec[((size_t)chain * NCH + ci) * 128 + tid] = __expf(la[(dir ? 0 : 63) * 128 + tid]);
            __syncthreads();
            bf16_t* so = stt + ((size_t)chain * NCH + ci) * 32768 + (size_t)(32 * wid + j) * 128 + 4 * g;
#pragma unroll
            for (int dk = 0; dk < 4; ++dk) {
                f32x16 acc = zero16();
#pragma unroll
                for (int s = 0; s < 4; ++s) { const bf16x8 Af = *(const LAS bf16x8*)(ktT + (32 * dk + j) * 72 + 16 * s + 8 * g); acc = MFMA32(Af, Vf[s], acc); }
#pragma unroll
                for (int q = 0; q < 4; ++q) { u32x2 w; w.x = pack2(acc[4 * q], acc[4 * q + 1]); w.y = pack2(acc[4 * q + 2], acc[4 * q + 3]); *(u32x2*)(so + 32 * dk + 8 * q) = w; }
            }
            __syncthreads();
        }
    }
}
DI void phase_gla2(const Params& p) {
    bf16_t* stt = (bf16_t*)(p.ws + WS_ST); const float* dec = (const float*)(p.ws + WS_DEC);
    for (int gt = blockIdx.x * 512 + otid(); gt < 16 * 8192; gt += gridDim.x * 512) {
        const int chain = gt >> 13, e = gt & 8191, dv = e >> 5, dk0 = (e & 31) * 4, dir = chain & 1;
        bf16_t* base = stt + (size_t)chain * NCH * 32768 + dv * 128 + dk0;
        const float* dbase = dec + (size_t)chain * NCH * 128 + dk0;
        float s0 = 0.f, s1 = 0.f, s2 = 0.f, s3 = 0.f;
        for (int st = 0; st < NCH; st += 4) {
            u32x2 dS[4]; f32x4 dd[4]; int ci[4];
#pragma unroll
            for (int q = 0; q < 4; ++q) { const int step = st + q; ci[q] = dir ? (NCH - 1 - step) : (step < 4 ? 256 + step : step - 4);
                dS[q] = *(const u32x2*)(base + (size_t)ci[q] * 32768); dd[q] = *(const f32x4*)(dbase + (size_t)ci[q] * 128); }
#pragma unroll
            for (int q = 0; q < 4; ++q) {
                u32x2 w; w.x = pack2(s0, s1); w.y = pack2(s2, s3);
                *(u32x2*)(base + (size_t)ci[q] * 32768) = w;
                s0 = dd[q][0] * s0 + bf_lo(dS[q].x); s1 = dd[q][1] * s1 + bf_hi(dS[q].x); s2 = dd[q][2] * s2 + bf_lo(dS[q].y); s3 = dd[q][3] * s3 + bf_hi(dS[q].y);
            }
        }
    }
}
DI int gl_swz(int tok, int chunk) { return tok * 256 + ((chunk ^ (tok & 15)) << 4); }
template <int DIR>
DI void gla3_dir(const Params& p, LAS unsigned char* lds, const bf16_t* proj, int row0, int h, const bf16_t* state, const bf16x8 (&Vf)[2][2], f32x16 (&O)[2]) {
    const int tid = otid(), lane = tid & 63, wid = tid >> 6, j = lane & 31, g = lane >> 5;
    gla_logdecay(DIR, lds);
    const LAS float* la = (const LAS float*)(lds + GL_LA);
    { const int tok = tid >> 3, cc = (tid & 7) * 16;
        const bf16_t* rp = proj + (size_t)(row0 + tok) * PW + h * 128 + cc;
        const u32x4 q0 = *(const u32x4*)(rp + C_QC), q1 = *(const u32x4*)(rp + C_QC + 8), k0 = *(const u32x4*)(rp + C_KC), k1 = *(const u32x4*)(rp + C_KC + 8);
        const unsigned qw[8] = {q0.x, q0.y, q0.z, q0.w, q1.x, q1.y, q1.z, q1.w}, kw[8] = {k0.x, k0.y, k0.z, k0.w, k1.x, k1.y, k1.z, k1.w};
        unsigned qo[8], ko[8];
#pragma unroll
        for (int q = 0; q < 8; ++q) { const float b0 = la[tok * 128 + cc + 2 * q], b1 = la[tok * 128 + cc + 2 * q + 1];
            qo[q] = pack2(bf_lo(qw[q]) * 0.08838834764831845f * __expf(b0), bf_hi(qw[q]) * 0.08838834764831845f * __expf(b1));
            ko[q] = pack2(bf_lo(kw[q]) * __expf(-b0), bf_hi(kw[q]) * __expf(-b1)); }
        const int c0 = (tid & 7) * 2;
        *(LAS u32x4*)(lds + GL_QH + gl_swz(tok, c0)) = (u32x4){qo[0], qo[1], qo[2], qo[3]}; *(LAS u32x4*)(lds + GL_QH + gl_swz(tok, c0 + 1)) = (u32x4){qo[4], qo[5], qo[6], qo[7]};
        *(LAS u32x4*)(lds + GL_KT + gl_swz(tok, c0)) = (u32x4){ko[0], ko[1], ko[2], ko[3]}; *(LAS u32x4*)(lds + GL_KT + gl_swz(tok, c0 + 1)) = (u32x4){ko[4], ko[5], ko[6], ko[7]}; }
    __syncthreads();
    if (wid < 4) {
        const int tj = wid >> 1, ti = wid & 1;
        const bool skip = DIR == 0 ? (tj > ti) : (tj < ti);
        if (!skip) {
            f32x16 acc = zero16();
            const int ktok = 32 * tj + pi32(j), qtok = 32 * ti + j;
#pragma unroll
            for (int s = 0; s < 8; ++s) { const bf16x8 Af = *(const LAS bf16x8*)(lds + GL_KT + gl_swz(ktok, 2 * s + g)), Bf = *(const LAS bf16x8*)(lds + GL_QH + gl_swz(qtok, 2 * s + g)); acc = MFMA32(Af, Bf, acc); }
#pragma unroll
            for (int r = 0; r < 16; ++r) { const int kt = 32 * tj + 16 * (r >> 3) + 8 * g + (r & 7); const bool keep = DIR == 0 ? (kt <= qtok) : (kt >= qtok); acc[r] = keep ? acc[r] : 0.f; }
            asm volatile("s_waitcnt lgkmcnt(0)" ::: "memory");
#pragma unroll
            for (int s = 0; s < 2; ++s) { u32x4 w; w.x = pack2(acc[8 * s], acc[8 * s + 1]); w.y = pack2(acc[8 * s + 2], acc[8 * s + 3]); w.z = pack2(acc[8 * s + 4], acc[8 * s + 5]); w.w = pack2(acc[8 * s + 6], acc[8 * s + 7]);
                *(LAS u32x4*)(lds + GL_ATT + ((wid * 2 + s) * 64 + lane) * 16) = w; }
        }
    }
    bf16x8 Sf[8];
#pragma unroll
    for (int s = 0; s < 8; ++s) Sf[s] = *(const bf16x8*)(state + (size_t)(32 * wid + j) * 128 + 16 * s + 8 * g);
    __syncthreads();
#pragma unroll
    for (int ti = 0; ti < 2; ++ti) {
#pragma unroll
        for (int tj = 0; tj < 2; ++tj) {
            const bool skip = DIR == 0 ? (tj > ti) : (tj < ti);
            if (!skip) {
#pragma unroll
                for (int s = 0; s < 2; ++s) { const bf16x8 Bf = *(const LAS bf16x8*)(lds + GL_ATT + (((tj * 2 + ti) * 2 + s) * 64 + lane) * 16); O[ti] = MFMA32(Vf[tj][s], Bf, O[ti]); }
            }
        }
#pragma unroll
        for (int s = 0; s < 8; ++s) { const bf16x8 Bf = *(const LAS bf16x8*)(lds + GL_QH + gl_swz(32 * ti + j, 2 * s + g)); O[ti] = MFMA32(Sf[s], Bf, O[ti]); }
    }
    __syncthreads();
}
DI void phase_gla3(const Params& p, int l, LAS unsigned char* lds) {
    const int tid = otid(), lane = tid & 63, wid = tid >> 6, j = lane & 31, g = lane >> 5;
    bf16_t* proj = (bf16_t*)(p.ws + WS_PROJ);
    const bf16_t* vt = (const bf16_t*)(p.ws + WS_VT);
    const bf16_t* stt = (const bf16_t*)(p.ws + WS_ST);
    LAS float* ssq = (LAS float*)(lds + GL_SSQ);
    const bool last = (l == DEPTH - 1);
    for (int un = blockIdx.x; un < NB * NCH * 4; un += gridDim.x) {
        const int h = un & 3, ci = (un >> 2) % NCH, b = (un >> 2) / NCH;
        if (last && ci >= 256) continue;
        int row0, tok0; gla_chunk_rows(b, ci, row0, tok0);
        gla_stage_gate(p, l, proj, row0, h, lds);
        bf16x8 Vf[2][2];
#pragma unroll
        for (int tj = 0; tj < 2; ++tj)
#pragma unroll
            for (int s = 0; s < 2; ++s) Vf[tj][s] = *(const bf16x8*)(vt + ((size_t)b * VTR + 640 + h * 256 + 32 * wid + j) * TOKB + tok0 + 32 * tj + 16 * s + 8 * g);
        f32x16 O[2]; O[0] = zero16(); O[1] = zero16();
        __syncthreads();
        const size_t chain0 = (size_t)(b * 4 + h) * 2;
        gla3_dir<0>(p, lds, proj, row0, h, stt + ((chain0 + 0) * NCH + ci) * 32768, Vf, O);
        gla3_dir<1>(p, lds, proj, row0, h, stt + ((chain0 + 1) * NCH + ci) * 32768, Vf, O);
#pragma unroll
        for (int ti = 0; ti < 2; ++ti) { float s = 0.f;
#pragma unroll
            for (int r = 0; r < 16; ++r) s += O[ti][r] * O[ti][r];
            s += __shfl_xor(s, 32);
            if (g == 0) ssq[(32 * ti + j) * 8 + wid] = s; }
        __syncthreads();
        const float* gn = p.in[I_GNC] + l * 256;
#pragma unroll
        for (int ti = 0; ti < 2; ++ti) {
            float tot = 0.f;
#pragma unroll
            for (int w = 0; w < 8; ++w) tot += ssq[(32 * ti + j) * 8 + w];
            const float rstd = rsqrtf(tot * (1.0f / 256.0f) + EPS);
            bf16_t* rp = proj + (size_t)(row0 + 32 * ti + j) * PW + C_RC + h * 256 + 32 * wid + 4 * g;
#pragma unroll
            for (int q = 0; q < 4; ++q) {
                const u32x2 rw = *(const u32x2*)(rp + 8 * q);
                const f32x4 gv = *(const f32x4*)(gn + 32 * wid + 8 * q + 4 * g);
                const float r0 = bf_lo(rw.x), r1 = bf_hi(rw.x), r2 = bf_lo(rw.y), r3 = bf_hi(rw.y);
                const float y0 = O[ti][4 * q] * rstd * gv[0] * r0 * sigmoidf_(r0), y1 = O[ti][4 * q + 1] * rstd * gv[1] * r1 * sigmoidf_(r1);
                const float y2 = O[ti][4 * q + 2] * rstd * gv[2] * r2 * sigmoidf_(r2), y3 = O[ti][4 * q + 3] * rstd * gv[3] * r3 * sigmoidf_(r3);
                u32x2 w; w.x = pack2(y0, y1); w.y = pack2(y2, y3);
                *(u32x2*)(rp + 8 * q) = w;
            }
        }
        __syncthreads();
    }
}

#define CE_DESC(a, b) do { const float _hi = fmaxf(a, b), _lo = fminf(a, b); a = _hi; b = _lo; } while (0)
template <int N> DI void sort_desc(float (&v)[N]) {
#pragma unroll
    for (int k = 2; k <= N; k <<= 1)
#pragma unroll
        for (int jj = k >> 1; jj > 0; jj >>= 1)
#pragma unroll
            for (int i = 0; i < N; ++i) { const int x = i ^ jj; if (x > i) { if ((i & k) == 0) CE_DESC(v[i], v[x]); else CE_DESC(v[x], v[i]); } }
}
DI void merge_top16(float (&a)[16], const float (&b)[16]) {
#pragma unroll
    for (int i = 0; i < 16; ++i) a[i] = fmaxf(a[i], b[15 - i]);
#pragma unroll
    for (int jj = 8; jj > 0; jj >>= 1)
#pragma unroll
        for (int i = 0; i < 16; ++i) { const int x = i ^ jj; if (x > i) CE_DESC(a[i], a[x]); }
}
DI void merge_partner16(float (&a)[16]) {
    float b[16];
#pragma unroll
    for (int i = 0; i < 16; ++i) b[i] = __shfl_xor(a[i], 32);
    merge_top16(a, b);
}
DI void top16_of_64(float (&v)[64], float (&o)[16]) {
    float a[16], b[16];
#pragma unroll
    for (int i = 0; i < 16; ++i) { a[i] = v[i]; b[i] = v[16 + i]; }
    sort_desc<16>(a); sort_desc<16>(b); merge_top16(a, b);
#pragma unroll
    for (int i = 0; i < 16; ++i) { o[i] = v[32 + i]; b[i] = v[48 + i]; }
    sort_desc<16>(o); sort_desc<16>(b); merge_top16(o, b);
    merge_top16(o, a);
}
DI float bsel(int c, float a, float b) { const unsigned m = (unsigned)-(c != 0); return __uint_as_float((__float_as_uint(a) & m) | (__float_as_uint(b) & ~m)); }
DI float set_low(float f, unsigned mask, unsigned val) { return __uint_as_float((__float_as_uint(f) & ~mask) | val); }

DI void phase_peer_select(const Params& p, LAS unsigned char* lds) {
    const int tid = otid(), lane = tid & 63, wid = tid >> 6, j = lane & 31, g = lane >> 5;
    const bf16_t* pq = (const bf16_t*)(p.ws + WS_PQ);
    const bf16_t* subk = (const bf16_t*)(p.ws + WS_SUBK);
    int* pidx = (int*)(p.ws + WS_PIDX); float* pgw = (float*)(p.ws + WS_PG);
    LAS unsigned* tab = (LAS unsigned*)lds + wid * 2048;
    for (int it = blockIdx.x * 8 + wid; it < (NROW / 32) * 8; it += gridDim.x * 8) {
        const int ph = it & 7, r0 = (it >> 3) * 32;
        float top[2][16];
#pragma unroll
        for (int half = 0; half < 2; ++half) {
            bf16x8 Bq[8]; float ss = 0.f;
            const bf16_t* qp = pq + (size_t)(r0 + j) * 2048 + ph * 256 + half * 128 + 8 * g;
#pragma unroll
            for (int s = 0; s < 8; ++s) { const u32x4 w = *(const u32x4*)(qp + 16 * s); Bq[s] = __builtin_bit_cast(bf16x8, w);
                const float e0 = bf_lo(w.x), e1 = bf_hi(w.x), e2 = bf_lo(w.y), e3 = bf_hi(w.y), e4 = bf_lo(w.z), e5 = bf_hi(w.z), e6 = bf_lo(w.w), e7 = bf_hi(w.w);
                ss += e0 * e0 + e1 * e1 + e2 * e2 + e3 * e3 + e4 * e4 + e5 * e5 + e6 * e6 + e7 * e7; }
            ss += __shfl_xor(ss, 32);
            const float rstd = rsqrtf(ss * (1.0f / 128.0f) + EPS);
            const bf16_t* kp = subk + (size_t)((ph * 2 + half) * 128 + j) * 128 + 8 * g;
#pragma unroll
            for (int r = 0; r < 16; ++r) top[half][r] = -INFINITY;
#pragma unroll 1
            for (int kt = 0; kt < 4; ++kt) {
                f32x16 acc = zero16();
#pragma unroll
                for (int s = 0; s < 8; ++s) { const bf16x8 Af = *(const bf16x8*)(kp + (size_t)kt * 32 * 128 + 16 * s); acc = MFMA32(Af, Bq[s], acc); }
                float sc[16];
#pragma unroll
                for (int r = 0; r < 16; ++r) sc[r] = set_low(acc[r] * rstd, 127u, (unsigned)(32 * kt + (r & 3) + 8 * (r >> 2) + 4 * g));
                sort_desc<16>(sc);
                merge_top16(top[half], sc);
            }
            __builtin_amdgcn_sched_barrier(0);
            merge_partner16(top[half]);
        }
        float va[16], vb[16];
#pragma unroll
        for (int i = 0; i < 16; ++i) { va[i] = set_low(top[0][i], 127u, 0u); vb[i] = set_low(top[1][i], 127u, 0u);
            tab[i * 64 + lane] = __float_as_uint(top[0][i]) & 127u; tab[(16 + i) * 64 + lane] = __float_as_uint(top[1][i]) & 127u; }
        float cand[32];
#pragma unroll
        for (int i = 0; i < 27; ++i) {
            const int a = i < 16 ? 0 : (i < 23 ? 1 : (i < 26 ? 2 : 3));
            const int bb = i < 16 ? i : (i < 23 ? i - 15 : (i < 26 ? i - 21 : 3));
            const float s0 = va[a] + vb[bb], s1 = va[bb] + vb[a];
            float c = g ? s1 : s0;
            c = set_low(c, 255u, g ? (unsigned)(bb * 16 + a) : (unsigned)(a * 16 + bb));
            if (a == bb) c = g ? -INFINITY : c;
            cand[i] = c;
        }
#pragma unroll
        for (int i = 27; i < 32; ++i) cand[i] = -INFINITY;
        float ca[16], cb[16];
#pragma unroll
        for (int i = 0; i < 16; ++i) { ca[i] = cand[i]; cb[i] = cand[16 + i]; }
        sort_desc<16>(ca); sort_desc<16>(cb); merge_top16(ca, cb);
        merge_partner16(ca);
        const float mx = set_low(ca[0], 255u, 0u);
        float ev[16], sum = 0.f;
#pragma unroll
        for (int i = 0; i < 16; ++i) { ev[i] = __expf(set_low(ca[i], 255u, 0u) - mx); sum += ev[i]; }
        const float inv = 1.0f / sum;
        const size_t ob = (size_t)(r0 + j) * 128 + ph * 16 + 8 * g;
#pragma unroll
        for (int k = 0; k < 8; ++k) {
            const float cv = bsel(g, ca[8 + k], ca[k]); const float e = bsel(g, ev[8 + k], ev[k]);
            const unsigned pos = __float_as_uint(cv) & 255u;
            const unsigned i1 = tab[(pos >> 4) * 64 + lane], i2 = tab[(16 + (pos & 15)) * 64 + lane];
            pidx[ob + k] = (int)(i1 * 128u + i2); pgw[ob + k] = e * inv;
        }
    }
}

DI void phase_peer_gather(const Params& p, int l, const float* xin_lat, const float* xin_ctx, float* xo_lat, float* xo_ctx) {
    const int tid = otid(), lane = tid & 63, wid = tid >> 6;
    const bf16_t* h2 = (const bf16_t*)(p.ws + WS_H2);
    const bf16_t* pu = (const bf16_t*)(p.ws + WS_PU); const bf16_t* pv = (const bf16_t*)(p.ws + WS_PV);
    const int* pidx = (const int*)(p.ws + WS_PIDX); const float* pgw = (const float*)(p.ws + WS_PG);
    const float* mod = (const float*)(p.ws + WS_MOD) + (size_t)l * 3 * 6144;
    const bool last = (l == DEPTH - 1);
    const int nrows = last ? NLAT : NROW;
    const int kL = ((lane >> 5) & 1) * 8 + ((lane >> 4) & 1) * 4 + ((lane >> 3) & 1) * 2 + ((lane >> 2) & 1);
    for (int r = blockIdx.x * 8 + wid; r < nrows; r += gridDim.x * 8) {
        const u32x4 ha = *(const u32x4*)(h2 + (size_t)r * 1024 + 8 * lane), hb = *(const u32x4*)(h2 + (size_t)r * 1024 + 512 + 8 * lane);
        float hv[16];
        hv[0] = bf_lo(ha.x); hv[1] = bf_hi(ha.x); hv[2] = bf_lo(ha.y); hv[3] = bf_hi(ha.y); hv[4] = bf_lo(ha.z); hv[5] = bf_hi(ha.z); hv[6] = bf_lo(ha.w); hv[7] = bf_hi(ha.w);
        hv[8] = bf_lo(hb.x); hv[9] = bf_hi(hb.x); hv[10] = bf_lo(hb.y); hv[11] = bf_hi(hb.y); hv[12] = bf_lo(hb.z); hv[13] = bf_hi(hb.z); hv[14] = bf_lo(hb.w); hv[15] = bf_hi(hb.w);
        float out[16];
#pragma unroll
        for (int i = 0; i < 16; ++i) out[i] = 0.f;
        for (int ph = 0; ph < 8; ++ph) {
            const int my_idx = pidx[(size_t)r * 128 + ph * 16 + (lane & 15)];
            const float my_g = pgw[(size_t)r * 128 + ph * 16 + (lane & 15)];
            float d[16];
#pragma unroll
            for (int k = 0; k < 16; ++k) {
                const int e = __builtin_amdgcn_readlane(my_idx, k);
                const bf16_t* ub = pu + (size_t)e * 1024 + 8 * lane;
                const u32x4 ua = *(const u32x4*)ub, uc = *(const u32x4*)(ub + 512);
                float s = bf_lo(ua.x) * hv[0];
                s = fmaf(bf_hi(ua.x), hv[1], s); s = fmaf(bf_lo(ua.y), hv[2], s); s = fmaf(bf_hi(ua.y), hv[3], s); s = fmaf(bf_lo(ua.z), hv[4], s); s = fmaf(bf_hi(ua.z), hv[5], s);
                s = fmaf(bf_lo(ua.w), hv[6], s); s = fmaf(bf_hi(ua.w), hv[7], s); s = fmaf(bf_lo(uc.x), hv[8], s); s = fmaf(bf_hi(uc.x), hv[9], s); s = fmaf(bf_lo(uc.y), hv[10], s);
                s = fmaf(bf_hi(uc.y), hv[11], s); s = fmaf(bf_lo(uc.z), hv[12], s); s = fmaf(bf_hi(uc.z), hv[13], s); s = fmaf(bf_lo(uc.w), hv[14], s); s = fmaf(bf_hi(uc.w), hv[15], s);
                d[k] = s;
            }
            float t8[8], t4[4], t2[2], t1;
            { const bool up = (lane & 32) != 0;
#pragma unroll
                for (int k = 0; k < 8; ++k) { const float keep = up ? d[k + 8] : d[k], send = up ? d[k] : d[k + 8]; t8[k] = keep + __shfl_xor(send, 32); } }
            { const bool up = (lane & 16) != 0;
#pragma unroll
                for (int k = 0; k < 4; ++k) { const float keep = up ? t8[k + 4] : t8[k], send = up ? t8[k] : t8[k + 4]; t4[k] = keep + __shfl_xor(send, 16); } }
            { const bool up = (lane & 8) != 0;
#pragma unroll
                for (int k = 0; k < 2; ++k) { const float keep = up ? t4[k + 2] : t4[k], send = up ? t4[k] : t4[k + 2]; t2[k] = keep + __shfl_xor(send, 8); } }
            { const bool up = (lane & 4) != 0; const float keep = up ? t2[1] : t2[0], send = up ? t2[0] : t2[1]; t1 = keep + __shfl_xor(send, 4); }
            t1 += __shfl_xor(t1, 2); t1 += __shfl_xor(t1, 1);
            const float gk = __shfl(my_g, kL);
            const float wv = gk * 0.5f * t1 * (1.0f + erff(t1 * 0.70710678118654752f));
#pragma unroll
            for (int k = 0; k < 16; ++k) {
                const int e = __builtin_amdgcn_readlane(my_idx, k);
                const int src = ((k >> 3) & 1) * 32 + ((k >> 2) & 1) * 16 + ((k >> 1) & 1) * 8 + (k & 1) * 4;
                const float w = __uint_as_float((unsigned)__builtin_amdgcn_readlane((int)__float_as_uint(wv), src));
                const bf16_t* vb = pv + (size_t)e * 1024 + 8 * lane;
                const u32x4 ua = *(const u32x4*)vb, uc = *(const u32x4*)(vb + 512);
                out[0] = fmaf(w, bf_lo(ua.x), out[0]); out[1] = fmaf(w, bf_hi(ua.x), out[1]); out[2] = fmaf(w, bf_lo(ua.y), out[2]); out[3] = fmaf(w, bf_hi(ua.y), out[3]);
                out[4] = fmaf(w, bf_lo(ua.z), out[4]); out[5] = fmaf(w, bf_hi(ua.z), out[5]); out[6] = fmaf(w, bf_lo(ua.w), out[6]); out[7] = fmaf(w, bf_hi(ua.w), out[7]);
                out[8] = fmaf(w, bf_lo(uc.x), out[8]); out[9] = fmaf(w, bf_hi(uc.x), out[9]); out[10] = fmaf(w, bf_lo(uc.y), out[10]); out[11] = fmaf(w, bf_hi(uc.y), out[11]);
                out[12] = fmaf(w, bf_lo(uc.z), out[12]); out[13] = fmaf(w, bf_hi(uc.z), out[13]); out[14] = fmaf(w, bf_lo(uc.w), out[14]); out[15] = fmaf(w, bf_hi(uc.w), out[15]);
            }
        }
        if (DBG_ZERO & 8) {
#pragma unroll
            for (int i = 0; i < 16; ++i) out[i] = 0.f; }
        const bool lat = r < NLAT;
        const int mv = lat ? (r >> 14) : 2;
        const float* g2 = mod + mv * 6144 + 5 * 1024;
        const float* xi = lat ? xin_lat + (size_t)r * 1024 : xin_ctx + (size_t)(r - NLAT) * 1024;
        float* xo = lat ? xo_lat + (size_t)r * 1024 : xo_ctx + (size_t)(r - NLAT) * 1024;
#pragma unroll
        for (int hf = 0; hf < 2; ++hf)
#pragma unroll
            for (int q = 0; q < 2; ++q) { const int c = hf * 512 + 8 * lane + 4 * q;
                const f32x4 xv = *(const f32x4*)(xi + c), gv = *(const f32x4*)(g2 + c);
                f32x4 o; o[0] = xv[0] + gv[0] * out[hf * 8 + 4 * q]; o[1] = xv[1] + gv[1] * out[hf * 8 + 4 * q + 1]; o[2] = xv[2] + gv[2] * out[hf * 8 + 4 * q + 2]; o[3] = xv[3] + gv[3] * out[hf * 8 + 4 * q + 3];
                *(f32x4*)(xo + c) = o; }
    }
}

__global__ void __launch_bounds__(512, 2) hybrid_fwd(Params p) {
    extern __shared__ __attribute__((aligned(16))) unsigned char lds_raw[];
    LAS unsigned char* lds = (LAS unsigned char*)lds_raw;
    if (threadIdx.x == 0) *(LAS u32x4*)(lds + LDS_BARW) = (u32x4){0u, 0u, 0u, 0u};
    __syncthreads();
    XcdBarrier bar; bar.bar = (unsigned*)(p.ws + WS_CTL); bar.x = 0; bar.st = (volatile LAS unsigned*)(lds + LDS_BARW);
    if (p.use_bar) bar = xcd_barrier_post((unsigned*)(p.ws + WS_CTL), (volatile LAS unsigned*)(lds + LDS_BARW));
#define IN(ph) ((ph) >= p.gp_lo && (ph) < p.gp_hi)
#define SEAM() do { if (p.use_bar) xcd_barrier(bar); else __syncthreads(); } while (0)
    bf16_t* proj = (bf16_t*)(p.ws + WS_PROJ);
    float* ctxr = (float*)(p.ws + WS_CTX);
    if (IN(0)) { phase_mod(p, (LAS float*)lds); SEAM(); }
    for (int l = 0; l < DEPTH; ++l) {
        const int gb = 1 + l * NPH;
        const float* xin_lat = l == 0 ? p.in[I_X] : p.out;
        const float* xin_ctx = l == 0 ? p.in[I_CTX] : ctxr;
        if (IN(gb + 0)) { phase_convert(p, l, (LAS float*)lds); phase_norm(p, l, 0, xin_lat, xin_ctx, (bf16_t*)(p.ws + WS_H)); SEAM(); }
        if (IN(gb + 1)) {
            pg8::Gemm g{}; g.A = (const bf16_t*)(p.ws + WS_H); g.Bt = (const bf16_t*)(p.ws + WS_WIN); g.lda = 1024; g.ldb = 1024; g.K = 1024; g.bseg = 0;
            pg8::Order<1> so; so.init(NROW, 8704, gridDim.x, blockIdx.x);
            pg8::EpiBf16 e; e.O = proj; e.ldc = PW; e.ncols = PW;
            pg8::gemm_phase(lds, g, so, e); SEAM();
        }
        if (IN(gb + 2)) { phase_post(p, l, lds); SEAM(); }
        if (IN(gb + 3)) { phase_attn(p, l, lds); __syncthreads(); phase_gla1(p, l, lds); SEAM(); }
        if (IN(gb + 4)) { phase_gla2(p); SEAM(); }
        if (IN(gb + 5)) { phase_gla3(p, l, lds); SEAM(); }
        if (IN(gb + 6)) {
            pg8::Gemm g{}; g.A = proj; g.Bt = (const bf16_t*)(p.ws + WS_WO); g.lda = PW; g.ldb = 512; g.K = 512; g.bseg = (size_t)1024 * 512;
            g.ac0 = C_QA; g.ac1 = C_QB; g.ac2 = C_RC; g.ac3 = C_RC + 512;
            pg8::Order<4> so; so.init(NROW, 1024, gridDim.x, blockIdx.x);
            pg8::EpiMerge e; e.proj = proj; e.M32 = (float*)(p.ws + WS_M32); e.Mo = (bf16_t*)(p.ws + WS_M);
            pg8::gemm_phase(lds, g, so, e); SEAM();
        }
        if (IN(gb + 7)) {
            pg8::Gemm g{}; g.A = (const bf16_t*)(p.ws + WS_M); g.Bt = (const bf16_t*)(p.ws + WS_WOUT); g.lda = 1024; g.ldb = 1024; g.K = 1024; g.bseg = 0;
            pg8::Order<1> so; so.init(NROW, 1024, gridDim.x, blockIdx.x);
            pg8::EpiResid e; e.xin_lat = xin_lat; e.xin_ctx = xin_ctx; e.xout_lat = p.out; e.xout_ctx = ctxr; e.gate = (const float*)(p.ws + WS_MOD) + (size_t)l * 3 * 6144 + 2 * 1024;
            pg8::gemm_phase(lds, g, so, e); SEAM();
        }
        if (IN(gb + 8)) { phase_norm(p, l, 1, p.out, ctxr, (bf16_t*)(p.ws + WS_H2)); SEAM(); }
        if (IN(gb + 9)) {
            pg8::Gemm g{}; g.A = (const bf16_t*)(p.ws + WS_H2); g.Bt = (const bf16_t*)(p.ws + WS_WPQ); g.lda = 1024; g.ldb = 1024; g.K = 1024; g.bseg = 0;
            pg8::Order<1> so; so.init(NROW, 2048, gridDim.x, blockIdx.x);
            pg8::EpiBf16 e; e.O = (bf16_t*)(p.ws + WS_PQ); e.ldc = 2048; e.ncols = 2048;
            pg8::gemm_phase(lds, g, so, e); SEAM();
        }
        if (IN(gb + 10)) { phase_peer_select(p, lds); SEAM(); }
        if (IN(gb + 11)) { phase_peer_gather(p, l, p.out, ctxr, p.out, ctxr); SEAM(); }
    }
#undef IN
#undef SEAM
}

#ifndef MK_LAUNCHES
#define MK_LAUNCHES 0
#endif
extern "C" void kernel_launch(void* const* d_in, const int* in_sizes, int n_in, void* d_out, int out_size, void* d_ws, size_t ws_size, hipStream_t stream) {
    static int grid = 0;
    if (grid == 0) {
        if (n_in != 29 || in_sizes[0] != NLAT * D || out_size != NLAT * D || ws_size < WS_END) {
            fprintf(stderr, "kernel_launch: unexpected problem (n_in %d, in0 %d, out %d, ws %zu, need %zu); nothing launched\n", n_in, n_in > 0 ? in_sizes[0] : -1, out_size, ws_size, (size_t)WS_END); grid = -1; return; }
        int dev = 0, cus = 0, per_cu = 0;
        if (hipGetDevice(&dev) != hipSuccess || hipDeviceGetAttribute(&cus, hipDeviceAttributeMultiprocessorCount, dev) != hipSuccess) { grid = -1; return; }
        if (hipFuncSetAttribute((const void*)hybrid_fwd, hipFuncAttributeMaxDynamicSharedMemorySize, LDS_BYTES) != hipSuccess) { fprintf(stderr, "kernel_launch: hipFuncSetAttribute failed\n"); grid = -1; return; }
        if (hipOccupancyMaxActiveBlocksPerMultiprocessor(&per_cu, (const void*)hybrid_fwd, 512, LDS_BYTES) != hipSuccess || per_cu < 1) { fprintf(stderr, "kernel_launch: occupancy query says %d\n", per_cu); grid = -1; return; }
        (void)hipGetLastError();
        grid = cus;
    }
    if (grid < 0) return;
    (void)hipMemsetAsync((char*)d_ws + WS_CTL, 0, 65536, stream);
    Params p{};
    for (int i = 0; i < 29; ++i) p.in[i] = (const float*)d_in[i];
    p.out = (float*)d_out; p.ws = (unsigned char*)d_ws; p.pad0 = 0;
#if MK_LAUNCHES == 0
    p.gp_lo = 0; p.gp_hi = NGPH; p.use_bar = 1;
    hipLaunchKernelGGL(hybrid_fwd, dim3(grid), dim3(512), LDS_BYTES, stream, p);
#else
    p.use_bar = 0;
    for (int gp = 0; gp < NGPH; ++gp) { p.gp_lo = gp; p.gp_hi = gp + 1; hipLaunchKernelGGL(hybrid_fwd, dim3(grid), dim3(512), LDS_BYTES, stream, p); }
#endif
}
```

```cpp
#include <hip/hip_runtime.h>
#include <stdint.h>
#include <stdio.h>

#define DBG_ZERO 0
#define PROBE_MASK 0
#define PROBE_MULT 1
#define RPROBE 0
#define LAS __attribute__((address_space(3)))
#define DI __device__ __forceinline__
#define GAS __attribute__((address_space(1)))
typedef unsigned short bf16_t;
typedef short bf16x8 __attribute__((ext_vector_type(8)));
typedef float f32x4 __attribute__((ext_vector_type(4)));
typedef float f32x16 __attribute__((ext_vector_type(16)));
typedef unsigned u32x4 __attribute__((ext_vector_type(4)));
typedef unsigned u32x2 __attribute__((ext_vector_type(2)));

constexpr int D = 1024, NB = 2, S = 16384, LC = 256, DEPTH = 4;
constexpr int NLAT = NB * S;
constexpr int NROW = NLAT + NB * LC;
constexpr int PW = 8480;
constexpr int C_KA = 0, C_VA = 128, C_KB = 256, C_VB = 768, C_KC = 1280, C_VC = 1792, C_AC = 2816, C_QA = 2848, C_QB = 3360, C_QC = 3872, C_RC = 4384, C_GT = 5408;
constexpr int TOKB = S + LC;
constexpr int VTR = 1664;
constexpr int NCH = 260;
constexpr float EPS = 1e-6f;
constexpr float LOG2E = 1.4426950408889634f;
constexpr float O8_SCALE = 8.0f, WO8_SCALE = 64.0f;
constexpr float H8_SCALE = 8.0f, WIN8_SCALE = 64.0f;
constexpr int NPH = 15;
constexpr int NGPH = 1 + DEPTH * NPH;

constexpr size_t WS_CTL = 0;
constexpr size_t WS_MOD = 65536;
constexpr size_t WS_CTX = WS_MOD + 512 * 1024;
constexpr size_t WS_WIN = WS_CTX + 2 * 1024 * 1024;
constexpr size_t WS_WO = WS_WIN + (size_t)8704 * 1024 * 2;
constexpr size_t WS_WOUT = WS_WO + (size_t)3 * 1024 * 1024 * 2;
constexpr size_t WS_WPQ = WS_WOUT + (size_t)1024 * 1024 * 2;
constexpr size_t WS_SUBK = WS_WPQ + (size_t)2048 * 1024 * 2;
constexpr size_t WS_PU = WS_SUBK + 512 * 1024;
constexpr size_t WS_PV = WS_PU + (size_t)16384 * 1024 * 2;
constexpr size_t WS_PROJ = WS_PV + (size_t)16384 * 1024 * 2;
constexpr size_t WS_VT = WS_PROJ + (size_t)NROW * PW * 2;
constexpr size_t WS_DEC = WS_VT + (size_t)NB * VTR * TOKB * 2;
constexpr size_t WS_ST = WS_DEC + (size_t)16 * NCH * 128 * 4;
constexpr size_t WS_TU = WS_ST + (size_t)16 * NCH * 32768 * 2;
constexpr size_t WS_TV = WS_TU + (size_t)8 * 1024 * 1024;
constexpr size_t WS_WO8 = WS_TV + (size_t)8 * 1024 * 1024;
constexpr size_t WS_END = WS_WO8 + (size_t)3 * 1024 * 1024;
constexpr size_t WS_O8 = WS_PU;
constexpr size_t WS_H = WS_ST;
constexpr size_t WS_M = WS_ST + (size_t)NROW * 2048 * 2;
constexpr size_t WS_H2 = WS_VT;
constexpr size_t WS_PQ = WS_ST;
constexpr size_t WS_PART = WS_ST;
constexpr int CW_QUEUE = 4096;
constexpr size_t WS_PIDX = WS_PROJ;
constexpr size_t WS_PG = WS_PROJ + (size_t)NROW * 128 * 4;
static_assert(WS_M + (size_t)NROW * 1024 * 2 <= WS_END && (size_t)NROW * 1024 * 2 <= (size_t)NB * VTR * TOKB * 2 && WS_END <= ((size_t)1 << 30), "workspace map");

constexpr int LDS_CTRL = 1024;
constexpr int LDS_BYTES = 163840;
constexpr int LDS_BARW = 0;

DI float bf_lo(unsigned w) { return __uint_as_float(w << 16); }
DI float bf_hi(unsigned w) { return __uint_as_float(w & 0xffff0000u); }
DI float bf2f(bf16_t b) { return __uint_as_float((unsigned)b << 16); }
typedef __bf16 bf16v2 __attribute__((ext_vector_type(2)));
DI unsigned pack2(float lo, float hi) { bf16v2 v; v.x = (__bf16)lo; v.y = (__bf16)hi; return __builtin_bit_cast(unsigned, v); }
DI unsigned pack4_fp8(float a, float b, float c, float d) { int r = 0; r = __builtin_amdgcn_cvt_pk_fp8_f32(a, b, r, false); r = __builtin_amdgcn_cvt_pk_fp8_f32(c, d, r, true); return (unsigned)r; }
DI bf16_t f2bf(float f) { return (bf16_t)(pack2(f, 0.f) & 0xffffu); }
DI float wave_sum(float v) {
#pragma unroll
    for (int o = 32; o > 0; o >>= 1) v += __shfl_xor(v, o);
    return v;
}
DI int otid() { int t = threadIdx.x; asm volatile("" : "+v"(t)); return t; }
template <class T> DI T* opq(T* ptr) { const unsigned slo = (unsigned)(uintptr_t)ptr, shi = (unsigned)((uintptr_t)ptr >> 32); unsigned lo, hi;
    asm volatile("v_mov_b32 %0, %2\n\tv_mov_b32 %1, %3" : "=v"(lo), "=v"(hi) : "s"(slo), "s"(shi));
    lo = (unsigned)__builtin_amdgcn_readfirstlane((int)lo); hi = (unsigned)__builtin_amdgcn_readfirstlane((int)hi); return (T*)(GAS T*)(((uintptr_t)hi << 32) | (uintptr_t)lo); }
DI float sigmoidf_(float x) { return __builtin_amdgcn_rcpf(1.0f + __builtin_amdgcn_exp2f(x * -LOG2E)); }
DI f32x16 zero16() { f32x16 z; for (int i = 0; i < 16; ++i) z[i] = 0.f; return z; }
#define MFMA32(a, b, c) __builtin_amdgcn_mfma_f32_32x32x16_bf16((a), (b), (c), 0, 0, 0)
DI int pi32(int i) { return (i & 0x13) | ((i & 8) >> 1) | ((i & 4) << 1); }

#define XB_TMO      128
#define XB_XCNT(j)  (256  + 64 * (j))
#define XB_XSUB(j)  (1280 + 64 * (j))
#define XB_XGEN(j)  (2304 + 64 * (j))
#define XB_TOP      3328
#define XB_TOPGEN   3392
#define XCD_BAR_WORDS 3456
#define XB_SPIN_CAP (1u << 22)
DI unsigned xb_ld(unsigned* p)              { return __hip_atomic_load(p, __ATOMIC_RELAXED, __HIP_MEMORY_SCOPE_AGENT); }
DI unsigned xb_add(unsigned* p, unsigned v) { return __hip_atomic_fetch_add(p, v, __ATOMIC_RELAXED, __HIP_MEMORY_SCOPE_AGENT); }
DI unsigned xb_xcc_id() { return (unsigned)__builtin_amdgcn_s_getreg((3 << 11) | 20) & 0xFu; }
#define XB_SPIN(cond, bar) do { unsigned _sp = 0; while (cond) { __builtin_amdgcn_s_sleep(1); \
    if ((++_sp & 255u) == 0u) { if (xb_ld(&(bar)[XB_TMO])) break; if (_sp > XB_SPIN_CAP) { atomicAdd(&(bar)[XB_TMO], 1u); break; } } } } while (0)
struct XcdBarrier { unsigned* bar; unsigned x; volatile LAS unsigned* st; };
DI XcdBarrier xcd_barrier_post(unsigned* bar, volatile LAS unsigned* st) {
    XcdBarrier b; b.bar = bar; b.x = xb_xcc_id(); b.st = st;
    if (threadIdx.x == 0) (void)xb_add(&bar[XB_XCNT(b.x)], 1u);
    return b;
}
DI void xcd_barrier_complete(unsigned* bar, unsigned x, unsigned& nloc, unsigned& nx) {
    const unsigned G = gridDim.x * gridDim.y * gridDim.z;
    unsigned sum, cnt, mine, sp = 0u;
    for (;;) {
        sum = 0u; cnt = 0u; mine = 0u;
#pragma unroll
        for (unsigned j = 0; j < 16; ++j) { const unsigned c = xb_ld(&bar[XB_XCNT(j)]); sum += c; cnt += (c > 0u) ? 1u : 0u; mine = (j == x) ? c : mine; }
        if (sum == G) break;
        __builtin_amdgcn_s_sleep(1);
        if ((++sp & 255u) == 0u) { if (xb_ld(&bar[XB_TMO])) break; if (sp > XB_SPIN_CAP) { atomicAdd(&bar[XB_TMO], 1u); break; } }
    }
    nloc = mine > 0u ? mine : 1u; nx = cnt > 0u ? cnt : 1u;
}
DI void xcd_barrier(const XcdBarrier& b) {
    asm volatile("s_waitcnt vmcnt(0)" ::: "memory");
    __syncthreads();
    if (threadIdx.x == 0) {
        unsigned* bar = b.bar;
        __builtin_amdgcn_s_waitcnt(0);
        unsigned nloc = b.st[0], nx = b.st[1];
        if (nloc == 0u) { xcd_barrier_complete(bar, b.x, nloc, nx); b.st[0] = nloc; b.st[1] = nx; }
        const unsigned old = xb_add(&bar[XB_XSUB(b.x)], 1u);
        const unsigned gen = old / nloc;
        if (old + 1u == (gen + 1u) * nloc) {
            __builtin_amdgcn_fence(__ATOMIC_RELEASE, "agent");
            asm volatile("s_waitcnt vmcnt(0)" ::: "memory");
            const unsigned og = xb_add(&bar[XB_TOP], 1u);
            const unsigned tg = og / nx;
            if (og + 1u == (tg + 1u) * nx) xb_add(&bar[XB_TOPGEN], 1u);
            else XB_SPIN(xb_ld(&bar[XB_TOPGEN]) == tg, bar);
            __builtin_amdgcn_fence(__ATOMIC_ACQUIRE, "agent");
            xb_add(&bar[XB_XGEN(b.x)], 1u);
            asm volatile("s_waitcnt vmcnt(0)" ::: "memory");
        } else {
            XB_SPIN(xb_ld(&bar[XB_XGEN(b.x)]) == gen, bar);
            __builtin_amdgcn_fence(__ATOMIC_ACQUIRE, "agent");
            asm volatile("s_waitcnt vmcnt(0)" ::: "memory");
        }
    }
    __syncthreads();
}

struct Params {
    const float* in[29];
    float* out;
    unsigned char* ws;
    int gp_lo, gp_hi;
    int use_bar, pad0;
};
extern __shared__ __attribute__((aligned(16))) unsigned char lds_raw[];
constexpr int LDS_PTRS = LDS_BARW + 64;
DI const float* pin_ld(int i) { const LAS unsigned* t = (const LAS unsigned*)((LAS unsigned char*)lds_raw + LDS_PTRS) + 2 * i;
    const unsigned lo = (unsigned)__builtin_amdgcn_readfirstlane((int)t[0]), hi = (unsigned)__builtin_amdgcn_readfirstlane((int)t[1]); return (const float*)(GAS const float*)(((uintptr_t)hi << 32) | (uintptr_t)lo); }
#define PIN(i) pin_ld(i)
DI unsigned long long rp_now() { return RPROBE ? __builtin_amdgcn_s_memrealtime() : 0ull; }
DI void rp_add(int id, unsigned long long t0) { if (RPROBE != 0 && RPROBE == id && threadIdx.x == 0) { LAS unsigned long long* a = (LAS unsigned long long*)((LAS unsigned char*)lds_raw + 512); *a += __builtin_amdgcn_s_memrealtime() - t0; } }
DI unsigned char* ws_ptr() {
    typedef __attribute__((address_space(4))) const unsigned char* kptr;
    kptr ka = (kptr)__builtin_amdgcn_kernarg_segment_ptr();
    unsigned off = (unsigned)__builtin_offsetof(Params, ws); asm volatile("" : "+s"(off));
    const unsigned long long v = *(__attribute__((address_space(4))) const unsigned long long*)(ka + off);
    return (unsigned char*)(GAS unsigned char*)v; }
enum { I_X = 0, I_C, I_CTX, I_CCTX, I_WMOD, I_BMOD, I_NORM1, I_NORM2, I_WIN, I_QNA, I_KNA, I_SINKA, I_QNB, I_KNB, I_RPB, I_WA2F, I_BAF, I_WA2B, I_BAB, I_GNC, I_WOA, I_WOB, I_WOC, I_WOUT, I_WPQ, I_PQG, I_SUBK, I_PU, I_PV };

namespace pg8 {
constexpr int BM = 256, BK = 64, HALF = 128, HTB = HALF * BK * 2, STAGE_BYTES = 8 * HTB, NXCD = 8, WGM = 8;
DI int lds_byte(int r, int c) { const int st = (r >> 4) * 2 + (c >> 5), rr = r & 15, cc = c & 31, ob = rr * 64 + cc * 2; return st * 1024 + (ob ^ (((ob >> 9) & 1) << 5)); }
DI void stage_rc(int b, int& R, int& C) { const int st = b / 1024, sb = b % 1024, swz = sb ^ (((sb >> 9) & 1) << 5); R = (st >> 1) * 16 + swz / 64; C = (st & 1) * 32 + (swz % 64) / 2; }
DI int perm32(int rho) { const int n = rho >> 4, i = rho & 15; return 8 * (i >> 2) + 4 * n + (i & 3); }
struct Unit { int pm, pn, seg; };
struct Gemm { const bf16_t* A; const bf16_t* Bt; int lda, ldb, K; int ac0, ac1, ac2, ac3; int k0, k1, k2, k3; size_t bseg; };
DI int gemm_kseg(const Gemm& g, int seg) { const int k = seg == 0 ? g.k0 : (seg == 1 ? g.k1 : (seg == 2 ? g.k2 : g.k3)); return k ? k : g.K; }
DI int gemm_acol(const Gemm& g, int seg) { return seg == 0 ? g.ac0 : (seg == 1 ? g.ac1 : (seg == 2 ? g.ac2 : g.ac3)); }
template <int NSEG> struct Order {
    int nM, nN, nwg, G, c;
    DI void init(int M, int N, int G_, int c_) { nM = M / BM; nN = N / BM; nwg = nM * nN; G = G_; c = c_; }
    DI bool next(int i, Unit& u) const {
        const int t = i / NSEG; u.seg = i - t * NSEG;
        const long L = (long)t * G + c; if (L >= nwg) return false;
        int wgid = (int)L; { const int q = nwg / NXCD, r = nwg % NXCD, xcd = wgid % NXCD, off = wgid / NXCD; wgid = (xcd < r ? xcd * (q + 1) : r * (q + 1) + (xcd - r) * q) + off; }
        const int nig = WGM * nN, gid = wgid / nig, fm = gid * WGM, gsz = (nM - fm) < WGM ? (nM - fm) : WGM;
        u.pm = fm + ((wgid % nig) % gsz); u.pn = (wgid % nig) / gsz; return true;
    }
};
DI unsigned cvt_pk_bf16(float lo, float hi) { unsigned r; asm volatile("v_cvt_pk_bf16_f32 %0, %1, %2" : "=v"(r) : "v"(lo), "v"(hi)); return r; }

template <int FP8, class Epi, class Sched>
DI void gemm_phase(LAS unsigned char* lds, const Gemm g, const Sched& S, const Epi& E, int rpid) {
    const int tid = otid(), wid = __builtin_amdgcn_readfirstlane(tid >> 6), lane = tid & 63, wr = wid >> 2, wc = wid & 3, fr = lane & 15, fq = lane >> 4;
    unsigned voffA[2], voffB[2];
#pragma unroll
    for (int i = 0; i < 2; ++i) { int R, C; stage_rc(tid * 16 + i * 8192, R, C); const int Rb = Epi::PERM ? ((R & ~31) + perm32(R & 31)) : R;
        voffA[i] = (unsigned)(R * g.lda + C) * 2u; voffB[i] = (unsigned)(Rb * g.ldb + C) * 2u; }
    const size_t kstep = (size_t)(BK * 2);
    const size_t hstepA = (size_t)HALF * g.lda * 2, hstepB = (size_t)HALF * g.ldb * 2;
    const unsigned ldsw = (unsigned)wid * 1024u;
    const int aoff = lds_byte(wr * 64 + fr, fq * 8), boff = lds_byte(wc * 32 + fr, fq * 8);
#define PG8_SA(b, h) (((b) * 2 + (h)) * HTB)
#define PG8_SB(b, h) ((4 + (b) * 2 + (h)) * HTB)
#define PG8_STAGE(bufoff, gbase, voff) do { _Pragma("unroll") for (int _i = 0; _i < 2; ++_i) \
        __builtin_amdgcn_global_load_lds((const unsigned*)((const char*)(gbase) + (voff)[_i]), (LAS unsigned*)(lds + (bufoff) + ldsw + _i * 8192), 16, 0, 0); } while (0)
#define PG8_FRAG(off) (*(const LAS bf16x8*)(lds + (off)))
#define PG8_LDA(dst, b, h) do { _Pragma("unroll") for (int m = 0; m < 4; ++m) { if (FP8) dst##8[m] = __builtin_shufflevector(__builtin_bit_cast(i32x4_, PG8_FRAG(PG8_SA(b, h) + aoff + m * 2048)), __builtin_bit_cast(i32x4_, PG8_FRAG(PG8_SA(b, h) + aoff + m * 2048 + 1024)), 0, 1, 2, 3, 4, 5, 6, 7); \
        else { _Pragma("unroll") for (int k = 0; k < 2; ++k) dst[m][k] = PG8_FRAG(PG8_SA(b, h) + aoff + m * 2048 + k * 1024); } } } while (0)
#define PG8_LDB(dst, b, h) do { _Pragma("unroll") for (int n = 0; n < 2; ++n) { if (FP8) dst##8[n] = __builtin_shufflevector(__builtin_bit_cast(i32x4_, PG8_FRAG(PG8_SB(b, h) + boff + n * 2048)), __builtin_bit_cast(i32x4_, PG8_FRAG(PG8_SB(b, h) + boff + n * 2048 + 1024)), 0, 1, 2, 3, 4, 5, 6, 7); \
        else { _Pragma("unroll") for (int k = 0; k < 2; ++k) dst[n][k] = PG8_FRAG(PG8_SB(b, h) + boff + n * 2048 + k * 1024); } } } while (0)
#define PG8_MMA(ai, bj, At, Bt) do { __builtin_amdgcn_s_setprio(1); _Pragma("unroll") for (int m = 0; m < 4; ++m) _Pragma("unroll") for (int n = 0; n < 2; ++n) { \
        if (FP8) asm volatile("v_mfma_scale_f32_16x16x128_f8f6f4 %0, %1, %2, %0, %3, %3 op_sel_hi:[0,0,0]" : "+v"(acc[ai][bj][m][n]) : "v"(Bt##8[n]), "v"(At##8[m]), "v"(sc127));   \
        else { _Pragma("unroll") for (int k = 0; k < 2; ++k) acc[ai][bj][m][n] = __builtin_amdgcn_mfma_f32_16x16x32_bf16(Bt[n][k], At[m][k], acc[ai][bj][m][n], 0, 0, 0); } } \
        __builtin_amdgcn_s_setprio(0); } while (0)
#define PG8_WAIT_V(n) asm volatile("s_waitcnt vmcnt(" #n ")" ::: "memory")
#define PG8_WAIT_L(n) asm volatile("s_waitcnt lgkmcnt(" #n ")" ::: "memory")
#define PG8_BAR __builtin_amdgcn_s_barrier()
#define PG8_SCHED __builtin_amdgcn_sched_barrier(0)
#define PG8_APTR(u) ((const char*)g.A + ((size_t)(u).pm * BM * g.lda + (size_t)gemm_acol(g, (u).seg)) * 2)
#define PG8_BPTR(u) ((const char*)g.Bt + ((size_t)(u).seg * g.bseg + (size_t)(u).pn * BM * g.ldb) * 2)
    Unit cur, nxt; int ui = 0;
    if (!S.next(0, cur)) return;
    f32x4 acc[2][2][4][2];
#pragma unroll
    for (int a = 0; a < 2; ++a)
#pragma unroll
        for (int b = 0; b < 2; ++b)
#pragma unroll
            for (int m = 0; m < 4; ++m)
#pragma unroll
                for (int n = 0; n < 2; ++n) acc[a][b][m][n] = (f32x4){0.f, 0.f, 0.f, 0.f};
    typedef int i32x4_ __attribute__((ext_vector_type(4))); typedef int i32x8_ __attribute__((ext_vector_type(8)));
    bf16x8 At[4][2], B0[2][2], B1[2][2];
    i32x8_ At8[4], B08[2], B18[2];
    int sc127 = 127; asm volatile("" : "+v"(sc127));
    const char* cA = PG8_APTR(cur); const char* cB = PG8_BPTR(cur);
    PG8_STAGE(PG8_SB(0, 0), cB, voffB); PG8_STAGE(PG8_SA(0, 0), cA, voffA); PG8_STAGE(PG8_SB(0, 1), cB + hstepB, voffB); PG8_STAGE(PG8_SA(0, 1), cA + hstepA, voffA);
    if (wr == 1) PG8_BAR;
    PG8_WAIT_V(4); PG8_BAR;
    PG8_STAGE(PG8_SB(1, 0), cB + kstep, voffB); PG8_STAGE(PG8_SA(1, 0), cA + kstep, voffA); PG8_STAGE(PG8_SB(1, 1), cB + hstepB + kstep, voffB);
    PG8_WAIT_V(6); PG8_BAR;
    for (;;) {
        const bool has_next = S.next(ui + 1, nxt);
        const int nt = gemm_kseg(g, cur.seg) / BK;
        const char* nA = has_next ? PG8_APTR(nxt) : cA; const char* nB = has_next ? PG8_BPTR(nxt) : cB;
        for (int t = 0; t < nt; t += 2) {
            const bool last = (t == nt - 2);
            const char* a1 = cA + (size_t)(t + 1) * kstep;
            const char* a2 = last ? nA : cA + (size_t)(t + 2) * kstep; const char* b2 = last ? nB : cB + (size_t)(t + 2) * kstep;
            const char* a3 = a2 + kstep; const char* b3 = b2 + kstep;
            PG8_LDB(B0, 0, 0); PG8_SCHED; PG8_LDA(At, 0, 0); PG8_STAGE(PG8_SA(1, 1), a1 + hstepA, voffA);
            PG8_WAIT_L(8); PG8_BAR; PG8_WAIT_L(0); PG8_MMA(0, 0, At, B0); PG8_BAR; PG8_SCHED;
            PG8_LDB(B1, 0, 1); PG8_STAGE(PG8_SB(0, 0), b2, voffB);
            PG8_BAR; PG8_WAIT_L(0); PG8_MMA(0, 1, At, B1); PG8_BAR;
            PG8_LDA(At, 0, 1); PG8_STAGE(PG8_SA(0, 0), a2, voffA);
            PG8_BAR; PG8_WAIT_L(0); PG8_MMA(1, 0, At, B0); PG8_BAR; PG8_SCHED;
            PG8_STAGE(PG8_SB(0, 1), b2 + hstepB, voffB);
            PG8_WAIT_V(6); PG8_BAR; PG8_MMA(1, 1, At, B1); PG8_BAR;
            PG8_LDB(B0, 1, 0); PG8_SCHED; PG8_LDA(At, 1, 0); PG8_STAGE(PG8_SA(0, 1), a2 + hstepA, voffA);
            PG8_WAIT_L(8); PG8_BAR; PG8_WAIT_L(0); PG8_MMA(0, 0, At, B0); PG8_BAR; PG8_SCHED;
            PG8_LDB(B1, 1, 1); PG8_STAGE(PG8_SB(1, 0), b3, voffB);
            PG8_BAR; PG8_WAIT_L(0); PG8_MMA(0, 1, At, B1); PG8_BAR;
            PG8_LDA(At, 1, 1); PG8_STAGE(PG8_SA(1, 0), a3, voffA);
            PG8_BAR; PG8_WAIT_L(0); PG8_MMA(1, 0, At, B0); PG8_BAR; PG8_SCHED;
            PG8_STAGE(PG8_SB(1, 1), b3 + hstepB, voffB);
            PG8_WAIT_V(6); PG8_BAR; PG8_MMA(1, 1, At, B1); PG8_BAR;
        }
        if (FP8) asm volatile("s_nop 15\n\ts_nop 15" ::: "memory");
        { const unsigned long long rt = rp_now(); E(acc, cur, wr, wc, fr, fq); if (RPROBE) asm volatile("s_waitcnt vmcnt(0)" ::: "memory"); rp_add(rpid, rt); }
        if (!has_next) break;
#pragma unroll
        for (int a = 0; a < 2; ++a)
#pragma unroll
            for (int b = 0; b < 2; ++b)
#pragma unroll
                for (int m = 0; m < 4; ++m)
#pragma unroll
                    for (int n = 0; n < 2; ++n) acc[a][b][m][n] = (f32x4){0.f, 0.f, 0.f, 0.f};
        cur = nxt; cA = nA; cB = nB; ++ui;
    }
    PG8_WAIT_V(0);
    if (wr == 0) PG8_BAR;
    PG8_BAR;
#undef PG8_SA
#undef PG8_SB
#undef PG8_STAGE
#undef PG8_FRAG
#undef PG8_LDA
#undef PG8_LDB
#undef PG8_MMA
#undef PG8_WAIT_V
#undef PG8_WAIT_L
#undef PG8_BAR
#undef PG8_SCHED
#undef PG8_APTR
#undef PG8_BPTR
}

struct EpiBf16 {
    static constexpr bool PERM = true;
    bf16_t* O; int ldc, ncols; float oscale;
    DI void operator()(const f32x4 (&acc)[2][2][4][2], const Unit& u, int wr, int wc, int fr, int fq) const {
        const int row0 = u.pm * BM + wr * 64 + fr, col0 = u.pn * BM + wc * 32 + 8 * fq;
#pragma unroll
        for (int ai = 0; ai < 2; ++ai)
#pragma unroll
            for (int m = 0; m < 4; ++m) { bf16_t* rowp = O + (size_t)(row0 + ai * HALF + m * 16) * ldc + col0;
#pragma unroll
                for (int bj = 0; bj < 2; ++bj) { const f32x4 v0 = acc[ai][bj][m][0] * oscale, v1 = acc[ai][bj][m][1] * oscale;
                    u32x4 w; w.x = cvt_pk_bf16(v0[0], v0[1]); w.y = cvt_pk_bf16(v0[2], v0[3]); w.z = cvt_pk_bf16(v1[0], v1[1]); w.w = cvt_pk_bf16(v1[2], v1[3]);
                    if (col0 + bj * HALF < ncols) *(u32x4*)(rowp + bj * HALF) = w; } }
    }
};
struct EpiMerge {
    static constexpr bool PERM = true;
    const bf16_t* proj; bf16_t* Mo; float oscale;
    DI void operator()(const f32x4 (&acc)[2][2][4][2], const Unit& u, int wr, int wc, int fr, int fq) const {
        const int row0 = u.pm * BM + wr * 64 + fr, col0 = u.pn * BM + wc * 32 + 8 * fq;
        const int gsel = u.seg;
        const bf16_t* gbase = proj + (size_t)row0 * PW + C_GT + gsel * 1024 + col0;
        bf16_t* mbase = Mo + (size_t)row0 * 1024 + col0;
#pragma unroll
        for (int ai = 0; ai < 2; ++ai) {
            u32x4 gw[4][2], pw[4][2];
#pragma unroll
            for (int m = 0; m < 4; ++m)
#pragma unroll
                for (int bj = 0; bj < 2; ++bj) {
                    gw[m][bj] = *(const u32x4*)(gbase + (size_t)(ai * HALF + m * 16) * PW + bj * HALF);
                    pw[m][bj] = u.seg > 0 ? *(const u32x4*)(mbase + (size_t)(ai * HALF + m * 16) * 1024 + bj * HALF) : (u32x4){0u, 0u, 0u, 0u};
                }
#pragma unroll
            for (int m = 0; m < 4; ++m)
#pragma unroll
                for (int bj = 0; bj < 2; ++bj) {
                    const u32x4 g4 = gw[m][bj], p4 = pw[m][bj];
                    f32x4 v0 = acc[ai][bj][m][0] * oscale, v1 = acc[ai][bj][m][1] * oscale;
                    v0[0] *= sigmoidf_(bf_lo(g4.x)); v0[1] *= sigmoidf_(bf_hi(g4.x)); v0[2] *= sigmoidf_(bf_lo(g4.y)); v0[3] *= sigmoidf_(bf_hi(g4.y));
                    v1[0] *= sigmoidf_(bf_lo(g4.z)); v1[1] *= sigmoidf_(bf_hi(g4.z)); v1[2] *= sigmoidf_(bf_lo(g4.w)); v1[3] *= sigmoidf_(bf_hi(g4.w));
                    if (DBG_ZERO & (1 << gsel)) { v0 *= 0.f; v1 *= 0.f; }
                    v0[0] += bf_lo(p4.x); v0[1] += bf_hi(p4.x); v0[2] += bf_lo(p4.y); v0[3] += bf_hi(p4.y); v1[0] += bf_lo(p4.z); v1[1] += bf_hi(p4.z); v1[2] += bf_lo(p4.w); v1[3] += bf_hi(p4.w);
                    u32x4 w; w.x = cvt_pk_bf16(v0[0], v0[1]); w.y = cvt_pk_bf16(v0[2], v0[3]); w.z = cvt_pk_bf16(v1[0], v1[1]); w.w = cvt_pk_bf16(v1[2], v1[3]);
                    *(u32x4*)(mbase + (size_t)(ai * HALF + m * 16) * 1024 + bj * HALF) = w;
                }
        }
    }
};
struct EpiResid {
    static constexpr bool PERM = false;
    const float* xin_lat; const float* xin_ctx; float* xout_lat; float* xout_ctx; const float* gate;
    DI void operator()(const f32x4 (&acc)[2][2][4][2], const Unit& u, int wr, int wc, int fr, int fq) const {
        const int rowt = u.pm * BM;
        const bool lat = rowt < NLAT;
        const int mv = lat ? (rowt >> 14) : 2;
        const float* xin = lat ? xin_lat + (size_t)rowt * 1024 : xin_ctx + (size_t)(rowt - NLAT) * 1024;
        float* xo = lat ? xout_lat + (size_t)rowt * 1024 : xout_ctx + (size_t)(rowt - NLAT) * 1024;
        const int r0 = wr * 64 + fr, col0 = u.pn * BM + wc * 32 + 4 * fq;
        const float* gp = gate + mv * 6144 + col0;
        f32x4 gv[2][2];
#pragma unroll
        for (int bj = 0; bj < 2; ++bj)
#pragma unroll
            for (int n = 0; n < 2; ++n) gv[bj][n] = *(const f32x4*)(gp + bj * HALF + n * 16);
#pragma unroll
        for (int ai = 0; ai < 2; ++ai)
#pragma unroll
            for (int mh = 0; mh < 2; ++mh) {
                f32x4 xv[2][2][2];
#pragma unroll
                for (int m2 = 0; m2 < 2; ++m2)
#pragma unroll
                    for (int bj = 0; bj < 2; ++bj)
#pragma unroll
                        for (int n = 0; n < 2; ++n) xv[m2][bj][n] = *(const f32x4*)(xin + (unsigned)(r0 + ai * HALF + (mh * 2 + m2) * 16) * 1024u + (unsigned)(col0 + bj * HALF + n * 16));
#pragma unroll
                for (int m2 = 0; m2 < 2; ++m2)
#pragma unroll
                    for (int bj = 0; bj < 2; ++bj)
#pragma unroll
                        for (int n = 0; n < 2; ++n) *(f32x4*)(xo + (unsigned)(r0 + ai * HALF + (mh * 2 + m2) * 16) * 1024u + (unsigned)(col0 + bj * HALF + n * 16)) = xv[m2][bj][n] + gv[bj][n] * acc[ai][bj][mh * 2 + m2][n];
            }
    }
};
}

DI f32x4 ctx_tile16(const bf16_t* A, int lda, const bf16_t* Bt, int ldb, int K, int lane) {
    const bf16_t* ap = A + (size_t)(lane & 15) * lda + 8 * (lane >> 4);
    const bf16_t* bp = Bt + (size_t)(lane & 15) * ldb + 8 * (lane >> 4);
    f32x4 acc0 = (f32x4){0.f, 0.f, 0.f, 0.f}, acc1 = acc0;
#pragma unroll 1
    for (int k = 0; k < K; k += 512) {
        bf16x8 a[16], b[16];
#pragma unroll
        for (int i = 0; i < 16; ++i) { a[i] = *(const bf16x8*)(ap + k + 32 * i); b[i] = *(const bf16x8*)(bp + k + 32 * i); }
#pragma unroll
        for (int i = 0; i < 16; i += 2) { acc0 = __builtin_amdgcn_mfma_f32_16x16x32_bf16(a[i], b[i], acc0, 0, 0, 0); acc1 = __builtin_amdgcn_mfma_f32_16x16x32_bf16(a[i + 1], b[i + 1], acc1, 0, 0, 0); }
    }
    return acc0 + acc1;
}
DI void phase_ctx_gemm(const Params& p, int l, int which, const float* xin_ctx) {
    unsigned char* const ws = ws_ptr();
    const int tid = otid(), lane = tid & 63, wid = tid >> 6;
    const bf16_t* proj = (const bf16_t*)(ws + WS_PROJ);
    bf16_t* Mo = (bf16_t*)(ws + WS_M);
    const int ncolt = which == 2 ? 128 : 64, ntile = 32 * ncolt;
    for (int wt = blockIdx.x * 8 + wid; wt < ntile; wt += gridDim.x * 8) {
        const int tr = wt / ncolt, tc = wt - tr * ncolt;
        const int r0 = NLAT + 16 * tr, c0 = 16 * tc;
        const int rowq = r0 + (lane >> 4) * 4, col = c0 + (lane & 15);
        if (which == 0) {
            f32x4 tot = (f32x4){0.f, 0.f, 0.f, 0.f};
#pragma unroll
            for (int seg = 0; seg < 3; ++seg) {
                const int acol = seg == 0 ? C_QA : (seg == 1 ? C_QB : C_RC), kk = seg == 2 ? 1024 : 512;
                const f32x4 acc = ctx_tile16(proj + (size_t)r0 * PW + acol, PW, (const bf16_t*)(ws + WS_WO) + (size_t)seg * 1024 * 1024 + (size_t)c0 * 1024, 1024, kk, lane);
#pragma unroll
                for (int q = 0; q < 4; ++q) tot[q] += sigmoidf_(bf2f(proj[(size_t)(rowq + q) * PW + C_GT + seg * 1024 + col])) * acc[q];
            }
#pragma unroll
            for (int q = 0; q < 4; ++q) Mo[(size_t)(rowq + q) * 1024 + col] = f2bf(tot[q]);
        } else if (which == 1) {
            const f32x4 acc = ctx_tile16(Mo + (size_t)r0 * 1024, 1024, (const bf16_t*)(ws + WS_WOUT) + (size_t)c0 * 1024, 1024, 1024, lane);
            const float g1 = ((const float*)(ws + WS_MOD))[((size_t)l * 3 + 2) * 6144 + 2 * 1024 + col];
            float* xo = (float*)(ws + WS_CTX);
#pragma unroll
            for (int q = 0; q < 4; ++q) { const size_t o = (size_t)(rowq + q - NLAT) * 1024 + col; xo[o] = xin_ctx[o] + g1 * acc[q]; }
        } else {
            const f32x4 acc = ctx_tile16((const bf16_t*)(ws + WS_H2) + (size_t)r0 * 1024, 1024, (const bf16_t*)(ws + WS_WPQ) + (size_t)c0 * 1024, 1024, 1024, lane);
            bf16_t* pq = (bf16_t*)(ws + WS_PQ);
#pragma unroll
            for (int q = 0; q < 4; ++q) pq[(size_t)(rowq + q) * 2048 + col] = f2bf(acc[q]);
        }
    }
}

DI void phase_mod(const Params& p, LAS float* lds) {
    unsigned char* const ws = ws_ptr();
    const int tid = otid();
    LAS float* act = lds;
    LAS float* red = lds + 3072;
    for (int i = tid; i < 3072; i += 512) { const int v = i >> 10, k = i & 1023; const float x = v < 2 ? PIN(I_C)[v * 1024 + k] : PIN(I_CCTX)[k]; act[i] = x / (1.0f + __expf(-x)); }
    __syncthreads();
    float* mod = (float*)(ws + WS_MOD);
    const int c4 = tid & 7, kg = tid >> 3;
    for (int cb = blockIdx.x; cb < 768; cb += gridDim.x) {
        const int l = cb / 192, col0 = (cb - l * 192) * 32;
        const float* W = PIN(I_WMOD) + (size_t)l * 1024 * 6144 + col0 + 4 * c4;
        f32x4 a0 = (f32x4){0.f, 0.f, 0.f, 0.f}, a1 = a0, a2 = a0;
#pragma unroll 8
        for (int k = kg; k < 1024; k += 64) { const f32x4 w = *(const f32x4*)(W + (size_t)k * 6144); a0 += w * act[k]; a1 += w * act[1024 + k]; a2 += w * act[2048 + k]; }
        *(LAS f32x4*)(red + (kg * 3 + 0) * 32 + 4 * c4) = a0; *(LAS f32x4*)(red + (kg * 3 + 1) * 32 + 4 * c4) = a1; *(LAS f32x4*)(red + (kg * 3 + 2) * 32 + 4 * c4) = a2;
        __syncthreads();
        if (tid < 96) { const int v = tid >> 5, cc = tid & 31; float sm = 0.f;
#pragma unroll 16
            for (int q = 0; q < 64; ++q) sm += red[(q * 3 + v) * 32 + cc];
            const int cj = col0 + cc;
            mod[((size_t)l * 3 + v) * 6144 + cj] = sm + PIN(I_BMOD)[l * 6144 + cj]; }
        __syncthreads();
    }

}

DI void tcvt_load(const float* src, int N, int kt, int nt, int tid, f32x4 (&v)[2]) {
    const int r = tid >> 4, c4 = (tid & 15) * 4;
#pragma unroll
    for (int i = 0; i < 2; ++i) { const int kk = kt * 64 + r + 32 * i, nn = nt * 64 + c4;
        v[i] = (f32x4){0.f, 0.f, 0.f, 0.f};
        if (nn < N) v[i] = *(const f32x4*)(src + (size_t)kk * N + nn); }
}
DI void tcvt_job(const float* src, int K, int N, int Npad, bf16_t* dst, int ldd, LAS float* tile, int& base, float fp8scale = 0.f) {
    const int tid = otid();
    const int nkt = K / 64, nnt = Npad / 64, ntl = nkt * nnt, G = gridDim.x;
    const int first = ((int)blockIdx.x - (base % G) + G) % G;
    f32x4 v[2];
    if (first < ntl) tcvt_load(src, N, first % nkt, first / nkt, tid, v);
    for (int t = first; t < ntl; t += G) {
        const int kt = t % nkt, nt = t / nkt;
        { const int r = tid >> 4, c4 = (tid & 15) * 4;
#pragma unroll
            for (int i = 0; i < 2; ++i) { LAS float* tp = tile + (r + 32 * i) * 65 + c4; tp[0] = v[i][0]; tp[1] = v[i][1]; tp[2] = v[i][2]; tp[3] = v[i][3]; } }
        if (t + G < ntl) tcvt_load(src, N, (t + G) % nkt, (t + G) / nkt, tid, v);
        __syncthreads();
        { const int n = tid >> 3, kc = (tid & 7) * 8; float x[8];
#pragma unroll
            for (int jj = 0; jj < 8; ++jj) x[jj] = tile[(kc + jj) * 65 + n];
            if (fp8scale != 0.f) { u32x2 w8; w8.x = pack4_fp8(x[0] * fp8scale, x[1] * fp8scale, x[2] * fp8scale, x[3] * fp8scale); w8.y = pack4_fp8(x[4] * fp8scale, x[5] * fp8scale, x[6] * fp8scale, x[7] * fp8scale);
                *(u32x2*)((unsigned char*)dst + (size_t)(nt * 64 + n) * ldd + kt * 64 + kc) = w8; }
            else { u32x4 w; w.x = pack2(x[0], x[1]); w.y = pack2(x[2], x[3]); w.z = pack2(x[4], x[5]); w.w = pack2(x[6], x[7]);
                *(u32x4*)(dst + (size_t)(nt * 64 + n) * ldd + kt * 64 + kc) = w; } }
        __syncthreads();
    }
    base += ntl;
}
DI void cvt_copy(const float* src, bf16_t* dst, size_t n) {
    const size_t nth = (size_t)gridDim.x * 512;
    for (size_t i = ((size_t)blockIdx.x * 512 + otid()) * 8; i < n; i += nth * 8) {
        const f32x4 a = *(const f32x4*)(src + i), b = *(const f32x4*)(src + i + 4);
        u32x4 w; w.x = pack2(a[0], a[1]); w.y = pack2(a[2], a[3]); w.z = pack2(b[0], b[1]); w.w = pack2(b[2], b[3]);
        *(u32x4*)(dst + i) = w;
    }
}
typedef float f32x2 __attribute__((ext_vector_type(2)));
constexpr float PU_SCALE = 64.0f, PV_SCALE = 4.0f;
constexpr int PSL = 4;
DI unsigned fp4_code(float x) {
    const float a = fabsf(x);
    const unsigned c = (unsigned)(a > 0.25f) + (unsigned)(a > 0.75f) + (unsigned)(a > 1.25f) + (unsigned)(a > 1.75f) + (unsigned)(a > 2.5f) + (unsigned)(a > 3.5f) + (unsigned)(a > 5.0f);
    return c | ((__float_as_uint(x) >> 28) & 8u);
}
DI unsigned pack8_fp4(const f32x4& a, const f32x4& b) {
    return fp4_code(a[0]) | (fp4_code(a[1]) << 4) | (fp4_code(a[2]) << 8) | (fp4_code(a[3]) << 12) | (fp4_code(b[0]) << 16) | (fp4_code(b[1]) << 20) | (fp4_code(b[2]) << 24) | (fp4_code(b[3]) << 28);
}
DI void cvt_copy_fp4(const float* src, unsigned char* dst, size_t n, float scale) {
    const size_t nth = (size_t)gridDim.x * 512;
    for (size_t i = ((size_t)blockIdx.x * 512 + otid()) * 32; i < n; i += nth * 32) {
        u32x4 w;
#pragma unroll
        for (int q = 0; q < 4; ++q) { const f32x4 a = *(const f32x4*)(src + i + 8 * q) * scale, b = *(const f32x4*)(src + i + 8 * q + 4) * scale; w[q] = pack8_fp4(a, b); }
        const size_t e = i >> 10, c0 = i & 1023;
        *(u32x4*)(dst + (c0 >> 8) * ((size_t)16384 * 128) + e * 128 + ((c0 & 255) >> 1)) = w;
    }
}
DI void phase_convert(const Params& p, int l, LAS float* lds) {
    unsigned char* const ws = ws_ptr();
    int base = 0;
    tcvt_job(PIN(I_WIN) + (size_t)l * 1024 * PW, 1024, PW, 8704, (bf16_t*)(ws + WS_WIN), 1024, lds, base, WIN8_SCALE);
    tcvt_job(PIN(I_WOA) + (size_t)l * 512 * 1024, 512, 1024, 1024, (bf16_t*)(ws + WS_WO), 1024, lds, base);
    tcvt_job(PIN(I_WOB) + (size_t)l * 512 * 1024, 512, 1024, 1024, (bf16_t*)(ws + WS_WO) + (size_t)1 * 1024 * 1024, 1024, lds, base);
    tcvt_job(PIN(I_WOC) + (size_t)l * 1024 * 1024, 1024, 1024, 1024, (bf16_t*)(ws + WS_WO) + (size_t)2 * 1024 * 1024, 1024, lds, base);
    tcvt_job(PIN(I_WOA) + (size_t)l * 512 * 1024, 512, 1024, 1024, (bf16_t*)(ws + WS_WO8), 1024, lds, base, WO8_SCALE);
    tcvt_job(PIN(I_WOB) + (size_t)l * 512 * 1024, 512, 1024, 1024, (bf16_t*)(ws + WS_WO8 + (size_t)1024 * 1024), 1024, lds, base, WO8_SCALE);
    tcvt_job(PIN(I_WOC) + (size_t)l * 1024 * 1024, 1024, 1024, 1024, (bf16_t*)(ws + WS_WO8 + (size_t)2 * 1024 * 1024), 1024, lds, base, WO8_SCALE);
    tcvt_job(PIN(I_WOUT) + (size_t)l * 1024 * 1024, 1024, 1024, 1024, (bf16_t*)(ws + WS_WOUT), 1024, lds, base);
    tcvt_job(PIN(I_WPQ) + (size_t)l * 1024 * 2048, 1024, 2048, 2048, (bf16_t*)(ws + WS_WPQ), 1024, lds, base);
    { const float* sk = PIN(I_SUBK) + (size_t)l * 262144; const float* pg = PIN(I_PQG) + l * 128; bf16_t* dst = (bf16_t*)(ws + WS_SUBK);
        for (int i = (blockIdx.x * 512 + otid()) * 2; i < 262144; i += gridDim.x * 1024) {
            const int d = i & 127; *(unsigned*)(dst + i) = pack2(sk[i] * pg[d], sk[i + 1] * pg[d + 1]); } }
    cvt_copy_fp4(PIN(I_PU) + (size_t)l * 16384 * 1024, ws + WS_TU, (size_t)16384 * 1024, PU_SCALE);
    cvt_copy_fp4(PIN(I_PV) + (size_t)l * 16384 * 1024, ws + WS_TV, (size_t)16384 * 1024, PV_SCALE);
}

DI void phase_norm(const Params& p, int l, int which, const float* xlat, const float* xctx, bf16_t* dst, int nrows) {
    unsigned char* const ws = ws_ptr();
    const int tid = otid(), lane = tid & 63, wid = tid >> 6;
    const float* gain = PIN(which ? I_NORM2 : I_NORM1) + l * 1024;
    const float* mod = (const float*)(ws + WS_MOD) + (size_t)l * 3 * 6144;
    for (int r0 = (blockIdx.x * 8 + wid) * 2; r0 < nrows; r0 += gridDim.x * 16) {
        f32x4 v[2][4];
#pragma unroll
        for (int rr = 0; rr < 2; ++rr) { const int r = r0 + rr; const float* x = r < NLAT ? xlat + (size_t)r * 1024 : xctx + (size_t)(r - NLAT) * 1024;
#pragma unroll
            for (int i = 0; i < 4; ++i) v[rr][i] = *(const f32x4*)(x + i * 256 + lane * 4); }
#pragma unroll
        for (int rr = 0; rr < 2; ++rr) { const int r = r0 + rr;
            const int mv = r < NLAT ? (r >> 14) : 2;
            const float* sh = mod + mv * 6144 + (which ? 3 : 0) * 1024; const float* sc = sh + 1024;
            float ss = 0.f;
#pragma unroll
            for (int i = 0; i < 4; ++i) ss += v[rr][i][0] * v[rr][i][0] + v[rr][i][1] * v[rr][i][1] + v[rr][i][2] * v[rr][i][2] + v[rr][i][3] * v[rr][i][3];
            ss = wave_sum(ss);
            const float rstd = rsqrtf(ss * (1.0f / 1024.0f) + EPS);
#pragma unroll
            for (int i = 0; i < 4; ++i) { const int c = i * 256 + lane * 4;
                const f32x4 g4 = *(const f32x4*)(gain + c), s4 = *(const f32x4*)(sc + c), h4 = *(const f32x4*)(sh + c);
                float y[4];
#pragma unroll
                for (int jj = 0; jj < 4; ++jj) y[jj] = v[rr][i][jj] * rstd * g4[jj] * (1.0f + s4[jj]) + h4[jj];
                if (which == 0) *(unsigned*)((unsigned char*)dst + (size_t)r * 1024 + c) = pack4_fp8(y[0] * H8_SCALE, y[1] * H8_SCALE, y[2] * H8_SCALE, y[3] * H8_SCALE);
                else { u32x2 w; w.x = pack2(y[0], y[1]); w.y = pack2(y[2], y[3]); *(u32x2*)(dst + (size_t)r * 1024 + c) = w; } } }
    }
}

DI void phase_post(const Params& p, int l, LAS unsigned char* lds) {
    unsigned char* const ws = ws_ptr();
    const int tid = otid(), lane = tid & 63, wid = tid >> 6;
    bf16_t* proj = (bf16_t*)(ws + WS_PROJ);
    {
        LAS float* tab = (LAS float*)lds;
        LAS float* gn = (LAS float*)(lds + 32768);
        for (int i = tid; i < 4096; i += 512) { const int pos = i >> 4, f = i & 15;
            const float inv = exp2f(-(float)f * (13.287712379549449f / 16.0f));
            const float ang = (float)pos * inv;
            const float n = rintf(ang * 0.15915494309189535f); float rr = fmaf(-n, 6.28125f, ang); rr = fmaf(-n, 1.9353071795864769e-3f, rr);
            tab[2 * i] = __cosf(rr); tab[2 * i + 1] = __sinf(rr); }
        if (tid < 256) { const int w = tid >> 6, d = tid & 63; gn[tid] = PIN(w == 0 ? I_QNA : (w == 1 ? I_QNB : (w == 2 ? I_KNB : I_KNA)))[l * 64 + d]; }
        __syncthreads();
        const int c8 = lane & 7;
        const float sgn = (c8 & 2) ? 1.0f : -1.0f;
        for (int r = blockIdx.x * 8 + wid; r < NROW; r += gridDim.x * 8) {
            bf16_t* row = proj + (size_t)r * PW;
            const bool lat = r < NLAT;
            const int t = r & (S - 1);
            const int pos = (c8 < 4) ? (t >> 6) : (t & 63);
            u32x4 wpre[4];
#pragma unroll
            for (int ps = 0; ps < 4; ++ps) { const int col = (ps == 0 ? C_QA : (ps == 1 ? C_QB : (ps == 2 ? C_KB : C_KA))) + 8 * (ps == 3 ? (lane & 15) : lane); wpre[ps] = *(const u32x4*)(row + col); }
#pragma unroll
            for (int ps = 0; ps < 4; ++ps) {
                const int col = (ps == 0 ? C_QA : (ps == 1 ? C_QB : (ps == 2 ? C_KB : C_KA))) + 8 * lane;
                if (ps == 3 && lane >= 16) continue;
                const u32x4 w = wpre[ps];
                float v[8] = {bf_lo(w.x), bf_hi(w.x), bf_lo(w.y), bf_hi(w.y), bf_lo(w.z), bf_hi(w.z), bf_lo(w.w), bf_hi(w.w)};
                float ss = 0.f;
#pragma unroll
                for (int i = 0; i < 8; ++i) ss += v[i] * v[i];
                ss += __shfl_xor(ss, 1); ss += __shfl_xor(ss, 2); ss += __shfl_xor(ss, 4);
                const float rstd = rsqrtf(ss * (1.0f / 64.0f) + EPS);
#pragma unroll
                for (int i = 0; i < 8; ++i) v[i] *= rstd * gn[ps * 64 + 8 * c8 + i];
                if ((ps == 0 || ps == 3) && lat) {
#pragma unroll
                    for (int i = 0; i < 8; ++i) { const float yp = __shfl_xor(v[i], 2); const int f = 8 * (c8 & 1) + i;
                        const float cs = tab[(pos * 16 + f) * 2], sn = tab[(pos * 16 + f) * 2 + 1];
                        v[i] = v[i] * cs + sgn * yp * sn; }
                }
                u32x4 o; o.x = pack2(v[0], v[1]); o.y = pack2(v[2], v[3]); o.z = pack2(v[4], v[5]); o.w = pack2(v[6], v[7]);
                *(u32x4*)(row + col) = o;
            }
        }
        __syncthreads();
    }
    {
        bf16_t* vt = (bf16_t*)(ws + WS_VT);
        const int ntl = (NROW / 64) * 13;
        const int rr = tid >> 3, ch = (tid & 7) * 16;
        auto src_of = [&](int it) -> const bf16_t* {
            const int tt = it / 13, cg = it - tt * 13;
            const int row0 = tt < 512 ? ((tt >> 8) * S + (tt & 255) * 64) : (NLAT + ((tt - 512) >> 2) * LC + ((tt - 512) & 3) * 64);
            const int vr0 = cg * 128;
            const int scol = vr0 < 128 ? C_VA + vr0 : (vr0 < 640 ? C_VB + (vr0 - 128) : C_VC + (vr0 - 640));
            return proj + (size_t)(row0 + rr) * PW + scol + ch; };
        int par = 0;
        u32x4 w0 = (u32x4){0u, 0u, 0u, 0u}, w1 = w0;
        if ((int)blockIdx.x < ntl) { const bf16_t* sp = src_of(blockIdx.x); w0 = *(const u32x4*)sp; w1 = *(const u32x4*)(sp + 8); }
        for (int it = blockIdx.x; it < ntl; it += gridDim.x, par ^= 1) {
            LAS bf16_t* tile = (LAS bf16_t*)(lds + par * 17408);
            const int tt = it / 13, cg = it - tt * 13;
            int b, tok0;
            if (tt < 512) { b = tt >> 8; tok0 = (tt & 255) * 64; } else { b = (tt - 512) >> 2; tok0 = S + ((tt - 512) & 3) * 64; }
            const int vr0 = cg * 128;
            *(LAS u32x4*)(tile + rr * 136 + ch) = w0; *(LAS u32x4*)(tile + rr * 136 + ch + 8) = w1;
            { const int nx = it + gridDim.x; if (nx < ntl) { const bf16_t* sp = src_of(nx); w0 = *(const u32x4*)sp; w1 = *(const u32x4*)(sp + 8); } }
            __syncthreads();
            { const int cc = tid >> 2, tk = (tid & 3) * 16; unsigned short v[16];
#pragma unroll
                for (int jj = 0; jj < 16; ++jj) v[jj] = tile[(tk + jj) * 136 + cc];
                u32x4 o0, o1;
                o0.x = v[0] | ((unsigned)v[1] << 16); o0.y = v[2] | ((unsigned)v[3] << 16); o0.z = v[4] | ((unsigned)v[5] << 16); o0.w = v[6] | ((unsigned)v[7] << 16);
                o1.x = v[8] | ((unsigned)v[9] << 16); o1.y = v[10] | ((unsigned)v[11] << 16); o1.z = v[12] | ((unsigned)v[13] << 16); o1.w = v[14] | ((unsigned)v[15] << 16);
                bf16_t* dp = vt + ((size_t)b * VTR + vr0 + cc) * TOKB + tok0 + tk;
                *(u32x4*)dp = o0; *(u32x4*)(dp + 8) = o1; }
        }
        __syncthreads();
    }
}

struct AttnState { bf16x8 Q[2][4]; f32x16 O[2][2]; float m[2], l[2]; };
struct TileRef { unsigned ku, vu; int kpos0; const LAS float* brow; };
struct AttnLane { const char* pb; const char* vb;
    unsigned ksrc, vsrc;
    LAS unsigned char* kbuf; LAS unsigned char* vbuf;
    unsigned krd, vrd; };
DI void attn_dma_k(const AttnLane& al, unsigned ku, int par) {
    const char* src = al.pb + (size_t)(ku + al.ksrc);
#pragma unroll
    for (int q = 0; q < 4; ++q) __builtin_amdgcn_global_load_lds((const unsigned*)(src + (size_t)q * (8 * PW * 2)), (LAS unsigned*)(al.kbuf + par * 8192 + q * 1024), 16, 0, 0);
}
DI void attn_dma_v(const AttnLane& al, unsigned vu, int par) {
    const char* src = al.vb + (size_t)(vu + al.vsrc);
#pragma unroll
    for (int q = 0; q < 4; ++q) __builtin_amdgcn_global_load_lds((const unsigned*)(src + (size_t)q * (16 * TOKB * 2)), (LAS unsigned*)(al.vbuf + par * 8192 + q * 1024), 16, 0, 0);
}
template <int MODE>
DI void attn_tile(AttnState& st, const AttnLane& al, int par, const TileRef& tr, unsigned kunext, unsigned vunext, int qpos0, int g, bool domask) {
    asm volatile("s_waitcnt vmcnt(12)" ::: "memory");
    f32x16 sc[2];
    {
        bf16x8 Kf[4];
#pragma unroll
        for (int s = 0; s < 4; ++s) Kf[s] = *(const LAS bf16x8*)(al.kbuf + par * 8192 + (al.krd ^ (unsigned)(s << 4)));
#pragma unroll
        for (int u = 0; u < 2; ++u) {
            sc[u] = zero16();
#pragma unroll
            for (int s = 0; s < 4; ++s) sc[u] = MFMA32(Kf[s], st.Q[u][s], sc[u]);
        }
    }
    asm volatile("s_waitcnt lgkmcnt(0)" ::: "memory");
    attn_dma_k(al, kunext, par);
    const int kpos0 = tr.kpos0;
    bf16x8 Vf[2][2];
#pragma unroll
    for (int u = 0; u < 2; ++u) {
        const int qp = qpos0 + 32 * u;
        if (MODE == 1 && domask) {
            const int base = kpos0 + 8 * g - qp + 128;
#pragma unroll
            for (int r = 0; r < 16; ++r) sc[u][r] = ((unsigned)(base + 16 * (r >> 3) + (r & 7)) <= 256u) ? sc[u][r] : -INFINITY;
        } else if (MODE == 2 && domask) {
            int cs = qp - 8; cs = cs < 0 ? 0 : (cs > 48 ? 48 : cs);
            const int vb = kpos0 + 8 * g - cs;
            const LAS float* bp = tr.brow + (kpos0 + 8 * g - qp + 15);
            float bv[16];
#pragma unroll
            for (int r = 0; r < 16; ++r) bv[r] = bp[16 * (r >> 3) + (r & 7)];
            asm volatile("" ::: "memory");
#pragma unroll
            for (int r = 0; r < 16; ++r) { const int o = 16 * (r >> 3) + (r & 7); const float t = sc[u][r] + bv[r]; sc[u][r] = ((unsigned)(vb + o) < 16u) ? t : -INFINITY; }
        }
        float mx = sc[u][0];
#pragma unroll
        for (int r = 1; r < 16; ++r) mx = fmaxf(mx, sc[u][r]);
        mx = fmaxf(mx, __shfl_xor(mx, 32));
        const float mn = fmaxf(st.m[u], mx);
        float rs = 0.f;
#pragma unroll
        for (int r = 0; r < 16; ++r) { const float pv = __builtin_amdgcn_exp2f(sc[u][r] - mn); rs += pv; sc[u][r] = pv; }
        if (__builtin_amdgcn_ballot_w64(mn > st.m[u]) != 0ull) {
            const float alpha = __builtin_amdgcn_exp2f(st.m[u] - mn);
            st.l[u] *= alpha;
#pragma unroll
            for (int r = 0; r < 16; ++r) { st.O[0][u][r] *= alpha; st.O[1][u][r] *= alpha; }
        }
        st.m[u] = mn;
        st.l[u] += rs;
        bf16x8 P[2];
#pragma unroll
        for (int s = 0; s < 2; ++s) { u32x4 w; w.x = pack2(sc[u][8 * s], sc[u][8 * s + 1]); w.y = pack2(sc[u][8 * s + 2], sc[u][8 * s + 3]); w.z = pack2(sc[u][8 * s + 4], sc[u][8 * s + 5]); w.w = pack2(sc[u][8 * s + 6], sc[u][8 * s + 7]);
            P[s] = __builtin_bit_cast(bf16x8, w); }
        if (u == 0) {
            asm volatile("s_waitcnt vmcnt(12)" ::: "memory");
#pragma unroll
            for (int dt = 0; dt < 2; ++dt)
#pragma unroll
                for (int s = 0; s < 2; ++s) Vf[dt][s] = *(const LAS bf16x8*)(al.vbuf + par * 8192 + dt * 2048 + (al.vrd ^ (unsigned)(s << 5)));
        }
#pragma unroll
        for (int dt = 0; dt < 2; ++dt)
#pragma unroll
            for (int s = 0; s < 2; ++s) st.O[dt][u] = MFMA32(Vf[dt][s], P[s], st.O[dt][u]);
    }
    asm volatile("s_waitcnt lgkmcnt(0)" ::: "memory");
    attn_dma_v(al, vunext, par);
}
DI void attn_load_q(AttnState& st, const bf16_t* proj, int qrow0, int qcol, int j, int g) {
    const float qs = 0.125f * LOG2E;
#pragma unroll
    for (int u = 0; u < 2; ++u) {
        const bf16_t* qp = proj + (size_t)(qrow0 + 32 * u + j) * PW + qcol + 32 * g;
#pragma unroll
        for (int s = 0; s < 4; ++s) { const u32x4 w = *(const u32x4*)(qp + 8 * s); u32x4 o;
            o.x = pack2(bf_lo(w.x) * qs, bf_hi(w.x) * qs); o.y = pack2(bf_lo(w.y) * qs, bf_hi(w.y) * qs); o.z = pack2(bf_lo(w.z) * qs, bf_hi(w.z) * qs); o.w = pack2(bf_lo(w.w) * qs, bf_hi(w.w) * qs);
            st.Q[u][s] = __builtin_bit_cast(bf16x8, o); }
        st.O[0][u] = zero16(); st.O[1][u] = zero16();
    }
}
DI void attn_store(const AttnState& st, bf16_t* proj, int qrow0, int ocol, int j, int g) {
#pragma unroll
    for (int u = 0; u < 2; ++u) {
        const float lt = st.l[u] + __shfl_xor(st.l[u], 32);
        const float inv = 1.0f / lt;
        bf16_t* op = proj + (size_t)(qrow0 + 32 * u + j) * PW + ocol + 4 * g;
#pragma unroll
        for (int dt = 0; dt < 2; ++dt)
#pragma unroll
            for (int q = 0; q < 4; ++q) { u32x2 w; w.x = pack2(st.O[dt][u][4 * q] * inv, st.O[dt][u][4 * q + 1] * inv); w.y = pack2(st.O[dt][u][4 * q + 2] * inv, st.O[dt][u][4 * q + 3] * inv);
                *(u32x2*)(op + 32 * dt + 8 * q) = w; }
    }
}
DI void attn_store8(const AttnState& st, unsigned char* o8, int qrow0, int obyte, int j, int g) {
#pragma unroll
    for (int u = 0; u < 2; ++u) {
        const float lt = st.l[u] + __shfl_xor(st.l[u], 32);
        const float inv = O8_SCALE / lt;
        unsigned char* op = o8 + (size_t)(qrow0 + 32 * u + j) * 2048 + obyte + 4 * g;
#pragma unroll
        for (int dt = 0; dt < 2; ++dt)
#pragma unroll
            for (int q = 0; q < 4; ++q) *(unsigned*)(op + 32 * dt + 8 * q) = pack4_fp8(st.O[dt][u][4 * q] * inv, st.O[dt][u][4 * q + 1] * inv, st.O[dt][u][4 * q + 2] * inv, st.O[dt][u][4 * q + 3] * inv);
    }
}
struct CtxTiles { unsigned k0, v0;
    DI TileRef operator()(int t) const { TileRef r; r.ku = k0 + (unsigned)(32 * t) * (PW * 2); r.vu = v0 + 64 * t; r.kpos0 = 0; r.brow = nullptr; return r; } };
struct LocATiles { unsigned k0, v0; int p0;
    DI TileRef operator()(int t) const { TileRef r; const int kp0 = p0 + 32 * t; r.ku = k0 + (unsigned)kp0 * (PW * 2); r.vu = v0 + 2 * kp0; r.kpos0 = kp0; r.brow = nullptr; return r; } };
struct LocBTiles { unsigned k0, v0; int rs; const LAS float* rpbh; int r;
    DI TileRef operator()(int t) const { TileRef q; const int kr = rs + (t >> 1), c0 = (t & 1) * 32; q.ku = k0 + (unsigned)(kr * 64 + c0) * (PW * 2); q.vu = v0 + 2 * (kr * 64 + c0); q.kpos0 = c0; q.brow = rpbh + (kr - r + 7) * 31; return q; } };
struct NoTiles { DI TileRef operator()(int) const { TileRef r; r.ku = 0; r.vu = 0; r.kpos0 = 0; r.brow = nullptr; return r; } };
template <int MODE, class LT>
DI void attn_run(AttnState& st, const AttnLane& al, const CtxTiles& ct, const LT& lt, int lo, int hi, int ulo, int uhi, int qpos0, int g) {
    const int ntot = 8 + (hi - lo);
    TileRef cur = ct(0), n1 = ct(1);
    attn_dma_k(al, cur.ku, 0); attn_dma_v(al, cur.vu, 0); attn_dma_k(al, n1.ku, 1); attn_dma_v(al, n1.vu, 1);
#pragma unroll 1
    for (int tt = 0; tt < ntot; ++tt) {
        int t2 = tt + 2; if (t2 > ntot - 1) t2 = ntot - 1;
        TileRef n2; if (t2 < 8) n2 = ct(t2); else n2 = lt(lo + t2 - 8);
        const int tl = lo + tt - 8;
        const bool domask = (tt >= 8) && !(tl >= ulo && tl < uhi);
        attn_tile<MODE>(st, al, tt & 1, cur, n2.ku, n2.vu, qpos0, g, domask);
        cur = n1; n1 = n2;
    }
}
DI void phase_attn(const Params& p, int l, LAS unsigned char* lds) {
    unsigned char* const ws = ws_ptr();
    const int tid = otid(), lane = tid & 63, wid = tid >> 6, j = lane & 31, g = lane >> 5;
    bf16_t* proj = (bf16_t*)(ws + WS_PROJ);
    LAS float* rpb = (LAS float*)(lds + 256);
    for (int i = tid; i < 8 * 15 * 31; i += 512) rpb[i] = PIN(I_RPB)[l * 3720 + i] * LOG2E;
    __syncthreads();
    const bool last = (l == DEPTH - 1);
    const int nitems = 8192 + (last ? 0 : 128);
    AttnLane al; al.pb = (const char*)(ws + WS_PROJ); al.vb = (const char*)(ws + WS_VT);
    { const int kr = lane >> 3, kc = (lane & 7) ^ (kr & 7); al.ksrc = (unsigned)(kr * PW * 2 + kc * 16);
        const int vr = lane >> 2, vc = (lane & 3) ^ ((vr >> 2) & 3); al.vsrc = (unsigned)(vr * TOKB * 2 + vc * 16);
        const int wu = __builtin_amdgcn_readfirstlane(wid);
        al.kbuf = lds + 16384 + wu * 16384; al.vbuf = lds + 16384 + wu * 16384 + 4096;
        const int rho = pi32(j); al.krd = (unsigned)(rho * 128 + (((4 * g) ^ (rho & 7)) << 4));
        al.vrd = (unsigned)(j * 64 + ((g ^ ((j >> 2) & 3)) << 4)); }
    for (int it = blockIdx.x * 8 + wid; it < nitems; it += gridDim.x * 8) {
        AttnState st;
        if (it < 4096) {
            const int half = it & 1, hh = (it >> 1) & 7, n = (it >> 4) & 127, b = it >> 11;
            const int q0 = n * 128 + half * 64, qrow0 = b * S + q0, g2 = hh >> 2;
            attn_load_q(st, proj, qrow0, C_QA + hh * 64, j, g);
            const float sk = PIN(I_SINKA)[l * 8 + hh] * LOG2E;
            st.m[0] = st.m[1] = sk; st.l[0] = st.l[1] = (g == 0) ? 1.0f : 0.0f;
            CtxTiles ct; ct.k0 = (unsigned)((NLAT + b * LC) * PW + C_KA + g2 * 64) * 2u; ct.v0 = (unsigned)((b * VTR + g2 * 64) * TOKB + S) * 2u;
            LocATiles la; la.k0 = (unsigned)(b * S * PW + C_KA + g2 * 64) * 2u; la.v0 = (unsigned)((b * VTR + g2 * 64) * TOKB) * 2u; la.p0 = (n - 1) * 128;
            int lo = half ? 2 : 0, hi = half ? 12 : 10;
            if (n == 0 && lo < 4) lo = 4;
            if (n == 127 && hi > 8) hi = 8;
            attn_run<1>(st, al, ct, la, lo, hi, 2 + 2 * half, 8 + 2 * half, q0 + j, g);
            attn_store8(st, ws + WS_O8, qrow0, hh * 64, j, g);
        } else if (it < 8192) {
            const int i2 = it - 4096, h = i2 & 7, r = (i2 >> 3) & 255, b = i2 >> 11;
            const int qrow0 = b * S + r * 64;
            attn_load_q(st, proj, qrow0, C_QB + h * 64, j, g);
            st.m[0] = st.m[1] = -INFINITY; st.l[0] = st.l[1] = 0.f;
            CtxTiles ct; ct.k0 = (unsigned)((NLAT + b * LC) * PW + C_KB + h * 64) * 2u; ct.v0 = (unsigned)((b * VTR + 128 + h * 64) * TOKB + S) * 2u;
            int rs = r - 4; rs = rs < 0 ? 0 : (rs > 248 ? 248 : rs);
            LocBTiles lb; lb.k0 = (unsigned)(b * S * PW + C_KB + h * 64) * 2u; lb.v0 = (unsigned)((b * VTR + 128 + h * 64) * TOKB) * 2u; lb.rs = rs; lb.rpbh = rpb + h * 15 * 31; lb.r = r;
            attn_run<2>(st, al, ct, lb, 0, 16, 0, 0, j, g);
            attn_store8(st, ws + WS_O8, qrow0, 512 + h * 64, j, g);
        } else {
            const int i2 = it - 8192, qt = i2 & 3, h = (i2 >> 2) & 7, b = (i2 >> 5) & 1, mixer = i2 >> 6;
            const int qrow0 = NLAT + b * LC + qt * 64;
            const int qcol = mixer == 0 ? C_QA + h * 64 : C_QB + h * 64;
            const int kcol = mixer == 0 ? C_KA + (h >> 2) * 64 : C_KB + h * 64;
            const int vr0 = mixer == 0 ? (h >> 2) * 64 : 128 + h * 64;
            attn_load_q(st, proj, qrow0, qcol, j, g);
            const float sk = PIN(I_SINKA)[l * 8 + h] * LOG2E;
            st.m[0] = st.m[1] = mixer == 0 ? sk : -INFINITY; st.l[0] = st.l[1] = (mixer == 0 && g == 0) ? 1.0f : 0.0f;
            CtxTiles ct; ct.k0 = (unsigned)((NLAT + b * LC) * PW + kcol) * 2u; ct.v0 = (unsigned)((b * VTR + vr0) * TOKB + S) * 2u;
            NoTiles nt;
            attn_run<0>(st, al, ct, nt, 0, 0, 0, 0, 0, g);
            attn_store(st, proj, qrow0, qcol, j, g);
        }
    }
}

DI void gla_chunk_rows(int b, int ci, int& row0, int& tok0) {
    if (ci < 256) { tok0 = ci * 64; row0 = b * S + tok0; } else { const int cc = ci - 256; tok0 = S + cc * 64; row0 = NLAT + b * LC + cc * 64; }
}
constexpr int GL_A = 0;
constexpr int GL_W = 8192;
constexpr int GL_B = 24576;
constexpr int GL_QT = 27648;
constexpr int GL_SSQ = 25600;
constexpr int GL_LA = 30720;
constexpr int GL_QH = 63488;
constexpr int GL_KT = 79872;
constexpr int GL_SB = 96256;
constexpr int GL_OUT = GL_QH + 18432;
constexpr int GL_ATT = GL_LA;
DI u32x4 gla_load_a(const bf16_t* proj, int row0, int tid) {
    u32x4 w = (u32x4){0u, 0u, 0u, 0u};
    if (tid < 256) w = *(const u32x4*)(proj + (size_t)(row0 + (tid >> 2)) * PW + C_AC + (tid & 3) * 8);
    return w;
}
DI void gla_stage_gate(const Params& p, int l, const u32x4& w, int h, LAS unsigned char* lds, int& cur_h) {
    const int tid = otid();
    LAS float* a_s = (LAS float*)(lds + GL_A); LAS float* w_s = (LAS float*)(lds + GL_W); LAS float* b_s = (LAS float*)(lds + GL_B);
    if (tid < 256) { const int tok = tid >> 2, c8 = (tid & 3) * 8;
        LAS float* d = a_s + tok * 32 + c8; d[0] = bf_lo(w.x); d[1] = bf_hi(w.x); d[2] = bf_lo(w.y); d[3] = bf_hi(w.y); d[4] = bf_lo(w.z); d[5] = bf_hi(w.z); d[6] = bf_lo(w.w); d[7] = bf_hi(w.w); }
    if (h != cur_h) {
        cur_h = h;
#pragma unroll
        for (int q = 0; q < 8; ++q) { const int i = tid + q * 512, dir = i >> 11, rr = (i >> 7) & 15, ch = i & 127;
            w_s[i] = PIN(dir ? I_WA2B : I_WA2F)[(size_t)l * 16 * 512 + rr * 512 + h * 128 + ch]; }
        if (tid < 256) { const int dir = tid >> 7, ch = tid & 127; b_s[tid] = PIN(dir ? I_BAB : I_BAF)[l * 512 + h * 128 + ch]; }
    }
}
DI void gla_logdecay(int dir, LAS unsigned char* lds) {
    const int tid = otid();
    const LAS float* a_s = (const LAS float*)(lds + GL_A); const LAS float* w_s = (const LAS float*)(lds + GL_W) + dir * 2048; const LAS float* b_s = (const LAS float*)(lds + GL_B) + dir * 128;
    LAS float* la = (LAS float*)(lds + GL_LA);
    LAS float* qt = (LAS float*)(lds + GL_QT);
    const int ch = tid & 127, tq = tid >> 7; float w[16];
#pragma unroll
    for (int i = 0; i < 16; ++i) w[i] = w_s[i * 128 + ch];
    const float bb = b_s[ch];
    float run = 0.f;
#pragma unroll 4
    for (int t = 0; t < 16; ++t) { const int tok = tq * 16 + (dir ? 15 - t : t); float z = bb;
        const LAS f32x4* ap = (const LAS f32x4*)(a_s + tok * 32 + dir * 16);
#pragma unroll
        for (int i = 0; i < 4; ++i) { const f32x4 av = ap[i]; z += av[0] * w[4 * i] + av[1] * w[4 * i + 1] + av[2] * w[4 * i + 2] + av[3] * w[4 * i + 3]; }
        run += (fminf(z, 0.f) - __logf(1.0f + __expf(-fabsf(z)))) * (1.0f / 16.0f);
        la[tok * 128 + ch] = run; }
    qt[tq * 128 + ch] = run;
    __syncthreads();
    float off = 0.f;
#pragma unroll
    for (int q = 0; q < 4; ++q) { const float v = qt[q * 128 + ch]; off += (dir ? (q > tq) : (q < tq)) ? v : 0.f; }
#pragma unroll
    for (int t = 0; t < 16; ++t) la[(tq * 16 + t) * 128 + ch] += off;
    __syncthreads();
}
DI void phase_gla1(const Params& p, int l, LAS unsigned char* lds) {
    unsigned char* const ws = ws_ptr();
    const int tid = otid(), lane = tid & 63, wid = tid >> 6, j = lane & 31, g = lane >> 5;
    const bf16_t* proj = (const bf16_t*)(ws + WS_PROJ);
    const bf16_t* vt = (const bf16_t*)(ws + WS_VT);
    bf16_t* stt = (bf16_t*)(ws + WS_ST); float* dec = (float*)(ws + WS_DEC);
    const LAS float* la = (const LAS float*)(lds + GL_LA);
    LAS bf16_t* ktT = (LAS bf16_t*)(lds + GL_QH);
    int cur_h = -1;
    u32x4 a_pre = (u32x4){0u, 0u, 0u, 0u};
    if ((int)blockIdx.x < NB * NCH * 4) { int r0_, t0_; gla_chunk_rows(((int)blockIdx.x >> 2) / NCH, ((int)blockIdx.x >> 2) % NCH, r0_, t0_); a_pre = gla_load_a(proj, r0_, tid); }
    for (int un = blockIdx.x; un < NB * NCH * 4; un += gridDim.x) {
        const int h = un & 3, ci = (un >> 2) % NCH, b = (un >> 2) / NCH;
        int row0, tok0; gla_chunk_rows(b, ci, row0, tok0);
        gla_stage_gate(p, l, a_pre, h, lds, cur_h);
        { const int un2 = un + gridDim.x; if (un2 < NB * NCH * 4) { int r0_, t0_; gla_chunk_rows((un2 >> 2) / NCH, (un2 >> 2) % NCH, r0_, t0_); a_pre = gla_load_a(proj, r0_, tid); } }
        bf16x8 Vf[4];
#pragma unroll
        for (int s = 0; s < 4; ++s) Vf[s] = *(const bf16x8*)(vt + ((size_t)b * VTR + 640 + h * 256 + 32 * wid + j) * TOKB + tok0 + 16 * s + 8 * g);
        const u32x4 k0 = *(const u32x4*)(proj + (size_t)(row0 + (tid >> 3)) * PW + C_KC + h * 128 + (tid & 7) * 16), k1 = *(const u32x4*)(proj + (size_t)(row0 + (tid >> 3)) * PW + C_KC + h * 128 + (tid & 7) * 16 + 8);
        __syncthreads();
        for (int dir = 0; dir < 2; ++dir) {
            gla_logdecay(dir, lds);
            const int chain = (b * 4 + h) * 2 + dir;
            { const int tok = tid >> 3, cc = (tid & 7) * 16;
                const unsigned kw[8] = {k0.x, k0.y, k0.z, k0.w, k1.x, k1.y, k1.z, k1.w};
                const int te = dir ? 0 : 63;
#pragma unroll
                for (int q = 0; q < 8; ++q) { const int ch = cc + 2 * q;
                    const float w0 = __expf(la[te * 128 + ch] - la[tok * 128 + ch]), w1 = __expf(la[te * 128 + ch + 1] - la[tok * 128 + ch + 1]);
                    const int tr_ = (tok + 8 * (ch >> 4)) & 63;
                    ktT[ch * 72 + tr_] = f2bf(bf_lo(kw[q]) * w0); ktT[(ch + 1) * 72 + tr_] = f2bf(bf_hi(kw[q]) * w1); } }
            if (tid < 128) dec[((size_t)chain * NCH + ci) * 128 + tid] = __expf(la[(dir ? 0 : 63) * 128 + tid]);
            __syncthreads();
            bf16_t* so = stt + ((size_t)chain * NCH + ci) * 32768 + (size_t)(32 * wid) * 128;
            LAS unsigned char* ob = lds + GL_OUT + wid * 8704;
            const int prow = 16 * ((j >> 2) & 1) + 4 * (j >> 3) + (j & 3);
#pragma unroll
            for (int dk = 0; dk < 4; ++dk) {
                f32x16 acc = zero16();
                const int krow = 32 * dk + prow;
#pragma unroll
                for (int s = 0; s < 4; ++s) { const bf16x8 Af = *(const LAS bf16x8*)(ktT + krow * 72 + (((2 * s + g + (krow >> 4)) & 7) << 3)); acc = MFMA32(Af, Vf[s], acc); }
                u32x4 w0, w1;
                w0.x = pack2(acc[0], acc[1]); w0.y = pack2(acc[2], acc[3]); w0.z = pack2(acc[4], acc[5]); w0.w = pack2(acc[6], acc[7]);
                w1.x = pack2(acc[8], acc[9]); w1.y = pack2(acc[10], acc[11]); w1.z = pack2(acc[12], acc[13]); w1.w = pack2(acc[14], acc[15]);
                *(LAS u32x4*)(ob + j * 272 + 64 * dk + 32 * g) = w0; *(LAS u32x4*)(ob + j * 272 + 64 * dk + 32 * g + 16) = w1;
            }
#pragma unroll
            for (int q = 0; q < 8; ++q) { const int row = 4 * q + (lane >> 4), chk = lane & 15;
                *(u32x4*)(so + (size_t)row * 128 + chk * 8) = *(const LAS u32x4*)(ob + row * 272 + chk * 16); }
            __syncthreads();
        }
    }
}
DI void phase_gla2(const Params& p) {
    unsigned char* const ws = ws_ptr();
    const char* sb = (const char*)(ws + WS_ST); const char* db = (const char*)(ws + WS_DEC);
    for (int gt = blockIdx.x * 512 + otid(); gt < 16 * 8192; gt += gridDim.x * 512) {
        const int chain = gt >> 13, e = gt & 8191, dv = e >> 5, dk0 = (e & 31) * 4, dir = chain & 1;
        const unsigned so = (unsigned)((chain * NCH * 32768 + dv * 128 + dk0) * 2), dof = (unsigned)((chain * NCH * 128 + dk0) * 4);
        float s0, s1, s2, s3;
        asm volatile("v_mov_b32 %0, 0\n\tv_mov_b32 %1, 0\n\tv_mov_b32 %2, 0\n\tv_mov_b32 %3, 0" : "=v"(s0), "=v"(s1), "=v"(s2), "=v"(s3));
        auto chunk_of = [&](int step) -> int { return dir ? (NCH - 1 - step) : (step < 4 ? 256 + step : step - 4); };
        u32x2 dS[4], dSn[4]; f32x4 dd[4], ddn[4];
#pragma unroll
        for (int q = 0; q < 4; ++q) { const unsigned c = (unsigned)chunk_of(q); dS[q] = *(const u32x2*)(sb + (size_t)(so + c * 65536u)); dd[q] = *(const f32x4*)(db + (size_t)(dof + c * 512u)); }
        for (int st = 0; st < NCH; st += 4) {
            const int sn = st + 4 < NCH ? st + 4 : st;
#pragma unroll
            for (int q = 0; q < 4; ++q) { const unsigned c = (unsigned)chunk_of(sn + q); dSn[q] = *(const u32x2*)(sb + (size_t)(so + c * 65536u)); ddn[q] = *(const f32x4*)(db + (size_t)(dof + c * 512u)); }
#pragma unroll
            for (int q = 0; q < 4; ++q) {
                u32x2 w; w.x = pack2(s0, s1); w.y = pack2(s2, s3);
                *(u32x2*)((char*)sb + (size_t)(so + (unsigned)chunk_of(st + q) * 65536u)) = w;
                s0 = dd[q][0] * s0 + bf_lo(dS[q].x); s1 = dd[q][1] * s1 + bf_hi(dS[q].x); s2 = dd[q][2] * s2 + bf_lo(dS[q].y); s3 = dd[q][3] * s3 + bf_hi(dS[q].y);
            }
#pragma unroll
            for (int q = 0; q < 4; ++q) { dS[q] = dSn[q]; dd[q] = ddn[q]; }
        }
    }
}
DI int gl_swz(int tok, int chunk) { return tok * 256 + ((chunk ^ (tok & 15)) << 4); }
template <int DIR>
DI void gla3_dir(const Params& p, LAS unsigned char* lds, const u32x4 (&qk)[4], const bf16_t* state, const bf16x8 (&Vf)[2][2], f32x16 (&O)[2]) {
    const int tid = otid(), lane = tid & 63, wid = tid >> 6, j = lane & 31, g = lane >> 5;
    LAS unsigned char* sb = lds + GL_SB + __builtin_amdgcn_readfirstlane(wid) * 8192;
    { const char* src = (const char*)(state + (size_t)(32 * wid) * 128);
#pragma unroll
        for (int q = 0; q < 8; ++q) { const int r = 4 * q + (lane >> 4), c = (lane & 15) ^ (r & 15);
            __builtin_amdgcn_global_load_lds((const unsigned*)(src + r * 256 + c * 16), (LAS unsigned*)(sb + q * 1024), 16, 0, 0); } }
    gla_logdecay(DIR, lds);

    const LAS float* la = (const LAS float*)(lds + GL_LA);
    { const int tok = tid >> 3, cc = (tid & 7) * 16;
        const u32x4 q0 = qk[0], q1 = qk[1], k0 = qk[2], k1 = qk[3];
        const unsigned qw[8] = {q0.x, q0.y, q0.z, q0.w, q1.x, q1.y, q1.z, q1.w}, kw[8] = {k0.x, k0.y, k0.z, k0.w, k1.x, k1.y, k1.z, k1.w};
        unsigned qo[8], ko[8];
#pragma unroll
        for (int q = 0; q < 8; ++q) { const float b0 = la[tok * 128 + cc + 2 * q], b1 = la[tok * 128 + cc + 2 * q + 1];
            qo[q] = pack2(bf_lo(qw[q]) * 0.08838834764831845f * __expf(b0), bf_hi(qw[q]) * 0.08838834764831845f * __expf(b1));
            ko[q] = pack2(bf_lo(kw[q]) * __expf(fminf(-b0, 80.f)), bf_hi(kw[q]) * __expf(fminf(-b1, 80.f))); }
        const int c0 = (tid & 7) * 2;
        *(LAS u32x4*)(lds + GL_QH + gl_swz(tok, c0)) = (u32x4){qo[0], qo[1], qo[2], qo[3]}; *(LAS u32x4*)(lds + GL_QH + gl_swz(tok, c0 + 1)) = (u32x4){qo[4], qo[5], qo[6], qo[7]};
        *(LAS u32x4*)(lds + GL_KT + gl_swz(tok, c0)) = (u32x4){ko[0], ko[1], ko[2], ko[3]}; *(LAS u32x4*)(lds + GL_KT + gl_swz(tok, c0 + 1)) = (u32x4){ko[4], ko[5], ko[6], ko[7]}; }
    __syncthreads();
    if (wid < 4) {
        const int tj = wid >> 1, ti = wid & 1;
        const bool skip = DIR == 0 ? (tj > ti) : (tj < ti);
        if (!skip) {
            f32x16 acc = zero16();
            const int ktok = 32 * tj + pi32(j), qtok = 32 * ti + j;
#pragma unroll
            for (int s = 0; s < 8; ++s) { const bf16x8 Af = *(const LAS bf16x8*)(lds + GL_KT + gl_swz(ktok, 2 * s + g)), Bf = *(const LAS bf16x8*)(lds + GL_QH + gl_swz(qtok, 2 * s + g)); acc = MFMA32(Af, Bf, acc); }
#pragma unroll
            for (int r = 0; r < 16; ++r) { const int kt = 32 * tj + 16 * (r >> 3) + 8 * g + (r & 7); const bool keep = DIR == 0 ? (kt <= qtok) : (kt >= qtok); acc[r] = keep ? acc[r] : 0.f; }
            asm volatile("s_waitcnt lgkmcnt(0)" ::: "memory");
#pragma unroll
            for (int s = 0; s < 2; ++s) { u32x4 w; w.x = pack2(acc[8 * s], acc[8 * s + 1]); w.y = pack2(acc[8 * s + 2], acc[8 * s + 3]); w.z = pack2(acc[8 * s + 4], acc[8 * s + 5]); w.w = pack2(acc[8 * s + 6], acc[8 * s + 7]);
                *(LAS u32x4*)(lds + GL_ATT + ((wid * 2 + s) * 64 + lane) * 16) = w; }
        }
    }
    asm volatile("s_waitcnt vmcnt(0)" ::: "memory");
    bf16x8 Sf[8];
    { const int r = 16 * ((j >> 2) & 1) + 4 * (j >> 3) + (j & 3);
#pragma unroll
        for (int s = 0; s < 8; ++s) Sf[s] = *(const LAS bf16x8*)(sb + r * 256 + (((2 * s + g) ^ (r & 15)) << 4)); }
    __syncthreads();
#pragma unroll
    for (int ti = 0; ti < 2; ++ti) {
#pragma unroll
        for (int tj = 0; tj < 2; ++tj) {
            const bool skip = DIR == 0 ? (tj > ti) : (tj < ti);
            if (!skip) {
#pragma unroll
                for (int s = 0; s < 2; ++s) { const bf16x8 Bf = *(const LAS bf16x8*)(lds + GL_ATT + (((tj * 2 + ti) * 2 + s) * 64 + lane) * 16); O[ti] = MFMA32(Vf[tj][s], Bf, O[ti]); }
            }
        }
#pragma unroll
        for (int s = 0; s < 8; ++s) { const bf16x8 Bf = *(const LAS bf16x8*)(lds + GL_QH + gl_swz(32 * ti + j, 2 * s + g)); O[ti] = MFMA32(Sf[s], Bf, O[ti]); }
    }
    __syncthreads();
}
DI void phase_gla3(const Params& p, int l, LAS unsigned char* lds) {
    unsigned char* const ws = ws_ptr();
    const int tid = otid(), lane = tid & 63, wid = tid >> 6, j = lane & 31, g = lane >> 5;
    bf16_t* proj = (bf16_t*)(ws + WS_PROJ);
    const bf16_t* vt = (const bf16_t*)(ws + WS_VT);
    const bf16_t* stt = (const bf16_t*)(ws + WS_ST);
    LAS float* ssq = (LAS float*)(lds + GL_SSQ);
    const bool last = (l == DEPTH - 1);
    int cur_h = -1, a_for = -1;
    u32x4 a_pre = (u32x4){0u, 0u, 0u, 0u};
    for (int un = blockIdx.x; un < NB * NCH * 4; un += gridDim.x) {
        const int h = un & 3, ci = (un >> 2) % NCH, b = (un >> 2) / NCH;
        if (last && ci >= 256) continue;
        int row0, tok0; gla_chunk_rows(b, ci, row0, tok0);
        const int prow = 16 * ((j >> 2) & 1) + 4 * (j >> 3) + (j & 3);
        if (a_for != un) a_pre = gla_load_a(proj, row0, tid);
        gla_stage_gate(p, l, a_pre, h, lds, cur_h);
        { const int un2 = un + gridDim.x; if (un2 < NB * NCH * 4) { int r0_, t0_; gla_chunk_rows((un2 >> 2) / NCH, (un2 >> 2) % NCH, r0_, t0_); a_pre = gla_load_a(proj, r0_, tid); a_for = un2; } }
        bf16x8 Vf[2][2];
#pragma unroll
        for (int tj = 0; tj < 2; ++tj)
#pragma unroll
            for (int s = 0; s < 2; ++s) Vf[tj][s] = *(const bf16x8*)(vt + ((size_t)b * VTR + 640 + h * 256 + 32 * wid + prow) * TOKB + tok0 + 32 * tj + 16 * s + 8 * g);
        f32x16 O[2]; O[0] = zero16(); O[1] = zero16();
        u32x4 qk[4];
        { const bf16_t* rp = proj + (size_t)(row0 + (tid >> 3)) * PW + h * 128 + (tid & 7) * 16;
            qk[0] = *(const u32x4*)(rp + C_QC); qk[1] = *(const u32x4*)(rp + C_QC + 8); qk[2] = *(const u32x4*)(rp + C_KC); qk[3] = *(const u32x4*)(rp + C_KC + 8); }
        __syncthreads();
        const size_t chain0 = (size_t)(b * 4 + h) * 2;
        gla3_dir<0>(p, lds, qk, stt + ((chain0 + 0) * NCH + ci) * 32768, Vf, O);
        gla3_dir<1>(p, lds, qk, stt + ((chain0 + 1) * NCH + ci) * 32768, Vf, O);
#pragma unroll
        for (int ti = 0; ti < 2; ++ti) { float s = 0.f;
#pragma unroll
            for (int r = 0; r < 16; ++r) s += O[ti][r] * O[ti][r];
            s += __shfl_xor(s, 32);
            if (g == 0) ssq[(32 * ti + j) * 8 + wid] = s; }
        __syncthreads();
        const float* gn = PIN(I_GNC) + l * 256;
#pragma unroll
        for (int ti = 0; ti < 2; ++ti) {
            float tot = 0.f;
#pragma unroll
            for (int w = 0; w < 8; ++w) tot += ssq[(32 * ti + j) * 8 + w];
            const float rstd = rsqrtf(tot * (1.0f / 256.0f) + EPS);
            bf16_t* rp = proj + (size_t)(row0 + 32 * ti + j) * PW + C_RC + h * 256 + 32 * wid + 16 * g;
            const u32x4 ra = *(const u32x4*)rp, rb = *(const u32x4*)(rp + 8);
            const unsigned rw[8] = {ra.x, ra.y, ra.z, ra.w, rb.x, rb.y, rb.z, rb.w};
            float yv[16];
#pragma unroll
            for (int q = 0; q < 8; ++q) {
                const float r0 = bf_lo(rw[q]), r1 = bf_hi(rw[q]);
                const float g0 = gn[32 * wid + 16 * g + 2 * q], g1 = gn[32 * wid + 16 * g + 2 * q + 1];
                yv[2 * q] = O[ti][2 * q] * rstd * g0 * r0 * sigmoidf_(r0); yv[2 * q + 1] = O[ti][2 * q + 1] * rstd * g1 * r1 * sigmoidf_(r1);
            }
            if (ci < 256) {
                u32x4 w8;
#pragma unroll
                for (int q = 0; q < 4; ++q) w8[q] = pack4_fp8(yv[4 * q] * O8_SCALE, yv[4 * q + 1] * O8_SCALE, yv[4 * q + 2] * O8_SCALE, yv[4 * q + 3] * O8_SCALE);
                *(u32x4*)(ws + WS_O8 + (size_t)(row0 + 32 * ti + j) * 2048 + 1024 + h * 256 + 32 * wid + 16 * g) = w8;
            } else {
                unsigned ow[8];
#pragma unroll
                for (int q = 0; q < 8; ++q) ow[q] = pack2(yv[2 * q], yv[2 * q + 1]);
                *(u32x4*)rp = (u32x4){ow[0], ow[1], ow[2], ow[3]}; *(u32x4*)(rp + 8) = (u32x4){ow[4], ow[5], ow[6], ow[7]}; }
        }
        __syncthreads();
    }
}

#define CE_DESC(a, b) do { const float _hi = fmaxf(a, b), _lo = fminf(a, b); a = _hi; b = _lo; } while (0)
template <int N> DI void sort_desc(float (&v)[N]) {
#pragma unroll
    for (int k = 2; k <= N; k <<= 1)
#pragma unroll
        for (int jj = k >> 1; jj > 0; jj >>= 1)
#pragma unroll
            for (int i = 0; i < N; ++i) { const int x = i ^ jj; if (x > i) { if ((i & k) == 0) CE_DESC(v[i], v[x]); else CE_DESC(v[x], v[i]); } }
}
DI void merge_top16(float (&a)[16], const float (&b)[16]) {
#pragma unroll
    for (int i = 0; i < 16; ++i) a[i] = fmaxf(a[i], b[15 - i]);
#pragma unroll
    for (int jj = 8; jj > 0; jj >>= 1)
#pragma unroll
        for (int i = 0; i < 16; ++i) { const int x = i ^ jj; if (x > i) CE_DESC(a[i], a[x]); }
}
DI void merge_partner16(float (&a)[16]) {
    float b[16];
#pragma unroll
    for (int i = 0; i < 16; ++i) b[i] = __shfl_xor(a[i], 32);
    merge_top16(a, b);
}
DI void top16_of_64(float (&v)[64], float (&o)[16]) {
    float a[16], b[16];
#pragma unroll
    for (int i = 0; i < 16; ++i) { a[i] = v[i]; b[i] = v[16 + i]; }
    sort_desc<16>(a); sort_desc<16>(b); merge_top16(a, b);
#pragma unroll
    for (int i = 0; i < 16; ++i) { o[i] = v[32 + i]; b[i] = v[48 + i]; }
    sort_desc<16>(o); sort_desc<16>(b); merge_top16(o, b);
    merge_top16(o, a);
}
DI float bsel(int c, float a, float b) { const unsigned m = (unsigned)-(c != 0); return __uint_as_float((__float_as_uint(a) & m) | (__float_as_uint(b) & ~m)); }
DI float msel(unsigned long long m, float a, float b) { float r; asm("v_cndmask_b32 %0, %1, %2, %3" : "=v"(r) : "v"(b), "v"(a), "s"(m)); return r; }
DI float set_low(float f, unsigned mask, unsigned val) { return __uint_as_float((__float_as_uint(f) & ~mask) | val); }

DI void phase_peer_select(const Params& p, int l, LAS unsigned char* lds) {
    unsigned char* const ws = ws_ptr();
    const int tid = otid(), lane = tid & 63, wid = tid >> 6, j = lane & 31, g = lane >> 5;
    const bf16_t* pq = (const bf16_t*)(ws + WS_PQ);
    const bf16_t* subk = (const bf16_t*)(ws + WS_SUBK);
    unsigned short* pidx = (unsigned short*)(ws + WS_PIDX); float* pgw = (float*)(ws + WS_PG);
    LAS unsigned* tab = (LAS unsigned*)lds + wid * 2048;
    LAS unsigned char* kimg = lds + 65536;
    const int ngroups = (l == DEPTH - 1 ? NLAT : NROW) / 32, noct = (ngroups + 7) / 8;
    int cur_ph = -1;
    for (int w = blockIdx.x; w < 8 * noct; w += gridDim.x) {
        const int ph = w & 7, grp = (w >> 3) * 8 + wid;
        if (ph != cur_ph) {
            __syncthreads();
#pragma unroll
            for (int k = 0; k < 8; ++k) { const int pc = tid + 512 * k, row = pc >> 4, c = pc & 15;
                *(LAS u32x4*)(kimg + row * 256 + ((c ^ (row & 15)) << 4)) = *(const u32x4*)(subk + (size_t)(ph * 256 + row) * 128 + c * 8); }
            __syncthreads();
            cur_ph = ph;
        }
        if (grp >= ngroups) continue;
        const int r0 = grp * 32;
        float top[2][16];
#pragma unroll
        for (int half = 0; half < 2; ++half) {
            bf16x8 Bq[8]; float ss = 0.f;
            const bf16_t* qp = pq + (size_t)(r0 + j) * 2048 + ph * 256 + half * 128 + 8 * g;
#pragma unroll
            for (int s = 0; s < 8; ++s) { const u32x4 w4 = *(const u32x4*)(qp + 16 * s); Bq[s] = __builtin_bit_cast(bf16x8, w4);
                const float e0 = bf_lo(w4.x), e1 = bf_hi(w4.x), e2 = bf_lo(w4.y), e3 = bf_hi(w4.y), e4 = bf_lo(w4.z), e5 = bf_hi(w4.z), e6 = bf_lo(w4.w), e7 = bf_hi(w4.w);
                ss += e0 * e0 + e1 * e1 + e2 * e2 + e3 * e3 + e4 * e4 + e5 * e5 + e6 * e6 + e7 * e7; }
            ss += __shfl_xor(ss, 32);
            const float rstd = rsqrtf(ss * (1.0f / 128.0f) + EPS);
#pragma unroll
            for (int r = 0; r < 16; ++r) top[half][r] = -INFINITY;
#pragma unroll 1
            for (int kt = 0; kt < 4; ++kt) {
                f32x16 acc = zero16();
#pragma unroll
                for (int s = 0; s < 8; ++s) { const int row = half * 128 + kt * 32 + j; const bf16x8 Af = *(const LAS bf16x8*)(kimg + row * 256 + (((2 * s + g) ^ (row & 15)) << 4)); acc = MFMA32(Af, Bq[s], acc); }
                float sc[16];
#pragma unroll
                for (int r = 0; r < 16; ++r) sc[r] = set_low(acc[r] * rstd, 127u, (unsigned)(32 * kt + (r & 3) + 8 * (r >> 2) + 4 * g));
                sort_desc<16>(sc);
                merge_top16(top[half], sc);
            }
            __builtin_amdgcn_sched_barrier(0);
            merge_partner16(top[half]);
        }
        float va[16], vb[16];
#pragma unroll
        for (int i = 0; i < 16; ++i) { va[i] = set_low(top[0][i], 127u, 0u); vb[i] = set_low(top[1][i], 127u, 0u);
            tab[i * 64 + lane] = __float_as_uint(top[0][i]) & 127u; tab[(16 + i) * 64 + lane] = __float_as_uint(top[1][i]) & 127u; }
        float cand[32];
#pragma unroll
        for (int i = 0; i < 27; ++i) {
            const int a = i < 16 ? 0 : (i < 23 ? 1 : (i < 26 ? 2 : 3));
            const int bb = i < 16 ? i : (i < 23 ? i - 15 : (i < 26 ? i - 21 : 3));
            const float s0 = va[a] + vb[bb], s1 = va[bb] + vb[a];
            float c = g ? s1 : s0;
            c = set_low(c, 255u, g ? (unsigned)(bb * 16 + a) : (unsigned)(a * 16 + bb));
            if (a == bb) c = g ? -INFINITY : c;
            cand[i] = c;
        }
#pragma unroll
        for (int i = 27; i < 32; ++i) cand[i] = -INFINITY;
        float ca[16], cb[16];
#pragma unroll
        for (int i = 0; i < 16; ++i) { ca[i] = cand[i]; cb[i] = cand[16 + i]; }
        sort_desc<16>(ca); sort_desc<16>(cb); merge_top16(ca, cb);
        merge_partner16(ca);
        const float mx = set_low(ca[0], 255u, 0u);
        float ev[16], sum = 0.f;
#pragma unroll
        for (int i = 0; i < 16; ++i) { ev[i] = __expf(set_low(ca[i], 255u, 0u) - mx); sum += ev[i]; }
        const float inv = 1.0f / sum;
        const size_t ob = (size_t)(r0 + j) * 128 + ph * 16 + 8 * g;
#pragma unroll
        for (int k = 0; k < 8; ++k) {
            const float cv = bsel(g, ca[8 + k], ca[k]); const float e = bsel(g, ev[8 + k], ev[k]);
            const unsigned pos = __float_as_uint(cv) & 255u;
            const unsigned i1 = tab[(pos >> 4) * 64 + lane], i2 = tab[(16 + (pos & 15)) * 64 + lane];
            pidx[ob + k] = (unsigned short)(i1 * 128u + i2); pgw[ob + k] = e * inv;
        }
    }
}

constexpr int PEER_CHUNK_ROWS = 64;
#define FP4PAIR(w, b) __builtin_amdgcn_cvt_scalef32_pk_f32_fp4((w), 1.0f, (b))
template <int PHASE_V>
DI void phase_peer_uv(const Params& p, int l, LAS unsigned char* lds, float* xo_lat, float* xo_ctx) {
    unsigned char* const ws = ws_ptr();
    const int tid = otid(), lane = tid & 63, wid = tid >> 6, tsub = lane >> 3, c8 = lane & 7;
    const bf16_t* h2 = (const bf16_t*)(ws + WS_H2);
    const unsigned char* tabl = ws + (PHASE_V ? WS_TV : WS_TU);
    const unsigned short* pidx = (const unsigned short*)(ws + WS_PIDX);
    const float* pgw = (const float*)(ws + WS_PG);
    float* part = (float*)(ws + WS_PART);
    const float* mod = (const float*)(ws + WS_MOD) + (size_t)l * 3 * 6144;
    unsigned* qh = (unsigned*)(ws + WS_CTL) + CW_QUEUE + ((l * 2 + PHASE_V) * 8) * 64;
    LAS unsigned* sh = (LAS unsigned*)lds;
    const int nchunks = (l == DEPTH - 1 ? NLAT : NROW) / PEER_CHUNK_ROWS;
    int s = (int)(xb_xcc_id() & (unsigned)(PSL - 1)), tried = 0, par = 0;
    if (tid == 0) sh[0] = __hip_atomic_fetch_add(&qh[s * 64], 1u, __ATOMIC_RELAXED, __HIP_MEMORY_SCOPE_AGENT);
    __syncthreads();
    unsigned cur = sh[0];
    for (;;) {
        if ((int)cur >= nchunks) {
            s = (s + 1) & (PSL - 1); if (++tried == PSL) break;
            if (tid == 0) sh[par ^ 1] = __hip_atomic_fetch_add(&qh[s * 64], 1u, __ATOMIC_RELAXED, __HIP_MEMORY_SCOPE_AGENT);
            __syncthreads(); cur = sh[par ^ 1]; par ^= 1; continue;
        }
        unsigned nxt = 0u;
        if (tid == 0) nxt = __hip_atomic_fetch_add(&qh[s * 64], 1u, __ATOMIC_RELAXED, __HIP_MEMORY_SCOPE_AGENT);
        const int row = (int)cur * PEER_CHUNK_ROWS + wid * 8 + tsub;
        const unsigned char* tb = tabl + (size_t)s * ((size_t)16384 * 128);
        const unsigned c8o = 16u * (unsigned)c8;
        const unsigned short* ip = pidx + (size_t)row * 128;
        auto ldrows = [&](u32x4 (&r)[16], const u32x4& a, const u32x4& c) {
            const unsigned iw[8] = {a.x, a.y, a.z, a.w, c.x, c.y, c.z, c.w};
#pragma unroll
            for (int k = 0; k < 16; ++k) { const unsigned e = (k & 1) ? (iw[k >> 1] >> 16) : (iw[k >> 1] & 0xffffu); r[k] = *(const u32x4*)(tb + (size_t)((e << 7) | c8o)); } };
        if (!PHASE_V) {
            const bf16_t* hp = h2 + (size_t)row * 1024 + 256 * s + 32 * c8;
            f32x2 hv[16];
#pragma unroll
            for (int q = 0; q < 4; ++q) { const u32x4 hw = *(const u32x4*)(hp + 8 * q);
                hv[4 * q] = (f32x2){bf_lo(hw.x), bf_hi(hw.x)}; hv[4 * q + 1] = (f32x2){bf_lo(hw.y), bf_hi(hw.y)}; hv[4 * q + 2] = (f32x2){bf_lo(hw.z), bf_hi(hw.z)}; hv[4 * q + 3] = (f32x2){bf_lo(hw.w), bf_hi(hw.w)}; }
            float* pp = part + ((size_t)s * NROW + row) * 128 + 2 * c8;
            const unsigned long long m4 = __builtin_amdgcn_ballot_w64((lane & 4) != 0), m2 = __builtin_amdgcn_ballot_w64((lane & 2) != 0), m1 = __builtin_amdgcn_ballot_w64((lane & 1) != 0);
            auto reduce = [&](const u32x4 (&uw)[16], int kb) {
                float d[16];
#pragma unroll
                for (int k = 0; k < 16; ++k) { f32x2 a2 = FP4PAIR(uw[k][0], 0) * hv[0];
                    a2 += FP4PAIR(uw[k][0], 1) * hv[1]; a2 += FP4PAIR(uw[k][0], 2) * hv[2]; a2 += FP4PAIR(uw[k][0], 3) * hv[3];
#pragma unroll
                    for (int q = 1; q < 4; ++q) { a2 += FP4PAIR(uw[k][q], 0) * hv[4 * q]; a2 += FP4PAIR(uw[k][q], 1) * hv[4 * q + 1]; a2 += FP4PAIR(uw[k][q], 2) * hv[4 * q + 2]; a2 += FP4PAIR(uw[k][q], 3) * hv[4 * q + 3]; }
                    d[k] = a2[0] + a2[1]; }
                float t8[8], t4[4], t2[2];
#pragma unroll
                for (int k = 0; k < 8; ++k) { const float keep = msel(m4, d[k + 8], d[k]), send = msel(m4, d[k], d[k + 8]); t8[k] = keep + __shfl_xor(send, 4); }
#pragma unroll
                for (int k = 0; k < 4; ++k) { const float keep = msel(m2, t8[k + 4], t8[k]), send = msel(m2, t8[k], t8[k + 4]); t4[k] = keep + __shfl_xor(send, 2); }
#pragma unroll
                for (int k = 0; k < 2; ++k) { const float keep = msel(m1, t4[k + 2], t4[k]), send = msel(m1, t4[k], t4[k + 2]); t2[k] = keep + __shfl_xor(send, 1); }
                *(f32x2*)(pp + kb * 16) = (f32x2){t2[0], t2[1]}; };
            u32x4 ia0 = *(const u32x4*)ip, ia1 = *(const u32x4*)(ip + 8), ib0 = *(const u32x4*)(ip + 16), ib1 = *(const u32x4*)(ip + 24);
            u32x4 RA[16], RB[16];
            ldrows(RA, ia0, ia1);
#pragma unroll 1
            for (int kb = 0; kb < 8; kb += 2) {
                ldrows(RB, ib0, ib1);
                { const int kn = kb + 2 < 8 ? kb + 2 : 7; ia0 = *(const u32x4*)(ip + kn * 16); ia1 = *(const u32x4*)(ip + kn * 16 + 8); }
                reduce(RA, kb);
                ldrows(RA, ia0, ia1);
                { const int kn = kb + 3 < 8 ? kb + 3 : 7; ib0 = *(const u32x4*)(ip + kn * 16); ib1 = *(const u32x4*)(ip + kn * 16 + 8); }
                reduce(RB, kb + 1);
            }
        } else {
            const float* wp = pgw + (size_t)row * 128;
            f32x2 o2[16];
#pragma unroll
            for (int i = 0; i < 16; ++i) o2[i] = (f32x2){0.f, 0.f};
            auto accum = [&](const u32x4 (&vw)[16], const f32x4 (&wq)[4]) {
#pragma unroll
                for (int k = 0; k < 16; ++k) { const float w = wq[k >> 2][k & 3]; const f32x2 w2 = (f32x2){w, w};
#pragma unroll
                    for (int q = 0; q < 4; ++q) { o2[4 * q] += w2 * FP4PAIR(vw[k][q], 0); o2[4 * q + 1] += w2 * FP4PAIR(vw[k][q], 1); o2[4 * q + 2] += w2 * FP4PAIR(vw[k][q], 2); o2[4 * q + 3] += w2 * FP4PAIR(vw[k][q], 3); } } };
            auto ldw = [&](f32x4 (&wq)[4], int kb) {
#pragma unroll
                for (int q = 0; q < 4; ++q) wq[q] = *(const f32x4*)(wp + kb * 16 + 4 * q); };
            u32x4 ia0 = *(const u32x4*)ip, ia1 = *(const u32x4*)(ip + 8), ib0 = *(const u32x4*)(ip + 16), ib1 = *(const u32x4*)(ip + 24);
            f32x4 wa[4], wb[4]; ldw(wa, 0); ldw(wb, 1);
            u32x4 RA[16], RB[16];
            ldrows(RA, ia0, ia1);
#pragma unroll 1
            for (int kb = 0; kb < 8; kb += 2) {
                ldrows(RB, ib0, ib1);
                { const int kn = kb + 2 < 8 ? kb + 2 : 7; ia0 = *(const u32x4*)(ip + kn * 16); ia1 = *(const u32x4*)(ip + kn * 16 + 8); }
                accum(RA, wa);
                { const int kn = kb + 2 < 8 ? kb + 2 : 7; ldw(wa, kn); }
                ldrows(RA, ia0, ia1);
                { const int kn = kb + 3 < 8 ? kb + 3 : 7; ib0 = *(const u32x4*)(ip + kn * 16); ib1 = *(const u32x4*)(ip + kn * 16 + 8); }
                accum(RB, wb);
                { const int kn = kb + 3 < 8 ? kb + 3 : 7; ldw(wb, kn); }
            }
            if (DBG_ZERO & 8) {
#pragma unroll
                for (int i = 0; i < 16; ++i) o2[i] = (f32x2){0.f, 0.f}; }
            const bool lat = row < NLAT;
            const int mv = lat ? (row >> 14) : 2;
            const float* g2 = mod + mv * 6144 + 5 * 1024 + 256 * s + 32 * c8;
            float* xo = (lat ? xo_lat + (size_t)row * 1024 : xo_ctx + (size_t)(row - NLAT) * 1024) + 256 * s + 32 * c8;
#pragma unroll
            for (int q = 0; q < 8; ++q) { const f32x4 xv = *(const f32x4*)(xo + 4 * q), gv = *(const f32x4*)(g2 + 4 * q);
                f32x4 o; o[0] = xv[0] + gv[0] * o2[2 * q][0]; o[1] = xv[1] + gv[1] * o2[2 * q][1]; o[2] = xv[2] + gv[2] * o2[2 * q + 1][0]; o[3] = xv[3] + gv[3] * o2[2 * q + 1][1];
                *(f32x4*)(xo + 4 * q) = o; }
        }
        if (tid == 0) sh[par ^ 1] = nxt;
        __syncthreads();
        cur = sh[par ^ 1]; par ^= 1;
    }
    __syncthreads();
}
DI void phase_peer_w(const Params& p, int l) {
    unsigned char* const ws = ws_ptr();
    const float* part = (const float*)(ws + WS_PART);
    float* pgw = (float*)(ws + WS_PG);
    const int n = (l == DEPTH - 1 ? NLAT : NROW) * 128;
    for (int i = (blockIdx.x * 512 + otid()) * 4; i < n; i += gridDim.x * 2048) {
        f32x4 sm = *(const f32x4*)(part + i);
#pragma unroll
        for (int x = 1; x < PSL; ++x) sm += *(const f32x4*)(part + (size_t)x * NROW * 128 + i);
        const f32x4 g = *(const f32x4*)(pgw + i);
        f32x4 o;
#pragma unroll
        for (int q = 0; q < 4; ++q) { const float t = sm[q] * (1.0f / PU_SCALE); o[q] = g[q] * 0.5f * t * (1.0f + erff(t * 0.70710678118654752f)) * (1.0f / PV_SCALE); }
        *(f32x4*)(pgw + i) = o;
    }
}

__global__ void __launch_bounds__(512, 2) hybrid_fwd(Params p) {
    LAS unsigned char* const ldsc = (LAS unsigned char*)lds_raw;
    LAS unsigned char* lds = ldsc + LDS_CTRL;
    if (threadIdx.x == 0) { *(LAS u32x4*)(ldsc + LDS_BARW) = (u32x4){0u, 0u, 0u, 0u}; *(LAS unsigned long long*)(ldsc + 512) = 0ull;
        LAS unsigned long long* pt = (LAS unsigned long long*)(ldsc + LDS_PTRS);
#pragma unroll
        for (int i = 0; i < 29; ++i) pt[i] = (unsigned long long)(uintptr_t)p.in[i]; }
    __syncthreads();
    XcdBarrier bar; bar.bar = (unsigned*)(p.ws + WS_CTL); bar.x = 0; bar.st = (volatile LAS unsigned*)(ldsc + LDS_BARW);
    if (p.use_bar) bar = xcd_barrier_post((unsigned*)(p.ws + WS_CTL), (volatile LAS unsigned*)(ldsc + LDS_BARW));
#define IN(ph) ((ph) >= p.gp_lo && (ph) < p.gp_hi)
#define SEAM() do { if (p.use_bar) { XcdBarrier b2; b2.bar = (unsigned*)(ws_ptr() + WS_CTL); b2.x = bar.x; b2.st = (volatile LAS unsigned*)(ldsc + LDS_BARW); xcd_barrier(b2); } else __syncthreads(); } while (0)
    unsigned long long pr_acc = 0, pr_t0 = 0;
#define PT0() do { if (PROBE_MASK) pr_t0 = __builtin_amdgcn_s_memrealtime(); } while (0)
#define PT1(k) do { if (PROBE_MASK & (1 << (k))) pr_acc += __builtin_amdgcn_s_memrealtime() - pr_t0; } while (0)
    if (IN(0)) { PT0(); phase_mod(p, (LAS float*)lds); SEAM(); PT1(15); }
    for (int l = 0; l < DEPTH; ++l) {
        const int gb = 1 + l * NPH;
        unsigned char* const ws = ws_ptr();
        float* const outp = (float*)(GAS float*)p.out;
        bf16_t* const proj = (bf16_t*)(ws + WS_PROJ);
        float* const ctxr = (float*)(ws + WS_CTX);
        const float* xin_lat = l == 0 ? PIN(I_X) : outp;
        const float* xin_ctx = l == 0 ? PIN(I_CTX) : ctxr;
        if (IN(gb + 0)) { PT0(); phase_convert(p, l, (LAS float*)lds); phase_norm(p, l, 0, xin_lat, xin_ctx, (bf16_t*)(ws + WS_H), NROW); SEAM(); PT1(0); }
        if (IN(gb + 1)) { PT0();
            pg8::Gemm g{}; g.A = (const bf16_t*)(ws + WS_H); g.Bt = (const bf16_t*)(ws + WS_WIN); g.lda = 512; g.ldb = 512; g.K = 512; g.bseg = 0;
            pg8::Order<1> so; so.init(NROW, 8704, gridDim.x, blockIdx.x);
            pg8::EpiBf16 e; e.O = proj; e.ldc = PW; e.ncols = PW; e.oscale = 1.0f / (H8_SCALE * WIN8_SCALE);
            pg8::gemm_phase<1>(lds, g, so, e, 1); SEAM(); PT1(1);
        }
        if (IN(gb + 2)) { PT0(); phase_post(p, l, lds); SEAM(); PT1(2); }
        if (IN(gb + 3)) { PT0(); phase_gla1(p, l, lds); __syncthreads(); phase_attn(p, l, lds); SEAM(); PT1(3); }
        if (IN(gb + 5)) { PT0(); phase_gla2(p); SEAM(); PT1(5); }
        if (IN(gb + 6)) { PT0(); phase_gla3(p, l, lds); SEAM(); PT1(6); }
        if (IN(gb + 7)) { PT0();
            pg8::Gemm g{}; g.A = (const bf16_t*)(ws + WS_O8); g.Bt = (const bf16_t*)(ws + WS_WO8); g.lda = 1024; g.ldb = 512; g.K = 256; g.bseg = (size_t)1024 * 512;
            g.ac0 = 0; g.ac1 = 256; g.ac2 = 512; g.ac3 = 0; g.k0 = 256; g.k1 = 256; g.k2 = 512; g.k3 = 0;
            if (l != DEPTH - 1) phase_ctx_gemm(p, l, 0, xin_ctx);
            pg8::Order<3> so; so.init(NLAT, 1024, gridDim.x, blockIdx.x);
            pg8::EpiMerge e; e.proj = proj; e.Mo = (bf16_t*)(ws + WS_M); e.oscale = 1.0f / (O8_SCALE * WO8_SCALE);
            pg8::gemm_phase<1>(lds, g, so, e, 2); SEAM(); PT1(7);
        }
        if (IN(gb + 8)) { PT0();
            pg8::Gemm g{}; g.A = (const bf16_t*)(ws + WS_M); g.Bt = (const bf16_t*)(ws + WS_WOUT); g.lda = 1024; g.ldb = 1024; g.K = 1024; g.bseg = 0;
            if (l != DEPTH - 1) phase_ctx_gemm(p, l, 1, xin_ctx);
            pg8::Order<1> so; so.init(NLAT, 1024, gridDim.x, blockIdx.x);
            pg8::EpiResid e; e.xin_lat = xin_lat; e.xin_ctx = xin_ctx; e.xout_lat = outp; e.xout_ctx = ctxr; e.gate = (const float*)(ws + WS_MOD) + (size_t)l * 3 * 6144 + 2 * 1024;
            pg8::gemm_phase<0>(lds, g, so, e, 3); SEAM(); PT1(8);
        }
        if (IN(gb + 9)) { PT0(); phase_norm(p, l, 1, outp, ctxr, (bf16_t*)(ws + WS_H2), l == DEPTH - 1 ? NLAT : NROW); SEAM(); PT1(9); }
        if (IN(gb + 10)) { PT0();
            pg8::Gemm g{}; g.A = (const bf16_t*)(ws + WS_H2); g.Bt = (const bf16_t*)(ws + WS_WPQ); g.lda = 1024; g.ldb = 1024; g.K = 1024; g.bseg = 0;
            pg8::Order<1> so; so.init(l == DEPTH - 1 ? NLAT : NROW, 2048, gridDim.x, blockIdx.x);
            pg8::EpiBf16 e; e.O = (bf16_t*)(ws + WS_PQ); e.ldc = 2048; e.ncols = 2048; e.oscale = 1.0f;
            pg8::gemm_phase<0>(lds, g, so, e, 4); SEAM(); PT1(10);
        }
        if (IN(gb + 11)) { PT0(); phase_peer_select(p, l, lds); SEAM(); PT1(11); }
        if (IN(gb + 12)) { PT0(); phase_peer_uv<0>(p, l, lds, outp, ctxr); SEAM(); PT1(12); }
        if (IN(gb + 13)) { PT0(); phase_peer_w(p, l); SEAM(); PT1(13); }
        if (IN(gb + 14)) { PT0(); phase_peer_uv<1>(p, l, lds, outp, ctxr); SEAM(); PT1(14); }
    }
    if (RPROBE && blockIdx.x == 0) { __syncthreads(); const unsigned long long acc_t = *(LAS unsigned long long*)(ldsc + 512); const unsigned long long t0 = __builtin_amdgcn_s_memrealtime(); while (__builtin_amdgcn_s_memrealtime() - t0 < acc_t) __builtin_amdgcn_s_sleep(16); }
    if (PROBE_MASK && blockIdx.x == 0) { const unsigned long long t0 = __builtin_amdgcn_s_memrealtime(); while (__builtin_amdgcn_s_memrealtime() - t0 < pr_acc * PROBE_MULT) __builtin_amdgcn_s_sleep(16); }
#undef IN
#undef SEAM
}

#ifndef MK_LAUNCHES
#define MK_LAUNCHES 0
#endif
extern "C" void kernel_launch(void* const* d_in, const int* in_sizes, int n_in, void* d_out, int out_size, void* d_ws, size_t ws_size, hipStream_t stream) {
    static int grid = 0;
    if (grid == 0) {
        if (n_in != 29 || in_sizes[0] != NLAT * D || out_size != NLAT * D || ws_size < WS_END) {
            fprintf(stderr, "kernel_launch: unexpected problem (n_in %d, in0 %d, out %d, ws %zu, need %zu); nothing launched\n", n_in, n_in > 0 ? in_sizes[0] : -1, out_size, ws_size, (size_t)WS_END); grid = -1; return; }
        int dev = 0, cus = 0, per_cu = 0;
        if (hipGetDevice(&dev) != hipSuccess || hipDeviceGetAttribute(&cus, hipDeviceAttributeMultiprocessorCount, dev) != hipSuccess) { grid = -1; return; }
        if (hipFuncSetAttribute((const void*)hybrid_fwd, hipFuncAttributeMaxDynamicSharedMemorySize, LDS_BYTES) != hipSuccess) { fprintf(stderr, "kernel_launch: hipFuncSetAttribute failed\n"); grid = -1; return; }
        if (hipOccupancyMaxActiveBlocksPerMultiprocessor(&per_cu, (const void*)hybrid_fwd, 512, LDS_BYTES) != hipSuccess || per_cu < 1) { fprintf(stderr, "kernel_launch: occupancy query says %d\n", per_cu); grid = -1; return; }
        (void)hipGetLastError();
        grid = cus;
    }
    if (grid < 0) return;
    (void)hipMemsetAsync((char*)d_ws + WS_CTL, 0, 65536, stream);
    Params p{};
    for (int i = 0; i < 29; ++i) p.in[i] = (const float*)d_in[i];
    p.out = (float*)d_out; p.ws = (unsigned char*)d_ws; p.pad0 = 0;
#if MK_LAUNCHES == 0
    p.gp_lo = 0; p.gp_hi = NGPH; p.use_bar = 1;
    hipLaunchKernelGGL(hybrid_fwd, dim3(grid), dim3(512), LDS_BYTES, stream, p);
#else
    p.use_bar = 0;
    for (int gp = 0; gp < NGPH; ++gp) { p.gp_lo = gp; p.gp_hi = gp + 1; hipLaunchKernelGGL(hybrid_fwd, dim3(grid), dim3(512), LDS_BYTES, stream, p); }
#endif
}
```

```cpp
#include <hip/hip_runtime.h>
#include <stdint.h>
#include <stdio.h>

#define DBG_ZERO 0
#define PROBE_MASK 0
#define PROBE_MULT 1
#define RPROBE 0
#define LAS __attribute__((address_space(3)))
#define DI __device__ __forceinline__
#define GAS __attribute__((address_space(1)))
typedef unsigned short bf16_t;
typedef short bf16x8 __attribute__((ext_vector_type(8)));
typedef float f32x4 __attribute__((ext_vector_type(4)));
typedef float f32x16 __attribute__((ext_vector_type(16)));
typedef unsigned u32x4 __attribute__((ext_vector_type(4)));
typedef unsigned u32x2 __attribute__((ext_vector_type(2)));

constexpr int D = 1024, NB = 2, S = 16384, LC = 256, DEPTH = 4;
constexpr int NLAT = NB * S;
constexpr int NROW = NLAT + NB * LC;
constexpr int PW = 8480;
constexpr int C_KA = 0, C_VA = 128, C_KB = 256, C_VB = 768, C_KC = 1280, C_VC = 1792, C_AC = 2816, C_QA = 2848, C_QB = 3360, C_QC = 3872, C_RC = 4384, C_GT = 5408;
constexpr int TOKB = S + LC;
constexpr int VTR = 1664;
constexpr int NCH = 260;
constexpr float EPS = 1e-6f;
constexpr float LOG2E = 1.4426950408889634f;
constexpr float O8_SCALE = 8.0f, WO8_SCALE = 64.0f;
constexpr float H8_SCALE = 8.0f, WIN8_SCALE = 64.0f;
constexpr int NPH = 15;
constexpr int NGPH = 1 + DEPTH * NPH;

constexpr size_t WS_CTL = 0;
constexpr size_t WS_MOD = 65536;
constexpr size_t WS_CTX = WS_MOD + 512 * 1024;
constexpr size_t WS_WIN = WS_CTX + 2 * 1024 * 1024;
constexpr size_t WS_WO = WS_WIN + (size_t)8704 * 1024 * 2;
constexpr size_t WS_WOUT = WS_WO + (size_t)3 * 1024 * 1024 * 2;
constexpr size_t WS_WPQ = WS_WOUT + (size_t)1024 * 1024 * 2;
constexpr size_t WS_SUBK = WS_WPQ + (size_t)2048 * 1024 * 2;
constexpr size_t WS_PU = WS_SUBK + 512 * 1024;
constexpr size_t WS_PV = WS_PU + (size_t)16384 * 1024 * 2;
constexpr size_t WS_PROJ = WS_PV + (size_t)16384 * 1024 * 2;
constexpr size_t WS_VT = WS_PROJ + (size_t)NROW * PW * 2;
constexpr size_t WS_DEC = WS_VT + (size_t)NB * VTR * TOKB * 2;
constexpr size_t WS_ST = WS_DEC + (size_t)16 * NCH * 128 * 4;
constexpr size_t WS_TU = WS_ST + (size_t)16 * NCH * 32768 * 2;
constexpr size_t WS_TV = WS_TU + (size_t)8 * 1024 * 1024;
constexpr size_t WS_WO8 = WS_TV + (size_t)8 * 1024 * 1024;
constexpr size_t WS_END = WS_WO8 + (size_t)3 * 1024 * 1024;
constexpr size_t WS_O8 = WS_PU;
constexpr size_t WS_H = WS_ST;
constexpr size_t WS_M = WS_ST + (size_t)NROW * 2048 * 2;
constexpr size_t WS_H2 = WS_VT;
constexpr size_t WS_PQ = WS_ST;
constexpr size_t WS_PART = WS_ST;
constexpr int CW_QUEUE = 4096;
constexpr size_t WS_PIDX = WS_PROJ;
constexpr size_t WS_PG = WS_PROJ + (size_t)NROW * 128 * 4;
static_assert(WS_M + (size_t)NROW * 1024 * 2 <= WS_END && (size_t)NROW * 1024 * 2 <= (size_t)NB * VTR * TOKB * 2 && WS_END <= ((size_t)1 << 30), "workspace map");

constexpr int LDS_CTRL = 1024;
constexpr int LDS_BYTES = 163840;
constexpr int LDS_BARW = 0;

DI float bf_lo(unsigned w) { return __uint_as_float(w << 16); }
DI float bf_hi(unsigned w) { return __uint_as_float(w & 0xffff0000u); }
DI float bf2f(bf16_t b) { return __uint_as_float((unsigned)b << 16); }
typedef __bf16 bf16v2 __attribute__((ext_vector_type(2)));
DI unsigned pack2(float lo, float hi) { bf16v2 v; v.x = (__bf16)lo; v.y = (__bf16)hi; return __builtin_bit_cast(unsigned, v); }
DI void unpack4_fp8(unsigned w, float& a, float& b, float& c, float& d) { const auto lo = __builtin_amdgcn_cvt_pk_f32_fp8((int)w, false), hi = __builtin_amdgcn_cvt_pk_f32_fp8((int)w, true); a = lo[0]; b = lo[1]; c = hi[0]; d = hi[1]; }
DI unsigned pack4_fp8(float a, float b, float c, float d) { int r = 0; r = __builtin_amdgcn_cvt_pk_fp8_f32(a, b, r, false); r = __builtin_amdgcn_cvt_pk_fp8_f32(c, d, r, true); return (unsigned)r; }
DI bf16_t f2bf(float f) { return (bf16_t)(pack2(f, 0.f) & 0xffffu); }
DI float wave_sum(float v) {
#pragma unroll
    for (int o = 32; o > 0; o >>= 1) v += __shfl_xor(v, o);
    return v;
}
DI int otid() { int t = threadIdx.x; asm volatile("" : "+v"(t)); return t; }
template <class T> DI T* opq(T* ptr) { const unsigned slo = (unsigned)(uintptr_t)ptr, shi = (unsigned)((uintptr_t)ptr >> 32); unsigned lo, hi;
    asm volatile("v_mov_b32 %0, %2\n\tv_mov_b32 %1, %3" : "=v"(lo), "=v"(hi) : "s"(slo), "s"(shi));
    lo = (unsigned)__builtin_amdgcn_readfirstlane((int)lo); hi = (unsigned)__builtin_amdgcn_readfirstlane((int)hi); return (T*)(GAS T*)(((uintptr_t)hi << 32) | (uintptr_t)lo); }
DI float sigmoidf_(float x) { return __builtin_amdgcn_rcpf(1.0f + __builtin_amdgcn_exp2f(x * -LOG2E)); }
DI f32x16 zero16() { f32x16 z; for (int i = 0; i < 16; ++i) z[i] = 0.f; return z; }
#define MFMA32(a, b, c) __builtin_amdgcn_mfma_f32_32x32x16_bf16((a), (b), (c), 0, 0, 0)
DI int pi32(int i) { return (i & 0x13) | ((i & 8) >> 1) | ((i & 4) << 1); }

#define XB_TMO      128
#define XB_XCNT(j)  (256  + 64 * (j))
#define XB_XSUB(j)  (1280 + 64 * (j))
#define XB_XGEN(j)  (2304 + 64 * (j))
#define XB_TOP      3328
#define XB_TOPGEN   3392
#define XCD_BAR_WORDS 3456
#define XB_SPIN_CAP (1u << 22)
DI unsigned xb_ld(unsigned* p)              { return __hip_atomic_load(p, __ATOMIC_RELAXED, __HIP_MEMORY_SCOPE_AGENT); }
DI unsigned xb_add(unsigned* p, unsigned v) { return __hip_atomic_fetch_add(p, v, __ATOMIC_RELAXED, __HIP_MEMORY_SCOPE_AGENT); }
DI unsigned xb_xcc_id() { return (unsigned)__builtin_amdgcn_s_getreg((3 << 11) | 20) & 0xFu; }
#define XB_SPIN(cond, bar) do { unsigned _sp = 0; while (cond) { __builtin_amdgcn_s_sleep(1); \
    if ((++_sp & 255u) == 0u) { if (xb_ld(&(bar)[XB_TMO])) break; if (_sp > XB_SPIN_CAP) { atomicAdd(&(bar)[XB_TMO], 1u); break; } } } } while (0)
struct XcdBarrier { unsigned* bar; unsigned x; volatile LAS unsigned* st; };
DI XcdBarrier xcd_barrier_post(unsigned* bar, volatile LAS unsigned* st) {
    XcdBarrier b; b.bar = bar; b.x = xb_xcc_id(); b.st = st;
    if (threadIdx.x == 0) (void)xb_add(&bar[XB_XCNT(b.x)], 1u);
    return b;
}
DI void xcd_barrier_complete(unsigned* bar, unsigned x, unsigned& nloc, unsigned& nx) {
    const unsigned G = gridDim.x * gridDim.y * gridDim.z;
    unsigned sum, cnt, mine, sp = 0u;
    for (;;) {
        sum = 0u; cnt = 0u; mine = 0u;
#pragma unroll
        for (unsigned j = 0; j < 16; ++j) { const unsigned c = xb_ld(&bar[XB_XCNT(j)]); sum += c; cnt += (c > 0u) ? 1u : 0u; mine = (j == x) ? c : mine; }
        if (sum == G) break;
        __builtin_amdgcn_s_sleep(1);
        if ((++sp & 255u) == 0u) { if (xb_ld(&bar[XB_TMO])) break; if (sp > XB_SPIN_CAP) { atomicAdd(&bar[XB_TMO], 1u); break; } }
    }
    nloc = mine > 0u ? mine : 1u; nx = cnt > 0u ? cnt : 1u;
}
DI void xcd_barrier(const XcdBarrier& b) {
    asm volatile("s_waitcnt vmcnt(0)" ::: "memory");
    __syncthreads();
    if (threadIdx.x == 0) {
        unsigned* bar = b.bar;
        __builtin_amdgcn_s_waitcnt(0);
        unsigned nloc = b.st[0], nx = b.st[1];
        if (nloc == 0u) { xcd_barrier_complete(bar, b.x, nloc, nx); b.st[0] = nloc; b.st[1] = nx; }
        const unsigned old = xb_add(&bar[XB_XSUB(b.x)], 1u);
        const unsigned gen = old / nloc;
        if (old + 1u == (gen + 1u) * nloc) {
            __builtin_amdgcn_fence(__ATOMIC_RELEASE, "agent");
            asm volatile("s_waitcnt vmcnt(0)" ::: "memory");
            const unsigned og = xb_add(&bar[XB_TOP], 1u);
            const unsigned tg = og / nx;
            if (og + 1u == (tg + 1u) * nx) xb_add(&bar[XB_TOPGEN], 1u);
            else XB_SPIN(xb_ld(&bar[XB_TOPGEN]) == tg, bar);
            __builtin_amdgcn_fence(__ATOMIC_ACQUIRE, "agent");
            xb_add(&bar[XB_XGEN(b.x)], 1u);
            asm volatile("s_waitcnt vmcnt(0)" ::: "memory");
        } else {
            XB_SPIN(xb_ld(&bar[XB_XGEN(b.x)]) == gen, bar);
            __builtin_amdgcn_fence(__ATOMIC_ACQUIRE, "agent");
            asm volatile("s_waitcnt vmcnt(0)" ::: "memory");
        }
    }
    __syncthreads();
}

struct Params {
    const float* in[29];
    float* out;
    unsigned char* ws;
    int gp_lo, gp_hi;
    int use_bar, pad0;
};
extern __shared__ __attribute__((aligned(16))) unsigned char lds_raw[];
constexpr int LDS_PTRS = LDS_BARW + 64;
DI const float* pin_ld(int i) { const LAS unsigned* t = (const LAS unsigned*)((LAS unsigned char*)lds_raw + LDS_PTRS) + 2 * i;
    const unsigned lo = (unsigned)__builtin_amdgcn_readfirstlane((int)t[0]), hi = (unsigned)__builtin_amdgcn_readfirstlane((int)t[1]); return (const float*)(GAS const float*)(((uintptr_t)hi << 32) | (uintptr_t)lo); }
#define PIN(i) pin_ld(i)
DI unsigned long long rp_now() { return RPROBE ? __builtin_amdgcn_s_memrealtime() : 0ull; }
DI void rp_add(int id, unsigned long long t0) { if (RPROBE != 0 && RPROBE == id && threadIdx.x == 0) { LAS unsigned long long* a = (LAS unsigned long long*)((LAS unsigned char*)lds_raw + 512); *a += __builtin_amdgcn_s_memrealtime() - t0; } }
DI unsigned char* ws_ptr() {
    typedef __attribute__((address_space(4))) const unsigned char* kptr;
    kptr ka = (kptr)__builtin_amdgcn_kernarg_segment_ptr();
    unsigned off = (unsigned)__builtin_offsetof(Params, ws); asm volatile("" : "+s"(off));
    const unsigned long long v = *(__attribute__((address_space(4))) const unsigned long long*)(ka + off);
    return (unsigned char*)(GAS unsigned char*)v; }
enum { I_X = 0, I_C, I_CTX, I_CCTX, I_WMOD, I_BMOD, I_NORM1, I_NORM2, I_WIN, I_QNA, I_KNA, I_SINKA, I_QNB, I_KNB, I_RPB, I_WA2F, I_BAF, I_WA2B, I_BAB, I_GNC, I_WOA, I_WOB, I_WOC, I_WOUT, I_WPQ, I_PQG, I_SUBK, I_PU, I_PV };

namespace pg8 {
constexpr int BM = 256, BK = 64, HALF = 128, HTB = HALF * BK * 2, STAGE_BYTES = 8 * HTB, NXCD = 8, WGM = 8;
DI int lds_byte(int r, int c) { const int st = (r >> 4) * 2 + (c >> 5), rr = r & 15, cc = c & 31, ob = rr * 64 + cc * 2; return st * 1024 + (ob ^ (((ob >> 9) & 1) << 5)); }
DI void stage_rc(int b, int& R, int& C) { const int st = b / 1024, sb = b % 1024, swz = sb ^ (((sb >> 9) & 1) << 5); R = (st >> 1) * 16 + swz / 64; C = (st & 1) * 32 + (swz % 64) / 2; }
DI int perm32(int rho) { const int n = rho >> 4, i = rho & 15; return 8 * (i >> 2) + 4 * n + (i & 3); }
struct Unit { int pm, pn, seg; };
struct Gemm { const bf16_t* A; const bf16_t* Bt; int lda, ldb, K; int ac0, ac1, ac2, ac3; int k0, k1, k2, k3; size_t bseg; };
DI int gemm_kseg(const Gemm& g, int seg) { const int k = seg == 0 ? g.k0 : (seg == 1 ? g.k1 : (seg == 2 ? g.k2 : g.k3)); return k ? k : g.K; }
DI int gemm_acol(const Gemm& g, int seg) { return seg == 0 ? g.ac0 : (seg == 1 ? g.ac1 : (seg == 2 ? g.ac2 : g.ac3)); }
template <int NSEG> struct Order {
    int nM, nN, nwg, G, c;
    DI void init(int M, int N, int G_, int c_) { nM = M / BM; nN = N / BM; nwg = nM * nN; G = G_; c = c_; }
    DI bool next(int i, Unit& u) const {
        const int t = i / NSEG; u.seg = i - t * NSEG;
        const long L = (long)t * G + c; if (L >= nwg) return false;
        int wgid = (int)L; { const int q = nwg / NXCD, r = nwg % NXCD, xcd = wgid % NXCD, off = wgid / NXCD; wgid = (xcd < r ? xcd * (q + 1) : r * (q + 1) + (xcd - r) * q) + off; }
        const int nig = WGM * nN, gid = wgid / nig, fm = gid * WGM, gsz = (nM - fm) < WGM ? (nM - fm) : WGM;
        u.pm = fm + ((wgid % nig) % gsz); u.pn = (wgid % nig) / gsz; return true;
    }
};
DI unsigned cvt_pk_bf16(float lo, float hi) { unsigned r; asm volatile("v_cvt_pk_bf16_f32 %0, %1, %2" : "=v"(r) : "v"(lo), "v"(hi)); return r; }

template <int FP8, class Epi, class Sched>
DI void gemm_phase(LAS unsigned char* lds, const Gemm g, const Sched& S, const Epi& E, int rpid) {
    const int tid = otid(), wid = __builtin_amdgcn_readfirstlane(tid >> 6), lane = tid & 63, wr = wid >> 2, wc = wid & 3, fr = lane & 15, fq = lane >> 4;
    unsigned voffA[2], voffB[2];
#pragma unroll
    for (int i = 0; i < 2; ++i) { int R, C; stage_rc(tid * 16 + i * 8192, R, C); const int Rb = Epi::PERM ? ((R & ~31) + perm32(R & 31)) : R;
        voffA[i] = (unsigned)(R * g.lda + C) * 2u; voffB[i] = (unsigned)(Rb * g.ldb + C) * 2u; }
    const size_t kstep = (size_t)(BK * 2);
    const size_t hstepA = (size_t)HALF * g.lda * 2, hstepB = (size_t)HALF * g.ldb * 2;
    const unsigned ldsw = (unsigned)wid * 1024u;
    const int aoff = lds_byte(wr * 64 + fr, fq * 8), boff = lds_byte(wc * 32 + fr, fq * 8);
#define PG8_SA(b, h) (((b) * 2 + (h)) * HTB)
#define PG8_SB(b, h) ((4 + (b) * 2 + (h)) * HTB)
#define PG8_STAGE(bufoff, gbase, voff) do { _Pragma("unroll") for (int _i = 0; _i < 2; ++_i) \
        __builtin_amdgcn_global_load_lds((const unsigned*)((const char*)(gbase) + (voff)[_i]), (LAS unsigned*)(lds + (bufoff) + ldsw + _i * 8192), 16, 0, 0); } while (0)
#define PG8_FRAG(off) (*(const LAS bf16x8*)(lds + (off)))
#define PG8_LDA(dst, b, h) do { _Pragma("unroll") for (int m = 0; m < 4; ++m) { if (FP8) dst##8[m] = __builtin_shufflevector(__builtin_bit_cast(i32x4_, PG8_FRAG(PG8_SA(b, h) + aoff + m * 2048)), __builtin_bit_cast(i32x4_, PG8_FRAG(PG8_SA(b, h) + aoff + m * 2048 + 1024)), 0, 1, 2, 3, 4, 5, 6, 7); \
        else { _Pragma("unroll") for (int k = 0; k < 2; ++k) dst[m][k] = PG8_FRAG(PG8_SA(b, h) + aoff + m * 2048 + k * 1024); } } } while (0)
#define PG8_LDB(dst, b, h) do { _Pragma("unroll") for (int n = 0; n < 2; ++n) { if (FP8) dst##8[n] = __builtin_shufflevector(__builtin_bit_cast(i32x4_, PG8_FRAG(PG8_SB(b, h) + boff + n * 2048)), __builtin_bit_cast(i32x4_, PG8_FRAG(PG8_SB(b, h) + boff + n * 2048 + 1024)), 0, 1, 2, 3, 4, 5, 6, 7); \
        else { _Pragma("unroll") for (int k = 0; k < 2; ++k) dst[n][k] = PG8_FRAG(PG8_SB(b, h) + boff + n * 2048 + k * 1024); } } } while (0)
#define PG8_MMA(ai, bj, At, Bt) do { __builtin_amdgcn_s_setprio(1); _Pragma("unroll") for (int m = 0; m < 4; ++m) _Pragma("unroll") for (int n = 0; n < 2; ++n) { \
        if (FP8) asm volatile("v_mfma_scale_f32_16x16x128_f8f6f4 %0, %1, %2, %0, %3, %3 op_sel_hi:[0,0,0]" : "+v"(acc[ai][bj][m][n]) : "v"(Bt##8[n]), "v"(At##8[m]), "v"(sc127));   \
        else { _Pragma("unroll") for (int k = 0; k < 2; ++k) acc[ai][bj][m][n] = __builtin_amdgcn_mfma_f32_16x16x32_bf16(Bt[n][k], At[m][k], acc[ai][bj][m][n], 0, 0, 0); } } \
        __builtin_amdgcn_s_setprio(0); } while (0)
#define PG8_WAIT_V(n) asm volatile("s_waitcnt vmcnt(" #n ")" ::: "memory")
#define PG8_WAIT_L(n) asm volatile("s_waitcnt lgkmcnt(" #n ")" ::: "memory")
#define PG8_BAR __builtin_amdgcn_s_barrier()
#define PG8_SCHED __builtin_amdgcn_sched_barrier(0)
#define PG8_APTR(u) ((const char*)g.A + ((size_t)(u).pm * BM * g.lda + (size_t)gemm_acol(g, (u).seg)) * 2)
#define PG8_BPTR(u) ((const char*)g.Bt + ((size_t)(u).seg * g.bseg + (size_t)(u).pn * BM * g.ldb) * 2)
    Unit cur, nxt; int ui = 0;
    if (!S.next(0, cur)) return;
    f32x4 acc[2][2][4][2];
#pragma unroll
    for (int a = 0; a < 2; ++a)
#pragma unroll
        for (int b = 0; b < 2; ++b)
#pragma unroll
            for (int m = 0; m < 4; ++m)
#pragma unroll
                for (int n = 0; n < 2; ++n) acc[a][b][m][n] = (f32x4){0.f, 0.f, 0.f, 0.f};
    typedef int i32x4_ __attribute__((ext_vector_type(4))); typedef int i32x8_ __attribute__((ext_vector_type(8)));
    bf16x8 At[4][2], B0[2][2], B1[2][2];
    i32x8_ At8[4], B08[2], B18[2];
    int sc127 = 127; asm volatile("" : "+v"(sc127));
    const char* cA = PG8_APTR(cur); const char* cB = PG8_BPTR(cur);
    PG8_STAGE(PG8_SB(0, 0), cB, voffB); PG8_STAGE(PG8_SA(0, 0), cA, voffA); PG8_STAGE(PG8_SB(0, 1), cB + hstepB, voffB); PG8_STAGE(PG8_SA(0, 1), cA + hstepA, voffA);
    if (wr == 1) PG8_BAR;
    PG8_WAIT_V(4); PG8_BAR;
    PG8_STAGE(PG8_SB(1, 0), cB + kstep, voffB); PG8_STAGE(PG8_SA(1, 0), cA + kstep, voffA); PG8_STAGE(PG8_SB(1, 1), cB + hstepB + kstep, voffB);
    PG8_WAIT_V(6); PG8_BAR;
    for (;;) {
        const bool has_next = S.next(ui + 1, nxt);
        const int nt = gemm_kseg(g, cur.seg) / BK;
        const char* nA = has_next ? PG8_APTR(nxt) : cA; const char* nB = has_next ? PG8_BPTR(nxt) : cB;
        for (int t = 0; t < nt; t += 2) {
            const bool last = (t == nt - 2);
            const char* a1 = cA + (size_t)(t + 1) * kstep;
            const char* a2 = last ? nA : cA + (size_t)(t + 2) * kstep; const char* b2 = last ? nB : cB + (size_t)(t + 2) * kstep;
            const char* a3 = a2 + kstep; const char* b3 = b2 + kstep;
            PG8_LDB(B0, 0, 0); PG8_SCHED; PG8_LDA(At, 0, 0); PG8_STAGE(PG8_SA(1, 1), a1 + hstepA, voffA);
            PG8_WAIT_L(8); PG8_BAR; PG8_WAIT_L(0); PG8_MMA(0, 0, At, B0); PG8_BAR; PG8_SCHED;
            PG8_LDB(B1, 0, 1); PG8_STAGE(PG8_SB(0, 0), b2, voffB);
            PG8_BAR; PG8_WAIT_L(0); PG8_MMA(0, 1, At, B1); PG8_BAR;
            PG8_LDA(At, 0, 1); PG8_STAGE(PG8_SA(0, 0), a2, voffA);
            PG8_BAR; PG8_WAIT_L(0); PG8_MMA(1, 0, At, B0); PG8_BAR; PG8_SCHED;
            PG8_STAGE(PG8_SB(0, 1), b2 + hstepB, voffB);
            PG8_WAIT_V(6); PG8_BAR; PG8_MMA(1, 1, At, B1); PG8_BAR;
            PG8_LDB(B0, 1, 0); PG8_SCHED; PG8_LDA(At, 1, 0); PG8_STAGE(PG8_SA(0, 1), a2 + hstepA, voffA);
            PG8_WAIT_L(8); PG8_BAR; PG8_WAIT_L(0); PG8_MMA(0, 0, At, B0); PG8_BAR; PG8_SCHED;
            PG8_LDB(B1, 1, 1); PG8_STAGE(PG8_SB(1, 0), b3, voffB);
            PG8_BAR; PG8_WAIT_L(0); PG8_MMA(0, 1, At, B1); PG8_BAR;
            PG8_LDA(At, 1, 1); PG8_STAGE(PG8_SA(1, 0), a3, voffA);
            PG8_BAR; PG8_WAIT_L(0); PG8_MMA(1, 0, At, B0); PG8_BAR; PG8_SCHED;
            PG8_STAGE(PG8_SB(1, 1), b3 + hstepB, voffB);
            PG8_WAIT_V(6); PG8_BAR; PG8_MMA(1, 1, At, B1); PG8_BAR;
        }
        if (FP8) asm volatile("s_nop 15\n\ts_nop 15" ::: "memory");
        { const unsigned long long rt = rp_now(); E(acc, cur, wr, wc, fr, fq); if (RPROBE) asm volatile("s_waitcnt vmcnt(0)" ::: "memory"); rp_add(rpid, rt); }
        if (!has_next) break;
#pragma unroll
        for (int a = 0; a < 2; ++a)
#pragma unroll
            for (int b = 0; b < 2; ++b)
#pragma unroll
                for (int m = 0; m < 4; ++m)
#pragma unroll
                    for (int n = 0; n < 2; ++n) acc[a][b][m][n] = (f32x4){0.f, 0.f, 0.f, 0.f};
        cur = nxt; cA = nA; cB = nB; ++ui;
    }
    PG8_WAIT_V(0);
    if (wr == 0) PG8_BAR;
    PG8_BAR;
#undef PG8_SA
#undef PG8_SB
#undef PG8_STAGE
#undef PG8_FRAG
#undef PG8_LDA
#undef PG8_LDB
#undef PG8_MMA
#undef PG8_WAIT_V
#undef PG8_WAIT_L
#undef PG8_BAR
#undef PG8_SCHED
#undef PG8_APTR
#undef PG8_BPTR
}

struct EpiBf16 {
    static constexpr bool PERM = true;
    bf16_t* O; int ldc, ncols; float oscale;
    DI void operator()(const f32x4 (&acc)[2][2][4][2], const Unit& u, int wr, int wc, int fr, int fq) const {
        const int row0 = u.pm * BM + wr * 64 + fr, col0 = u.pn * BM + wc * 32 + 8 * fq;
#pragma unroll
        for (int ai = 0; ai < 2; ++ai)
#pragma unroll
            for (int m = 0; m < 4; ++m) { bf16_t* rowp = O + (size_t)(row0 + ai * HALF + m * 16) * ldc + col0;
#pragma unroll
                for (int bj = 0; bj < 2; ++bj) { const f32x4 v0 = acc[ai][bj][m][0] * oscale, v1 = acc[ai][bj][m][1] * oscale;
                    u32x4 w; w.x = cvt_pk_bf16(v0[0], v0[1]); w.y = cvt_pk_bf16(v0[2], v0[3]); w.z = cvt_pk_bf16(v1[0], v1[1]); w.w = cvt_pk_bf16(v1[2], v1[3]);
                    if (col0 + bj * HALF < ncols) *(u32x4*)(rowp + bj * HALF) = w; } }
    }
};
struct EpiMerge {
    static constexpr bool PERM = true;
    const bf16_t* proj; bf16_t* Mo; float oscale;
    DI void operator()(const f32x4 (&acc)[2][2][4][2], const Unit& u, int wr, int wc, int fr, int fq) const {
        const int row0 = u.pm * BM + wr * 64 + fr, col0 = u.pn * BM + wc * 32 + 8 * fq;
        const int gsel = u.seg;
        const bf16_t* gbase = proj + (size_t)row0 * PW + C_GT + gsel * 1024 + col0;
        bf16_t* mbase = Mo + (size_t)row0 * 1024 + col0;
#pragma unroll
        for (int ai = 0; ai < 2; ++ai) {
            u32x4 gw[4][2], pw[4][2];
#pragma unroll
            for (int m = 0; m < 4; ++m)
#pragma unroll
                for (int bj = 0; bj < 2; ++bj) {
                    gw[m][bj] = *(const u32x4*)(gbase + (size_t)(ai * HALF + m * 16) * PW + bj * HALF);
                    pw[m][bj] = u.seg > 0 ? *(const u32x4*)(mbase + (size_t)(ai * HALF + m * 16) * 1024 + bj * HALF) : (u32x4){0u, 0u, 0u, 0u};
                }
#pragma unroll
            for (int m = 0; m < 4; ++m)
#pragma unroll
                for (int bj = 0; bj < 2; ++bj) {
                    const u32x4 g4 = gw[m][bj], p4 = pw[m][bj];
                    f32x4 v0 = acc[ai][bj][m][0] * oscale, v1 = acc[ai][bj][m][1] * oscale;
                    v0[0] *= sigmoidf_(bf_lo(g4.x)); v0[1] *= sigmoidf_(bf_hi(g4.x)); v0[2] *= sigmoidf_(bf_lo(g4.y)); v0[3] *= sigmoidf_(bf_hi(g4.y));
                    v1[0] *= sigmoidf_(bf_lo(g4.z)); v1[1] *= sigmoidf_(bf_hi(g4.z)); v1[2] *= sigmoidf_(bf_lo(g4.w)); v1[3] *= sigmoidf_(bf_hi(g4.w));
                    if (DBG_ZERO & (1 << gsel)) { v0 *= 0.f; v1 *= 0.f; }
                    v0[0] += bf_lo(p4.x); v0[1] += bf_hi(p4.x); v0[2] += bf_lo(p4.y); v0[3] += bf_hi(p4.y); v1[0] += bf_lo(p4.z); v1[1] += bf_hi(p4.z); v1[2] += bf_lo(p4.w); v1[3] += bf_hi(p4.w);
                    u32x4 w; w.x = cvt_pk_bf16(v0[0], v0[1]); w.y = cvt_pk_bf16(v0[2], v0[3]); w.z = cvt_pk_bf16(v1[0], v1[1]); w.w = cvt_pk_bf16(v1[2], v1[3]);
                    *(u32x4*)(mbase + (size_t)(ai * HALF + m * 16) * 1024 + bj * HALF) = w;
                }
        }
    }
};
struct EpiResid {
    static constexpr bool PERM = false;
    const float* xin_lat; const float* xin_ctx; float* xout_lat; float* xout_ctx; const float* gate;
    DI void operator()(const f32x4 (&acc)[2][2][4][2], const Unit& u, int wr, int wc, int fr, int fq) const {
        const int rowt = u.pm * BM;
        const bool lat = rowt < NLAT;
        const int mv = lat ? (rowt >> 14) : 2;
        const float* xin = lat ? xin_lat + (size_t)rowt * 1024 : xin_ctx + (size_t)(rowt - NLAT) * 1024;
        float* xo = lat ? xout_lat + (size_t)rowt * 1024 : xout_ctx + (size_t)(rowt - NLAT) * 1024;
        const int r0 = wr * 64 + fr, col0 = u.pn * BM + wc * 32 + 4 * fq;
        const float* gp = gate + mv * 6144 + col0;
        f32x4 gv[2][2];
#pragma unroll
        for (int bj = 0; bj < 2; ++bj)
#pragma unroll
            for (int n = 0; n < 2; ++n) gv[bj][n] = *(const f32x4*)(gp + bj * HALF + n * 16);
#pragma unroll
        for (int ai = 0; ai < 2; ++ai)
#pragma unroll
            for (int mh = 0; mh < 2; ++mh) {
                f32x4 xv[2][2][2];
#pragma unroll
                for (int m2 = 0; m2 < 2; ++m2)
#pragma unroll
                    for (int bj = 0; bj < 2; ++bj)
#pragma unroll
                        for (int n = 0; n < 2; ++n) xv[m2][bj][n] = *(const f32x4*)(xin + (unsigned)(r0 + ai * HALF + (mh * 2 + m2) * 16) * 1024u + (unsigned)(col0 + bj * HALF + n * 16));
#pragma unroll
                for (int m2 = 0; m2 < 2; ++m2)
#pragma unroll
                    for (int bj = 0; bj < 2; ++bj)
#pragma unroll
                        for (int n = 0; n < 2; ++n) *(f32x4*)(xo + (unsigned)(r0 + ai * HALF + (mh * 2 + m2) * 16) * 1024u + (unsigned)(col0 + bj * HALF + n * 16)) = xv[m2][bj][n] + gv[bj][n] * acc[ai][bj][mh * 2 + m2][n];
            }
    }
};
}

DI f32x4 ctx_tile16(const bf16_t* A, int lda, const bf16_t* Bt, int ldb, int K, int lane) {
    const bf16_t* ap = A + (size_t)(lane & 15) * lda + 8 * (lane >> 4);
    const bf16_t* bp = Bt + (size_t)(lane & 15) * ldb + 8 * (lane >> 4);
    f32x4 acc0 = (f32x4){0.f, 0.f, 0.f, 0.f}, acc1 = acc0;
#pragma unroll 1
    for (int k = 0; k < K; k += 512) {
        bf16x8 a[16], b[16];
#pragma unroll
        for (int i = 0; i < 16; ++i) { a[i] = *(const bf16x8*)(ap + k + 32 * i); b[i] = *(const bf16x8*)(bp + k + 32 * i); }
#pragma unroll
        for (int i = 0; i < 16; i += 2) { acc0 = __builtin_amdgcn_mfma_f32_16x16x32_bf16(a[i], b[i], acc0, 0, 0, 0); acc1 = __builtin_amdgcn_mfma_f32_16x16x32_bf16(a[i + 1], b[i + 1], acc1, 0, 0, 0); }
    }
    return acc0 + acc1;
}
DI void phase_ctx_gemm(const Params& p, int l, int which, const float* xin_ctx) {
    unsigned char* const ws = ws_ptr();
    const int tid = otid(), lane = tid & 63, wid = tid >> 6;
    const bf16_t* proj = (const bf16_t*)(ws + WS_PROJ);
    bf16_t* Mo = (bf16_t*)(ws + WS_M);
    const int ncolt = which == 2 ? 128 : 64, ntile = 32 * ncolt;
    for (int wt = blockIdx.x * 8 + wid; wt < ntile; wt += gridDim.x * 8) {
        const int tr = wt / ncolt, tc = wt - tr * ncolt;
        const int r0 = NLAT + 16 * tr, c0 = 16 * tc;
        const int rowq = r0 + (lane >> 4) * 4, col = c0 + (lane & 15);
        if (which == 0) {
            f32x4 tot = (f32x4){0.f, 0.f, 0.f, 0.f};
#pragma unroll
            for (int seg = 0; seg < 3; ++seg) {
                const int acol = seg == 0 ? C_QA : (seg == 1 ? C_QB : C_RC), kk = seg == 2 ? 1024 : 512;
                const f32x4 acc = ctx_tile16(proj + (size_t)r0 * PW + acol, PW, (const bf16_t*)(ws + WS_WO) + (size_t)seg * 1024 * 1024 + (size_t)c0 * 1024, 1024, kk, lane);
#pragma unroll
                for (int q = 0; q < 4; ++q) tot[q] += sigmoidf_(bf2f(proj[(size_t)(rowq + q) * PW + C_GT + seg * 1024 + col])) * acc[q];
            }
#pragma unroll
            for (int q = 0; q < 4; ++q) Mo[(size_t)(rowq + q) * 1024 + col] = f2bf(tot[q]);
        } else if (which == 1) {
            const f32x4 acc = ctx_tile16(Mo + (size_t)r0 * 1024, 1024, (const bf16_t*)(ws + WS_WOUT) + (size_t)c0 * 1024, 1024, 1024, lane);
            const float g1 = ((const float*)(ws + WS_MOD))[((size_t)l * 3 + 2) * 6144 + 2 * 1024 + col];
            float* xo = (float*)(ws + WS_CTX);
#pragma unroll
            for (int q = 0; q < 4; ++q) { const size_t o = (size_t)(rowq + q - NLAT) * 1024 + col; xo[o] = xin_ctx[o] + g1 * acc[q]; }
        } else {
            const f32x4 acc = ctx_tile16((const bf16_t*)(ws + WS_H2) + (size_t)r0 * 1024, 1024, (const bf16_t*)(ws + WS_WPQ) + (size_t)c0 * 1024, 1024, 1024, lane);
            bf16_t* pq = (bf16_t*)(ws + WS_PQ);
#pragma unroll
            for (int q = 0; q < 4; ++q) pq[(size_t)(rowq + q) * 2048 + col] = f2bf(acc[q]);
        }
    }
}

DI void phase_mod(const Params& p, LAS float* lds) {
    unsigned char* const ws = ws_ptr();
    const int tid = otid();
    LAS float* act = lds;
    LAS float* red = lds + 3072;
    for (int i = tid; i < 3072; i += 512) { const int v = i >> 10, k = i & 1023; const float x = v < 2 ? PIN(I_C)[v * 1024 + k] : PIN(I_CCTX)[k]; act[i] = x / (1.0f + __expf(-x)); }
    __syncthreads();
    float* mod = (float*)(ws + WS_MOD);
    const int c4 = tid & 7, kg = tid >> 3;
    for (int cb = blockIdx.x; cb < 768; cb += gridDim.x) {
        const int l = cb / 192, col0 = (cb - l * 192) * 32;
        const float* W = PIN(I_WMOD) + (size_t)l * 1024 * 6144 + col0 + 4 * c4;
        f32x4 a0 = (f32x4){0.f, 0.f, 0.f, 0.f}, a1 = a0, a2 = a0;
#pragma unroll 8
        for (int k = kg; k < 1024; k += 64) { const f32x4 w = *(const f32x4*)(W + (size_t)k * 6144); a0 += w * act[k]; a1 += w * act[1024 + k]; a2 += w * act[2048 + k]; }
        *(LAS f32x4*)(red + (kg * 3 + 0) * 32 + 4 * c4) = a0; *(LAS f32x4*)(red + (kg * 3 + 1) * 32 + 4 * c4) = a1; *(LAS f32x4*)(red + (kg * 3 + 2) * 32 + 4 * c4) = a2;
        __syncthreads();
        if (tid < 96) { const int v = tid >> 5, cc = tid & 31; float sm = 0.f;
#pragma unroll 16
            for (int q = 0; q < 64; ++q) sm += red[(q * 3 + v) * 32 + cc];
            const int cj = col0 + cc;
            mod[((size_t)l * 3 + v) * 6144 + cj] = sm + PIN(I_BMOD)[l * 6144 + cj]; }
        __syncthreads();
    }

}

DI void tcvt_load(const float* src, int N, int kt, int nt, int tid, f32x4 (&v)[2]) {
    const int r = tid >> 4, c4 = (tid & 15) * 4;
#pragma unroll
    for (int i = 0; i < 2; ++i) { const int kk = kt * 64 + r + 32 * i, nn = nt * 64 + c4;
        v[i] = (f32x4){0.f, 0.f, 0.f, 0.f};
        if (nn < N) v[i] = *(const f32x4*)(src + (size_t)kk * N + nn); }
}
DI void tcvt_job(const float* src, int K, int N, int Npad, bf16_t* dst, int ldd, LAS float* tile, int& base, float fp8scale = 0.f) {
    const int tid = otid();
    const int nkt = K / 64, nnt = Npad / 64, ntl = nkt * nnt, G = gridDim.x;
    const int first = ((int)blockIdx.x - (base % G) + G) % G;
    f32x4 v[2];
    if (first < ntl) tcvt_load(src, N, first % nkt, first / nkt, tid, v);
    for (int t = first; t < ntl; t += G) {
        const int kt = t % nkt, nt = t / nkt;
        { const int r = tid >> 4, c4 = (tid & 15) * 4;
#pragma unroll
            for (int i = 0; i < 2; ++i) { LAS float* tp = tile + (r + 32 * i) * 65 + c4; tp[0] = v[i][0]; tp[1] = v[i][1]; tp[2] = v[i][2]; tp[3] = v[i][3]; } }
        if (t + G < ntl) tcvt_load(src, N, (t + G) % nkt, (t + G) / nkt, tid, v);
        __syncthreads();
        { const int n = tid >> 3, kc = (tid & 7) * 8; float x[8];
#pragma unroll
            for (int jj = 0; jj < 8; ++jj) x[jj] = tile[(kc + jj) * 65 + n];
            if (fp8scale != 0.f) { u32x2 w8; w8.x = pack4_fp8(x[0] * fp8scale, x[1] * fp8scale, x[2] * fp8scale, x[3] * fp8scale); w8.y = pack4_fp8(x[4] * fp8scale, x[5] * fp8scale, x[6] * fp8scale, x[7] * fp8scale);
                *(u32x2*)((unsigned char*)dst + (size_t)(nt * 64 + n) * ldd + kt * 64 + kc) = w8; }
            else { u32x4 w; w.x = pack2(x[0], x[1]); w.y = pack2(x[2], x[3]); w.z = pack2(x[4], x[5]); w.w = pack2(x[6], x[7]);
                *(u32x4*)(dst + (size_t)(nt * 64 + n) * ldd + kt * 64 + kc) = w; } }
        __syncthreads();
    }
    base += ntl;
}
DI void cvt_copy(const float* src, bf16_t* dst, size_t n) {
    const size_t nth = (size_t)gridDim.x * 512;
    for (size_t i = ((size_t)blockIdx.x * 512 + otid()) * 8; i < n; i += nth * 8) {
        const f32x4 a = *(const f32x4*)(src + i), b = *(const f32x4*)(src + i + 4);
        u32x4 w; w.x = pack2(a[0], a[1]); w.y = pack2(a[2], a[3]); w.z = pack2(b[0], b[1]); w.w = pack2(b[2], b[3]);
        *(u32x4*)(dst + i) = w;
    }
}
typedef float f32x2 __attribute__((ext_vector_type(2)));
constexpr float PU_SCALE = 64.0f, PV_SCALE = 4.0f;
constexpr int PSL = 4;
DI unsigned fp4_code(float x) {
    const float a = fabsf(x);
    const unsigned c = (unsigned)(a > 0.25f) + (unsigned)(a > 0.75f) + (unsigned)(a > 1.25f) + (unsigned)(a > 1.75f) + (unsigned)(a > 2.5f) + (unsigned)(a > 3.5f) + (unsigned)(a > 5.0f);
    return c | ((__float_as_uint(x) >> 28) & 8u);
}
DI unsigned pack8_fp4(const f32x4& a, const f32x4& b) {
    return fp4_code(a[0]) | (fp4_code(a[1]) << 4) | (fp4_code(a[2]) << 8) | (fp4_code(a[3]) << 12) | (fp4_code(b[0]) << 16) | (fp4_code(b[1]) << 20) | (fp4_code(b[2]) << 24) | (fp4_code(b[3]) << 28);
}
DI void cvt_copy_fp4(const float* src, unsigned char* dst, size_t n, float scale) {
    const size_t nth = (size_t)gridDim.x * 512;
    for (size_t i = ((size_t)blockIdx.x * 512 + otid()) * 32; i < n; i += nth * 32) {
        u32x4 w;
#pragma unroll
        for (int q = 0; q < 4; ++q) { const f32x4 a = *(const f32x4*)(src + i + 8 * q) * scale, b = *(const f32x4*)(src + i + 8 * q + 4) * scale; w[q] = pack8_fp4(a, b); }
        const size_t e = i >> 10, c0 = i & 1023;
        *(u32x4*)(dst + (c0 >> 8) * ((size_t)16384 * 128) + e * 128 + ((c0 & 255) >> 1)) = w;
    }
}
DI void phase_convert(const Params& p, int l, LAS float* lds) {
    unsigned char* const ws = ws_ptr();
    int base = 0;
    tcvt_job(PIN(I_WIN) + (size_t)l * 1024 * PW, 1024, PW, 8704, (bf16_t*)(ws + WS_WIN), 1024, lds, base, WIN8_SCALE);
    tcvt_job(PIN(I_WOA) + (size_t)l * 512 * 1024, 512, 1024, 1024, (bf16_t*)(ws + WS_WO), 1024, lds, base);
    tcvt_job(PIN(I_WOB) + (size_t)l * 512 * 1024, 512, 1024, 1024, (bf16_t*)(ws + WS_WO) + (size_t)1 * 1024 * 1024, 1024, lds, base);
    tcvt_job(PIN(I_WOC) + (size_t)l * 1024 * 1024, 1024, 1024, 1024, (bf16_t*)(ws + WS_WO) + (size_t)2 * 1024 * 1024, 1024, lds, base);
    tcvt_job(PIN(I_WOA) + (size_t)l * 512 * 1024, 512, 1024, 1024, (bf16_t*)(ws + WS_WO8), 1024, lds, base, WO8_SCALE);
    tcvt_job(PIN(I_WOB) + (size_t)l * 512 * 1024, 512, 1024, 1024, (bf16_t*)(ws + WS_WO8 + (size_t)1024 * 1024), 1024, lds, base, WO8_SCALE);
    tcvt_job(PIN(I_WOC) + (size_t)l * 1024 * 1024, 1024, 1024, 1024, (bf16_t*)(ws + WS_WO8 + (size_t)2 * 1024 * 1024), 1024, lds, base, WO8_SCALE);
    tcvt_job(PIN(I_WOUT) + (size_t)l * 1024 * 1024, 1024, 1024, 1024, (bf16_t*)(ws + WS_WOUT), 1024, lds, base);
    tcvt_job(PIN(I_WPQ) + (size_t)l * 1024 * 2048, 1024, 2048, 2048, (bf16_t*)(ws + WS_WPQ), 1024, lds, base);
    { const float* sk = PIN(I_SUBK) + (size_t)l * 262144; const float* pg = PIN(I_PQG) + l * 128; bf16_t* dst = (bf16_t*)(ws + WS_SUBK);
        for (int i = (blockIdx.x * 512 + otid()) * 2; i < 262144; i += gridDim.x * 1024) {
            const int d = i & 127; *(unsigned*)(dst + i) = pack2(sk[i] * pg[d], sk[i + 1] * pg[d + 1]); } }
    cvt_copy_fp4(PIN(I_PU) + (size_t)l * 16384 * 1024, ws + WS_TU, (size_t)16384 * 1024, PU_SCALE);
    cvt_copy_fp4(PIN(I_PV) + (size_t)l * 16384 * 1024, ws + WS_TV, (size_t)16384 * 1024, PV_SCALE);
}

DI void phase_norm(const Params& p, int l, int which, const float* xlat, const float* xctx, bf16_t* dst, int nrows) {
    unsigned char* const ws = ws_ptr();
    const int tid = otid(), lane = tid & 63, wid = tid >> 6;
    const float* gain = PIN(which ? I_NORM2 : I_NORM1) + l * 1024;
    const float* mod = (const float*)(ws + WS_MOD) + (size_t)l * 3 * 6144;
    for (int r0 = (blockIdx.x * 8 + wid) * 2; r0 < nrows; r0 += gridDim.x * 16) {
        f32x4 v[2][4];
#pragma unroll
        for (int rr = 0; rr < 2; ++rr) { const int r = r0 + rr; const float* x = r < NLAT ? xlat + (size_t)r * 1024 : xctx + (size_t)(r - NLAT) * 1024;
#pragma unroll
            for (int i = 0; i < 4; ++i) v[rr][i] = *(const f32x4*)(x + i * 256 + lane * 4); }
#pragma unroll
        for (int rr = 0; rr < 2; ++rr) { const int r = r0 + rr;
            const int mv = r < NLAT ? (r >> 14) : 2;
            const float* sh = mod + mv * 6144 + (which ? 3 : 0) * 1024; const float* sc = sh + 1024;
            float ss = 0.f;
#pragma unroll
            for (int i = 0; i < 4; ++i) ss += v[rr][i][0] * v[rr][i][0] + v[rr][i][1] * v[rr][i][1] + v[rr][i][2] * v[rr][i][2] + v[rr][i][3] * v[rr][i][3];
            ss = wave_sum(ss);
            const float rstd = rsqrtf(ss * (1.0f / 1024.0f) + EPS);
#pragma unroll
            for (int i = 0; i < 4; ++i) { const int c = i * 256 + lane * 4;
                const f32x4 g4 = *(const f32x4*)(gain + c), s4 = *(const f32x4*)(sc + c), h4 = *(const f32x4*)(sh + c);
                float y[4];
#pragma unroll
                for (int jj = 0; jj < 4; ++jj) y[jj] = v[rr][i][jj] * rstd * g4[jj] * (1.0f + s4[jj]) + h4[jj];
                if (which == 0) *(unsigned*)((unsigned char*)dst + (size_t)r * 1024 + c) = pack4_fp8(y[0] * H8_SCALE, y[1] * H8_SCALE, y[2] * H8_SCALE, y[3] * H8_SCALE);
                else { u32x2 w; w.x = pack2(y[0], y[1]); w.y = pack2(y[2], y[3]); *(u32x2*)(dst + (size_t)r * 1024 + c) = w; } } }
    }
}

DI void phase_post(const Params& p, int l, LAS unsigned char* lds) {
    unsigned char* const ws = ws_ptr();
    const int tid = otid(), lane = tid & 63, wid = tid >> 6;
    bf16_t* proj = (bf16_t*)(ws + WS_PROJ);
    {
        LAS float* tab = (LAS float*)lds;
        LAS float* gn = (LAS float*)(lds + 32768);
        for (int i = tid; i < 4096; i += 512) { const int pos = i >> 4, f = i & 15;
            const float inv = exp2f(-(float)f * (13.287712379549449f / 16.0f));
            const float ang = (float)pos * inv;
            const float n = rintf(ang * 0.15915494309189535f); float rr = fmaf(-n, 6.28125f, ang); rr = fmaf(-n, 1.9353071795864769e-3f, rr);
            tab[2 * i] = __cosf(rr); tab[2 * i + 1] = __sinf(rr); }
        if (tid < 256) { const int w = tid >> 6, d = tid & 63; gn[tid] = PIN(w == 0 ? I_QNA : (w == 1 ? I_QNB : (w == 2 ? I_KNB : I_KNA)))[l * 64 + d]; }
        __syncthreads();
        const int c8 = lane & 7;
        const float sgn = (c8 & 2) ? 1.0f : -1.0f;
        for (int r = blockIdx.x * 8 + wid; r < NROW; r += gridDim.x * 8) {
            bf16_t* row = proj + (size_t)r * PW;
            const bool lat = r < NLAT;
            const int t = r & (S - 1);
            const int pos = (c8 < 4) ? (t >> 6) : (t & 63);
            u32x4 wpre[4];
#pragma unroll
            for (int ps = 0; ps < 4; ++ps) { const int col = (ps == 0 ? C_QA : (ps == 1 ? C_QB : (ps == 2 ? C_KB : C_KA))) + 8 * (ps == 3 ? (lane & 15) : lane); wpre[ps] = *(const u32x4*)(row + col); }
#pragma unroll
            for (int ps = 0; ps < 4; ++ps) {
                const int col = (ps == 0 ? C_QA : (ps == 1 ? C_QB : (ps == 2 ? C_KB : C_KA))) + 8 * lane;
                if (ps == 3 && lane >= 16) continue;
                const u32x4 w = wpre[ps];
                float v[8] = {bf_lo(w.x), bf_hi(w.x), bf_lo(w.y), bf_hi(w.y), bf_lo(w.z), bf_hi(w.z), bf_lo(w.w), bf_hi(w.w)};
                float ss = 0.f;
#pragma unroll
                for (int i = 0; i < 8; ++i) ss += v[i] * v[i];
                ss += __shfl_xor(ss, 1); ss += __shfl_xor(ss, 2); ss += __shfl_xor(ss, 4);
                const float rstd = rsqrtf(ss * (1.0f / 64.0f) + EPS);
#pragma unroll
                for (int i = 0; i < 8; ++i) v[i] *= rstd * gn[ps * 64 + 8 * c8 + i];
                if ((ps == 0 || ps == 3) && lat) {
#pragma unroll
                    for (int i = 0; i < 8; ++i) { const float yp = __shfl_xor(v[i], 2); const int f = 8 * (c8 & 1) + i;
                        const float cs = tab[(pos * 16 + f) * 2], sn = tab[(pos * 16 + f) * 2 + 1];
                        v[i] = v[i] * cs + sgn * yp * sn; }
                }
                u32x4 o; o.x = pack2(v[0], v[1]); o.y = pack2(v[2], v[3]); o.z = pack2(v[4], v[5]); o.w = pack2(v[6], v[7]);
                *(u32x4*)(row + col) = o;
            }
        }
        __syncthreads();
    }
    {
        bf16_t* vt = (bf16_t*)(ws + WS_VT);
        const int ntl = (NROW / 64) * 13;
        const int rr = tid >> 3, ch = (tid & 7) * 16;
        auto src_of = [&](int it) -> const bf16_t* {
            const int tt = it / 13, cg = it - tt * 13;
            const int row0 = tt < 512 ? ((tt >> 8) * S + (tt & 255) * 64) : (NLAT + ((tt - 512) >> 2) * LC + ((tt - 512) & 3) * 64);
            const int vr0 = cg * 128;
            const int scol = vr0 < 128 ? C_VA + vr0 : (vr0 < 640 ? C_VB + (vr0 - 128) : C_VC + (vr0 - 640));
            return proj + (size_t)(row0 + rr) * PW + scol + ch; };
        int par = 0;
        u32x4 w0 = (u32x4){0u, 0u, 0u, 0u}, w1 = w0;
        if ((int)blockIdx.x < ntl) { const bf16_t* sp = src_of(blockIdx.x); w0 = *(const u32x4*)sp; w1 = *(const u32x4*)(sp + 8); }
        for (int it = blockIdx.x; it < ntl; it += gridDim.x, par ^= 1) {
            LAS bf16_t* tile = (LAS bf16_t*)(lds + par * 17408);
            const int tt = it / 13, cg = it - tt * 13;
            int b, tok0;
            if (tt < 512) { b = tt >> 8; tok0 = (tt & 255) * 64; } else { b = (tt - 512) >> 2; tok0 = S + ((tt - 512) & 3) * 64; }
            const int vr0 = cg * 128;
            *(LAS u32x4*)(tile + rr * 136 + ch) = w0; *(LAS u32x4*)(tile + rr * 136 + ch + 8) = w1;
            { const int nx = it + gridDim.x; if (nx < ntl) { const bf16_t* sp = src_of(nx); w0 = *(const u32x4*)sp; w1 = *(const u32x4*)(sp + 8); } }
            __syncthreads();
            { const int cc = tid >> 2, tk = (tid & 3) * 16; unsigned short v[16];
#pragma unroll
                for (int jj = 0; jj < 16; ++jj) v[jj] = tile[(tk + jj) * 136 + cc];
                u32x4 o0, o1;
                o0.x = v[0] | ((unsigned)v[1] << 16); o0.y = v[2] | ((unsigned)v[3] << 16); o0.z = v[4] | ((unsigned)v[5] << 16); o0.w = v[6] | ((unsigned)v[7] << 16);
                o1.x = v[8] | ((unsigned)v[9] << 16); o1.y = v[10] | ((unsigned)v[11] << 16); o1.z = v[12] | ((unsigned)v[13] << 16); o1.w = v[14] | ((unsigned)v[15] << 16);
                bf16_t* dp = vt + ((size_t)b * VTR + vr0 + cc) * TOKB + tok0 + tk;
                *(u32x4*)dp = o0; *(u32x4*)(dp + 8) = o1; }
        }
        __syncthreads();
    }
}

struct AttnState { bf16x8 Q[2][4]; f32x16 O[2][2]; float m[2], l[2]; };
struct TileRef { unsigned ku, vu; int kpos0; const LAS float* brow; };
struct AttnLane { const char* pb; const char* vb;
    unsigned ksrc, vsrc;
    LAS unsigned char* kbuf; LAS unsigned char* vbuf;
    unsigned krd, vrd; };
DI void attn_dma_k(const AttnLane& al, unsigned ku, int par) {
    const char* src = al.pb + (size_t)(ku + al.ksrc);
#pragma unroll
    for (int q = 0; q < 4; ++q) __builtin_amdgcn_global_load_lds((const unsigned*)(src + (size_t)q * (8 * PW * 2)), (LAS unsigned*)(al.kbuf + par * 8192 + q * 1024), 16, 0, 0);
}
DI void attn_dma_v(const AttnLane& al, unsigned vu, int par) {
    const char* src = al.vb + (size_t)(vu + al.vsrc);
#pragma unroll
    for (int q = 0; q < 4; ++q) __builtin_amdgcn_global_load_lds((const unsigned*)(src + (size_t)q * (16 * TOKB * 2)), (LAS unsigned*)(al.vbuf + par * 8192 + q * 1024), 16, 0, 0);
}
template <int MODE>
DI void attn_tile(AttnState& st, const AttnLane& al, int par, const TileRef& tr, unsigned kunext, unsigned vunext, int qpos0, int g, bool domask) {
    asm volatile("s_waitcnt vmcnt(12)" ::: "memory");
    f32x16 sc[2];
    {
        bf16x8 Kf[4];
#pragma unroll
        for (int s = 0; s < 4; ++s) Kf[s] = *(const LAS bf16x8*)(al.kbuf + par * 8192 + (al.krd ^ (unsigned)(s << 4)));
#pragma unroll
        for (int u = 0; u < 2; ++u) {
            sc[u] = zero16();
#pragma unroll
            for (int s = 0; s < 4; ++s) sc[u] = MFMA32(Kf[s], st.Q[u][s], sc[u]);
        }
    }
    asm volatile("s_waitcnt lgkmcnt(0)" ::: "memory");
    attn_dma_k(al, kunext, par);
    const int kpos0 = tr.kpos0;
    bf16x8 Vf[2][2];
#pragma unroll
    for (int u = 0; u < 2; ++u) {
        const int qp = qpos0 + 32 * u;
        if (MODE == 1 && domask) {
            const int base = kpos0 + 8 * g - qp + 128;
#pragma unroll
            for (int r = 0; r < 16; ++r) sc[u][r] = ((unsigned)(base + 16 * (r >> 3) + (r & 7)) <= 256u) ? sc[u][r] : -INFINITY;
        } else if (MODE == 2 && domask) {
            int cs = qp - 8; cs = cs < 0 ? 0 : (cs > 48 ? 48 : cs);
            const int vb = kpos0 + 8 * g - cs;
            const LAS float* bp = tr.brow + (kpos0 + 8 * g - qp + 15);
            float bv[16];
#pragma unroll
            for (int r = 0; r < 16; ++r) bv[r] = bp[16 * (r >> 3) + (r & 7)];
            asm volatile("" ::: "memory");
#pragma unroll
            for (int r = 0; r < 16; ++r) { const int o = 16 * (r >> 3) + (r & 7); const float t = sc[u][r] + bv[r]; sc[u][r] = ((unsigned)(vb + o) < 16u) ? t : -INFINITY; }
        }
        float mx = sc[u][0];
#pragma unroll
        for (int r = 1; r < 16; ++r) mx = fmaxf(mx, sc[u][r]);
        mx = fmaxf(mx, __shfl_xor(mx, 32));
        const float mn = fmaxf(st.m[u], mx);
        float rs = 0.f;
#pragma unroll
        for (int r = 0; r < 16; ++r) { const float pv = __builtin_amdgcn_exp2f(sc[u][r] - mn); rs += pv; sc[u][r] = pv; }
        if (__builtin_amdgcn_ballot_w64(mn > st.m[u]) != 0ull) {
            const float alpha = __builtin_amdgcn_exp2f(st.m[u] - mn);
            st.l[u] *= alpha;
#pragma unroll
            for (int r = 0; r < 16; ++r) { st.O[0][u][r] *= alpha; st.O[1][u][r] *= alpha; }
        }
        st.m[u] = mn;
        st.l[u] += rs;
        bf16x8 P[2];
#pragma unroll
        for (int s = 0; s < 2; ++s) { u32x4 w; w.x = pack2(sc[u][8 * s], sc[u][8 * s + 1]); w.y = pack2(sc[u][8 * s + 2], sc[u][8 * s + 3]); w.z = pack2(sc[u][8 * s + 4], sc[u][8 * s + 5]); w.w = pack2(sc[u][8 * s + 6], sc[u][8 * s + 7]);
            P[s] = __builtin_bit_cast(bf16x8, w); }
        if (u == 0) {
            asm volatile("s_waitcnt vmcnt(12)" ::: "memory");
#pragma unroll
            for (int dt = 0; dt < 2; ++dt)
#pragma unroll
                for (int s = 0; s < 2; ++s) Vf[dt][s] = *(const LAS bf16x8*)(al.vbuf + par * 8192 + dt * 2048 + (al.vrd ^ (unsigned)(s << 5)));
        }
#pragma unroll
        for (int dt = 0; dt < 2; ++dt)
#pragma unroll
            for (int s = 0; s < 2; ++s) st.O[dt][u] = MFMA32(Vf[dt][s], P[s], st.O[dt][u]);
    }
    asm volatile("s_waitcnt lgkmcnt(0)" ::: "memory");
    attn_dma_v(al, vunext, par);
}
DI void attn_load_q(AttnState& st, const bf16_t* proj, int qrow0, int qcol, int j, int g) {
    const float qs = 0.125f * LOG2E;
#pragma unroll
    for (int u = 0; u < 2; ++u) {
        const bf16_t* qp = proj + (size_t)(qrow0 + 32 * u + j) * PW + qcol + 32 * g;
#pragma unroll
        for (int s = 0; s < 4; ++s) { const u32x4 w = *(const u32x4*)(qp + 8 * s); u32x4 o;
            o.x = pack2(bf_lo(w.x) * qs, bf_hi(w.x) * qs); o.y = pack2(bf_lo(w.y) * qs, bf_hi(w.y) * qs); o.z = pack2(bf_lo(w.z) * qs, bf_hi(w.z) * qs); o.w = pack2(bf_lo(w.w) * qs, bf_hi(w.w) * qs);
            st.Q[u][s] = __builtin_bit_cast(bf16x8, o); }
        st.O[0][u] = zero16(); st.O[1][u] = zero16();
    }
}
DI void attn_store(const AttnState& st, bf16_t* proj, int qrow0, int ocol, int j, int g) {
#pragma unroll
    for (int u = 0; u < 2; ++u) {
        const float lt = st.l[u] + __shfl_xor(st.l[u], 32);
        const float inv = 1.0f / lt;
        bf16_t* op = proj + (size_t)(qrow0 + 32 * u + j) * PW + ocol + 4 * g;
#pragma unroll
        for (int dt = 0; dt < 2; ++dt)
#pragma unroll
            for (int q = 0; q < 4; ++q) { u32x2 w; w.x = pack2(st.O[dt][u][4 * q] * inv, st.O[dt][u][4 * q + 1] * inv); w.y = pack2(st.O[dt][u][4 * q + 2] * inv, st.O[dt][u][4 * q + 3] * inv);
                *(u32x2*)(op + 32 * dt + 8 * q) = w; }
    }
}
DI void attn_store8(const AttnState& st, unsigned char* o8, int qrow0, int obyte, int j, int g) {
#pragma unroll
    for (int u = 0; u < 2; ++u) {
        const float lt = st.l[u] + __shfl_xor(st.l[u], 32);
        const float inv = O8_SCALE / lt;
        unsigned char* op = o8 + (size_t)(qrow0 + 32 * u + j) * 2048 + obyte + 4 * g;
#pragma unroll
        for (int dt = 0; dt < 2; ++dt)
#pragma unroll
            for (int q = 0; q < 4; ++q) *(unsigned*)(op + 32 * dt + 8 * q) = pack4_fp8(st.O[dt][u][4 * q] * inv, st.O[dt][u][4 * q + 1] * inv, st.O[dt][u][4 * q + 2] * inv, st.O[dt][u][4 * q + 3] * inv);
    }
}
struct CtxTiles { unsigned k0, v0;
    DI TileRef operator()(int t) const { TileRef r; r.ku = k0 + (unsigned)(32 * t) * (PW * 2); r.vu = v0 + 64 * t; r.kpos0 = 0; r.brow = nullptr; return r; } };
struct LocATiles { unsigned k0, v0; int p0;
    DI TileRef operator()(int t) const { TileRef r; const int kp0 = p0 + 32 * t; r.ku = k0 + (unsigned)kp0 * (PW * 2); r.vu = v0 + 2 * kp0; r.kpos0 = kp0; r.brow = nullptr; return r; } };
struct LocBTiles { unsigned k0, v0; int rs; const LAS float* rpbh; int r;
    DI TileRef operator()(int t) const { TileRef q; const int kr = rs + (t >> 1), c0 = (t & 1) * 32; q.ku = k0 + (unsigned)(kr * 64 + c0) * (PW * 2); q.vu = v0 + 2 * (kr * 64 + c0); q.kpos0 = c0; q.brow = rpbh + (kr - r + 7) * 31; return q; } };
struct NoTiles { DI TileRef operator()(int) const { TileRef r; r.ku = 0; r.vu = 0; r.kpos0 = 0; r.brow = nullptr; return r; } };
template <int MODE, class LT>
DI void attn_run(AttnState& st, const AttnLane& al, const CtxTiles& ct, const LT& lt, int lo, int hi, int ulo, int uhi, int qpos0, int g) {
    const int ntot = 8 + (hi - lo);
    TileRef cur = ct(0), n1 = ct(1);
    attn_dma_k(al, cur.ku, 0); attn_dma_v(al, cur.vu, 0); attn_dma_k(al, n1.ku, 1); attn_dma_v(al, n1.vu, 1);
#pragma unroll 1
    for (int tt = 0; tt < ntot; ++tt) {
        int t2 = tt + 2; if (t2 > ntot - 1) t2 = ntot - 1;
        TileRef n2; if (t2 < 8) n2 = ct(t2); else n2 = lt(lo + t2 - 8);
        const int tl = lo + tt - 8;
        const bool domask = (tt >= 8) && !(tl >= ulo && tl < uhi);
        attn_tile<MODE>(st, al, tt & 1, cur, n2.ku, n2.vu, qpos0, g, domask);
        cur = n1; n1 = n2;
    }
}
DI void phase_attn(const Params& p, int l, LAS unsigned char* lds) {
    unsigned char* const ws = ws_ptr();
    const int tid = otid(), lane = tid & 63, wid = tid >> 6, j = lane & 31, g = lane >> 5;
    bf16_t* proj = (bf16_t*)(ws + WS_PROJ);
    LAS float* rpb = (LAS float*)(lds + 256);
    for (int i = tid; i < 8 * 15 * 31; i += 512) rpb[i] = PIN(I_RPB)[l * 3720 + i] * LOG2E;
    __syncthreads();
    const bool last = (l == DEPTH - 1);
    const int nitems = 8192 + (last ? 0 : 128);
    AttnLane al; al.pb = (const char*)(ws + WS_PROJ); al.vb = (const char*)(ws + WS_VT);
    { const int kr = lane >> 3, kc = (lane & 7) ^ (kr & 7); al.ksrc = (unsigned)(kr * PW * 2 + kc * 16);
        const int vr = lane >> 2, vc = (lane & 3) ^ ((vr >> 2) & 3); al.vsrc = (unsigned)(vr * TOKB * 2 + vc * 16);
        const int wu = __builtin_amdgcn_readfirstlane(wid);
        al.kbuf = lds + 16384 + wu * 16384; al.vbuf = lds + 16384 + wu * 16384 + 4096;
        const int rho = pi32(j); al.krd = (unsigned)(rho * 128 + (((4 * g) ^ (rho & 7)) << 4));
        al.vrd = (unsigned)(j * 64 + ((g ^ ((j >> 2) & 3)) << 4)); }
    for (int it = blockIdx.x * 8 + wid; it < nitems; it += gridDim.x * 8) {
        AttnState st;
        if (it < 4096) {
            const int half = it & 1, hh = (it >> 1) & 7, n = (it >> 4) & 127, b = it >> 11;
            const int q0 = n * 128 + half * 64, qrow0 = b * S + q0, g2 = hh >> 2;
            attn_load_q(st, proj, qrow0, C_QA + hh * 64, j, g);
            const float sk = PIN(I_SINKA)[l * 8 + hh] * LOG2E;
            st.m[0] = st.m[1] = sk; st.l[0] = st.l[1] = (g == 0) ? 1.0f : 0.0f;
            CtxTiles ct; ct.k0 = (unsigned)((NLAT + b * LC) * PW + C_KA + g2 * 64) * 2u; ct.v0 = (unsigned)((b * VTR + g2 * 64) * TOKB + S) * 2u;
            LocATiles la; la.k0 = (unsigned)(b * S * PW + C_KA + g2 * 64) * 2u; la.v0 = (unsigned)((b * VTR + g2 * 64) * TOKB) * 2u; la.p0 = (n - 1) * 128;
            int lo = half ? 2 : 0, hi = half ? 12 : 10;
            if (n == 0 && lo < 4) lo = 4;
            if (n == 127 && hi > 8) hi = 8;
            attn_run<1>(st, al, ct, la, lo, hi, 2 + 2 * half, 8 + 2 * half, q0 + j, g);
            attn_store8(st, ws + WS_O8, qrow0, hh * 64, j, g);
        } else if (it < 8192) {
            const int i2 = it - 4096, h = i2 & 7, r = (i2 >> 3) & 255, b = i2 >> 11;
            const int qrow0 = b * S + r * 64;
            attn_load_q(st, proj, qrow0, C_QB + h * 64, j, g);
            st.m[0] = st.m[1] = -INFINITY; st.l[0] = st.l[1] = 0.f;
            CtxTiles ct; ct.k0 = (unsigned)((NLAT + b * LC) * PW + C_KB + h * 64) * 2u; ct.v0 = (unsigned)((b * VTR + 128 + h * 64) * TOKB + S) * 2u;
            int rs = r - 4; rs = rs < 0 ? 0 : (rs > 248 ? 248 : rs);
            LocBTiles lb; lb.k0 = (unsigned)(b * S * PW + C_KB + h * 64) * 2u; lb.v0 = (unsigned)((b * VTR + 128 + h * 64) * TOKB) * 2u; lb.rs = rs; lb.rpbh = rpb + h * 15 * 31; lb.r = r;
            attn_run<2>(st, al, ct, lb, 0, 16, 0, 0, j, g);
            attn_store8(st, ws + WS_O8, qrow0, 512 + h * 64, j, g);
        } else {
            const int i2 = it - 8192, qt = i2 & 3, h = (i2 >> 2) & 7, b = (i2 >> 5) & 1, mixer = i2 >> 6;
            const int qrow0 = NLAT + b * LC + qt * 64;
            const int qcol = mixer == 0 ? C_QA + h * 64 : C_QB + h * 64;
            const int kcol = mixer == 0 ? C_KA + (h >> 2) * 64 : C_KB + h * 64;
            const int vr0 = mixer == 0 ? (h >> 2) * 64 : 128 + h * 64;
            attn_load_q(st, proj, qrow0, qcol, j, g);
            const float sk = PIN(I_SINKA)[l * 8 + h] * LOG2E;
            st.m[0] = st.m[1] = mixer == 0 ? sk : -INFINITY; st.l[0] = st.l[1] = (mixer == 0 && g == 0) ? 1.0f : 0.0f;
            CtxTiles ct; ct.k0 = (unsigned)((NLAT + b * LC) * PW + kcol) * 2u; ct.v0 = (unsigned)((b * VTR + vr0) * TOKB + S) * 2u;
            NoTiles nt;
            attn_run<0>(st, al, ct, nt, 0, 0, 0, 0, 0, g);
            attn_store(st, proj, qrow0, qcol, j, g);
        }
    }
}

DI void gla_chunk_rows(int b, int ci, int& row0, int& tok0) {
    if (ci < 256) { tok0 = ci * 64; row0 = b * S + tok0; } else { const int cc = ci - 256; tok0 = S + cc * 64; row0 = NLAT + b * LC + cc * 64; }
}
constexpr int GL_A = 0;
constexpr int GL_W = 8192;
constexpr int GL_B = 24576;
constexpr int GL_QT = 27648;
constexpr int GL_SSQ = 25600;
constexpr int GL_LA = 30720;
constexpr int GL_QH = 63488;
constexpr int GL_KT = 79872;
constexpr int GL_SB = 96256;
constexpr int GL_OUT = GL_QH + 18432;
constexpr int GL_ATT = GL_LA;
DI u32x4 gla_load_a(const bf16_t* proj, int row0, int) {
    const int tid = otid();
    u32x4 w = (u32x4){0u, 0u, 0u, 0u};
    if (tid < 256) w = *(const u32x4*)(proj + (size_t)(row0 + (tid >> 2)) * PW + C_AC + (tid & 3) * 8);
    return w;
}
DI void gla_stage_gate(const Params& p, int l, const u32x4& w, int h, LAS unsigned char* lds, int& cur_h) {
    const int tid = otid();
    LAS float* a_s = (LAS float*)(lds + GL_A); LAS float* w_s = (LAS float*)(lds + GL_W); LAS float* b_s = (LAS float*)(lds + GL_B);
    if (tid < 256) { const int tok = tid >> 2, c8 = (tid & 3) * 8;
        LAS float* d = a_s + tok * 32 + c8; d[0] = bf_lo(w.x); d[1] = bf_hi(w.x); d[2] = bf_lo(w.y); d[3] = bf_hi(w.y); d[4] = bf_lo(w.z); d[5] = bf_hi(w.z); d[6] = bf_lo(w.w); d[7] = bf_hi(w.w); }
    if (h != cur_h) {
        cur_h = h;
#pragma unroll
        for (int q = 0; q < 8; ++q) { const int i = tid + q * 512, dir = i >> 11, rr = (i >> 7) & 15, ch = i & 127;
            w_s[i] = PIN(dir ? I_WA2B : I_WA2F)[(size_t)l * 16 * 512 + rr * 512 + h * 128 + ch]; }
        if (tid < 256) { const int dir = tid >> 7, ch = tid & 127; b_s[tid] = PIN(dir ? I_BAB : I_BAF)[l * 512 + h * 128 + ch]; }
    }
}
DI void gla_logdecay(int dir, LAS unsigned char* lds) {
    const int tid = otid();
    const LAS float* a_s = (const LAS float*)(lds + GL_A); const LAS float* w_s = (const LAS float*)(lds + GL_W) + dir * 2048; const LAS float* b_s = (const LAS float*)(lds + GL_B) + dir * 128;
    LAS float* la = (LAS float*)(lds + GL_LA);
    LAS float* qt = (LAS float*)(lds + GL_QT);
    const int ch = tid & 127, tq = tid >> 7; float w[16];
#pragma unroll
    for (int i = 0; i < 16; ++i) w[i] = w_s[i * 128 + ch];
    const float bb = b_s[ch];
    float run = 0.f;
#pragma unroll 4
    for (int t = 0; t < 16; ++t) { const int tok = tq * 16 + (dir ? 15 - t : t); float z = bb;
        const LAS f32x4* ap = (const LAS f32x4*)(a_s + tok * 32 + dir * 16);
#pragma unroll
        for (int i = 0; i < 4; ++i) { const f32x4 av = ap[i]; z += av[0] * w[4 * i] + av[1] * w[4 * i + 1] + av[2] * w[4 * i + 2] + av[3] * w[4 * i + 3]; }
        run += (fminf(z, 0.f) - __logf(1.0f + __expf(-fabsf(z)))) * (1.0f / 16.0f);
        la[tok * 128 + ch] = run; }
    qt[tq * 128 + ch] = run;
    __syncthreads();
    float off = 0.f;
#pragma unroll
    for (int q = 0; q < 4; ++q) { const float v = qt[q * 128 + ch]; off += (dir ? (q > tq) : (q < tq)) ? v : 0.f; }
#pragma unroll
    for (int t = 0; t < 16; ++t) la[(tq * 16 + t) * 128 + ch] += off;
    __syncthreads();
}
DI void phase_gla1(const Params& p, int l, LAS unsigned char* lds) {
    unsigned char* const ws = ws_ptr();
    const int tid = otid(), lane = tid & 63, wid = tid >> 6, j = lane & 31, g = lane >> 5;
    const bf16_t* proj = (const bf16_t*)(ws + WS_PROJ);
    const bf16_t* vt = (const bf16_t*)(ws + WS_VT);
    unsigned char* stt = ws + WS_ST; float* dec = (float*)(ws + WS_DEC);
    const LAS float* la = (const LAS float*)(lds + GL_LA);
    LAS bf16_t* ktT = (LAS bf16_t*)(lds + GL_QH);
    int cur_h = -1;
    u32x4 a_pre = (u32x4){0u, 0u, 0u, 0u};
    if ((int)blockIdx.x < NB * NCH * 4) { int r0_, t0_; gla_chunk_rows(((int)blockIdx.x >> 2) / NCH, ((int)blockIdx.x >> 2) % NCH, r0_, t0_); a_pre = gla_load_a(proj, r0_, tid); }
    for (int un = blockIdx.x; un < NB * NCH * 4; un += gridDim.x) {
        const int h = un & 3, ci = (un >> 2) % NCH, b = (un >> 2) / NCH;
        int row0, tok0; gla_chunk_rows(b, ci, row0, tok0);
        gla_stage_gate(p, l, a_pre, h, lds, cur_h);
        { const int un2 = un + gridDim.x; if (un2 < NB * NCH * 4) { int r0_, t0_; gla_chunk_rows((un2 >> 2) / NCH, (un2 >> 2) % NCH, r0_, t0_); a_pre = gla_load_a(proj, r0_, tid); } }
        bf16x8 Vf[4];
#pragma unroll
        for (int s = 0; s < 4; ++s) Vf[s] = *(const bf16x8*)(vt + ((size_t)b * VTR + 640 + h * 256 + 32 * wid + j) * TOKB + tok0 + 16 * s + 8 * g);
        const u32x4 k0 = *(const u32x4*)(proj + (size_t)(row0 + (tid >> 3)) * PW + C_KC + h * 128 + (tid & 7) * 16), k1 = *(const u32x4*)(proj + (size_t)(row0 + (tid >> 3)) * PW + C_KC + h * 128 + (tid & 7) * 16 + 8);
        __syncthreads();
        for (int dir = 0; dir < 2; ++dir) {
            gla_logdecay(dir, lds);
            const int chain = (b * 4 + h) * 2 + dir;
            { const int tok = tid >> 3, cc = (tid & 7) * 16;
                const unsigned kw[8] = {k0.x, k0.y, k0.z, k0.w, k1.x, k1.y, k1.z, k1.w};
                const int te = dir ? 0 : 63;
#pragma unroll
                for (int q = 0; q < 8; ++q) { const int ch = cc + 2 * q;
                    const float w0 = __expf(la[te * 128 + ch] - la[tok * 128 + ch]), w1 = __expf(la[te * 128 + ch + 1] - la[tok * 128 + ch + 1]);
                    const int tr_ = (tok + 8 * (ch >> 4)) & 63;
                    ktT[ch * 72 + tr_] = f2bf(bf_lo(kw[q]) * w0); ktT[(ch + 1) * 72 + tr_] = f2bf(bf_hi(kw[q]) * w1); } }
            if (tid < 128) dec[((size_t)chain * NCH + ci) * 128 + tid] = __expf(la[(dir ? 0 : 63) * 128 + tid]);
            __syncthreads();
            unsigned char* so = stt + ((size_t)chain * NCH + ci) * 32768 + (size_t)(32 * wid) * 128;
            LAS unsigned char* ob = lds + GL_OUT + wid * 8704;
            const int prow = 16 * ((j >> 2) & 1) + 4 * (j >> 3) + (j & 3);
#pragma unroll
            for (int dk = 0; dk < 4; ++dk) {
                f32x16 acc = zero16();
                const int krow = 32 * dk + prow;
#pragma unroll
                for (int s = 0; s < 4; ++s) { const bf16x8 Af = *(const LAS bf16x8*)(ktT + krow * 72 + (((2 * s + g + (krow >> 4)) & 7) << 3)); acc = MFMA32(Af, Vf[s], acc); }
                u32x4 w0;
                w0.x = pack4_fp8(acc[0], acc[1], acc[2], acc[3]); w0.y = pack4_fp8(acc[4], acc[5], acc[6], acc[7]); w0.z = pack4_fp8(acc[8], acc[9], acc[10], acc[11]); w0.w = pack4_fp8(acc[12], acc[13], acc[14], acc[15]);
                *(LAS u32x4*)(ob + j * 144 + 32 * dk + 16 * g) = w0;
            }
#pragma unroll
            for (int q = 0; q < 4; ++q) { const int row = 8 * q + (lane >> 3), chk = lane & 7;
                *(u32x4*)(so + (size_t)row * 128 + chk * 16) = *(const LAS u32x4*)(ob + row * 144 + chk * 16); }
            __syncthreads();
        }
    }
}
DI void phase_gla2(const Params& p) {
    unsigned char* const ws = ws_ptr();
    const char* sb = (const char*)(ws + WS_ST); const char* db = (const char*)(ws + WS_DEC);
    for (int gt = blockIdx.x * 512 + otid(); gt < 16 * 8192; gt += gridDim.x * 512) {
        const int chain = gt >> 13, e = gt & 8191, dv = e >> 5, dk0 = (e & 31) * 4, dir = chain & 1;
        const unsigned so = (unsigned)(chain * NCH * 32768 + dv * 128 + dk0), dof = (unsigned)((chain * NCH * 128 + dk0) * 4);
        float s0, s1, s2, s3;
        asm volatile("v_mov_b32 %0, 0\n\tv_mov_b32 %1, 0\n\tv_mov_b32 %2, 0\n\tv_mov_b32 %3, 0" : "=v"(s0), "=v"(s1), "=v"(s2), "=v"(s3));
        auto chunk_of = [&](int step) -> int { return dir ? (NCH - 1 - step) : (step < 4 ? 256 + step : step - 4); };
        unsigned dS[4], dSn[4]; f32x4 dd[4], ddn[4];
#pragma unroll
        for (int q = 0; q < 4; ++q) { const unsigned c = (unsigned)chunk_of(q); dS[q] = *(const unsigned*)(sb + (size_t)(so + c * 32768u)); dd[q] = *(const f32x4*)(db + (size_t)(dof + c * 512u)); }
        for (int st = 0; st < NCH; st += 4) {
            const int sn = st + 4 < NCH ? st + 4 : st;
#pragma unroll
            for (int q = 0; q < 4; ++q) { const unsigned c = (unsigned)chunk_of(sn + q); dSn[q] = *(const unsigned*)(sb + (size_t)(so + c * 32768u)); ddn[q] = *(const f32x4*)(db + (size_t)(dof + c * 512u)); }
#pragma unroll
            for (int q = 0; q < 4; ++q) {
                *(unsigned*)((char*)sb + (size_t)(so + (unsigned)chunk_of(st + q) * 32768u)) = pack4_fp8(s0, s1, s2, s3);
                float e0, e1, e2, e3; unpack4_fp8(dS[q], e0, e1, e2, e3);
                s0 = dd[q][0] * s0 + e0; s1 = dd[q][1] * s1 + e1; s2 = dd[q][2] * s2 + e2; s3 = dd[q][3] * s3 + e3;
            }
#pragma unroll
            for (int q = 0; q < 4; ++q) { dS[q] = dSn[q]; dd[q] = ddn[q]; }
        }
    }
}
DI int gl_swz(int tok, int chunk) { return tok * 256 + ((chunk ^ (tok & 15)) << 4); }
template <int DIR>
DI void gla3_dir(const Params& p, LAS unsigned char* lds, const u32x4 (&qk)[4], const unsigned char* state, const bf16x8 (&Vf)[2][2], f32x16 (&O)[2]) {
    const int tid = otid(), lane = tid & 63, wid = tid >> 6, j = lane & 31, g = lane >> 5;
    LAS unsigned char* sb = lds + GL_SB + __builtin_amdgcn_readfirstlane(wid) * 8192;
    { const char* src = (const char*)(state + (size_t)(32 * wid) * 128);
#pragma unroll
        for (int q = 0; q < 4; ++q) { const int r = 8 * q + (lane >> 3), c = (lane & 7) ^ (r & 7);
            __builtin_amdgcn_global_load_lds((const unsigned*)(src + r * 128 + c * 16), (LAS unsigned*)(sb + q * 1024), 16, 0, 0); } }
    gla_logdecay(DIR, lds);

    const LAS float* la = (const LAS float*)(lds + GL_LA);
    { const int tok = tid >> 3, cc = (tid & 7) * 16;
        u32x4 q0 = qk[0], q1 = qk[1], k0 = qk[2], k1 = qk[3];
        asm volatile("" : "+v"(q0), "+v"(q1), "+v"(k0), "+v"(k1));
        const unsigned qw[8] = {q0.x, q0.y, q0.z, q0.w, q1.x, q1.y, q1.z, q1.w}, kw[8] = {k0.x, k0.y, k0.z, k0.w, k1.x, k1.y, k1.z, k1.w};
        unsigned qo[8], ko[8];
#pragma unroll
        for (int q = 0; q < 8; ++q) { const float b0 = la[tok * 128 + cc + 2 * q], b1 = la[tok * 128 + cc + 2 * q + 1];
            qo[q] = pack2(bf_lo(qw[q]) * 0.08838834764831845f * __expf(b0), bf_hi(qw[q]) * 0.08838834764831845f * __expf(b1));
            ko[q] = pack2(bf_lo(kw[q]) * __expf(fminf(-b0, 80.f)), bf_hi(kw[q]) * __expf(fminf(-b1, 80.f))); }
        const int c0 = (tid & 7) * 2;
        *(LAS u32x4*)(lds + GL_QH + gl_swz(tok, c0)) = (u32x4){qo[0], qo[1], qo[2], qo[3]}; *(LAS u32x4*)(lds + GL_QH + gl_swz(tok, c0 + 1)) = (u32x4){qo[4], qo[5], qo[6], qo[7]};
        *(LAS u32x4*)(lds + GL_KT + gl_swz(tok, c0)) = (u32x4){ko[0], ko[1], ko[2], ko[3]}; *(LAS u32x4*)(lds + GL_KT + gl_swz(tok, c0 + 1)) = (u32x4){ko[4], ko[5], ko[6], ko[7]}; }
    __syncthreads();
    if (wid < 4) {
        const int tj = wid >> 1, ti = wid & 1;
        const bool skip = DIR == 0 ? (tj > ti) : (tj < ti);
        if (!skip) {
            f32x16 acc = zero16();
            const int ktok = 32 * tj + pi32(j), qtok = 32 * ti + j;
#pragma unroll
            for (int s = 0; s < 8; ++s) { const bf16x8 Af = *(const LAS bf16x8*)(lds + GL_KT + gl_swz(ktok, 2 * s + g)), Bf = *(const LAS bf16x8*)(lds + GL_QH + gl_swz(qtok, 2 * s + g)); acc = MFMA32(Af, Bf, acc); }
#pragma unroll
            for (int r = 0; r < 16; ++r) { const int kt = 32 * tj + 16 * (r >> 3) + 8 * g + (r & 7); const bool keep = DIR == 0 ? (kt <= qtok) : (kt >= qtok); acc[r] = keep ? acc[r] : 0.f; }
            asm volatile("s_waitcnt lgkmcnt(0)" ::: "memory");
#pragma unroll
            for (int s = 0; s < 2; ++s) { u32x4 w; w.x = pack2(acc[8 * s], acc[8 * s + 1]); w.y = pack2(acc[8 * s + 2], acc[8 * s + 3]); w.z = pack2(acc[8 * s + 4], acc[8 * s + 5]); w.w = pack2(acc[8 * s + 6], acc[8 * s + 7]);
                *(LAS u32x4*)(lds + GL_ATT + ((wid * 2 + s) * 64 + lane) * 16) = w; }
        }
    }
    asm volatile("s_waitcnt vmcnt(0)" ::: "memory");
    u32x2 S8[8];
    { const int r = 16 * ((j >> 2) & 1) + 4 * (j >> 3) + (j & 3);
#pragma unroll
        for (int s = 0; s < 8; ++s) S8[s] = *(const LAS u32x2*)(sb + r * 128 + ((s ^ (r & 7)) << 4) + 8 * g); }
    __syncthreads();
#pragma unroll
    for (int ti = 0; ti < 2; ++ti) {
#pragma unroll
        for (int tj = 0; tj < 2; ++tj) {
            const bool skip = DIR == 0 ? (tj > ti) : (tj < ti);
            if (!skip) {
#pragma unroll
                for (int s = 0; s < 2; ++s) { const bf16x8 Bf = *(const LAS bf16x8*)(lds + GL_ATT + (((tj * 2 + ti) * 2 + s) * 64 + lane) * 16); O[ti] = MFMA32(Vf[tj][s], Bf, O[ti]); }
            }
        }
#pragma unroll
        for (int s = 0; s < 8; ++s) { const bf16x8 Bf = *(const LAS bf16x8*)(lds + GL_QH + gl_swz(32 * ti + j, 2 * s + g));
            float e[8]; unpack4_fp8(S8[s].x, e[0], e[1], e[2], e[3]); unpack4_fp8(S8[s].y, e[4], e[5], e[6], e[7]);
            const u32x4 wb = (u32x4){pack2(e[0], e[1]), pack2(e[2], e[3]), pack2(e[4], e[5]), pack2(e[6], e[7])};
            O[ti] = MFMA32(__builtin_bit_cast(bf16x8, wb), Bf, O[ti]); }
    }
    __syncthreads();
}
DI void phase_gla3(const Params& p, int l, LAS unsigned char* lds) {
    unsigned char* const ws = ws_ptr();
    const int tid = otid(), lane = tid & 63, wid = tid >> 6, j = lane & 31, g = lane >> 5;
    bf16_t* proj = (bf16_t*)(ws + WS_PROJ);
    const bf16_t* vt = (const bf16_t*)(ws + WS_VT);
    const unsigned char* stt = ws + WS_ST;
    LAS float* ssq = (LAS float*)(lds + GL_SSQ);
    const bool last = (l == DEPTH - 1);
    int cur_h = -1, a_for = -1;
    u32x4 a_pre = (u32x4){0u, 0u, 0u, 0u};
    for (int un = blockIdx.x; un < NB * NCH * 4; un += gridDim.x) {
        const int h = un & 3, ci = (un >> 2) % NCH, b = (un >> 2) / NCH;
        if (last && ci >= 256) continue;
        int row0, tok0; gla_chunk_rows(b, ci, row0, tok0);
        const int prow = 16 * ((j >> 2) & 1) + 4 * (j >> 3) + (j & 3);
        if (a_for != un) a_pre = gla_load_a(proj, row0, tid);
        gla_stage_gate(p, l, a_pre, h, lds, cur_h);
        { const int un2 = un + gridDim.x; if (un2 < NB * NCH * 4) { int r0_, t0_; gla_chunk_rows((un2 >> 2) / NCH, (un2 >> 2) % NCH, r0_, t0_); a_pre = gla_load_a(proj, r0_, tid); a_for = un2; } }
        bf16x8 Vf[2][2];
        const int t2 = otid(), vrow = 32 * (t2 >> 6) + 16 * ((t2 >> 2) & 1) + 4 * ((t2 & 31) >> 3) + (t2 & 3), vg8 = 8 * ((t2 >> 5) & 1);
#pragma unroll
        for (int tj = 0; tj < 2; ++tj)
#pragma unroll
            for (int s = 0; s < 2; ++s) Vf[tj][s] = *(const bf16x8*)(vt + ((size_t)b * VTR + 640 + h * 256 + vrow) * TOKB + tok0 + 32 * tj + 16 * s + vg8);
        f32x16 O[2]; O[0] = zero16(); O[1] = zero16();
        u32x4 qk[4];
        { const bf16_t* rp = proj + (size_t)(row0 + (tid >> 3)) * PW + h * 128 + (tid & 7) * 16;
            qk[0] = *(const u32x4*)(rp + C_QC); qk[1] = *(const u32x4*)(rp + C_QC + 8); qk[2] = *(const u32x4*)(rp + C_KC); qk[3] = *(const u32x4*)(rp + C_KC + 8); }
        __syncthreads();
        const size_t chain0 = (size_t)(b * 4 + h) * 2;
        gla3_dir<0>(p, lds, qk, stt + ((chain0 + 0) * NCH + ci) * 32768, Vf, O);
        gla3_dir<1>(p, lds, qk, stt + ((chain0 + 1) * NCH + ci) * 32768, Vf, O);
#pragma unroll
        for (int ti = 0; ti < 2; ++ti) { float s = 0.f;
#pragma unroll
            for (int r = 0; r < 16; ++r) s += O[ti][r] * O[ti][r];
            s += __shfl_xor(s, 32);
            if (g == 0) ssq[(32 * ti + j) * 8 + wid] = s; }
        __syncthreads();
        const float* gn = PIN(I_GNC) + l * 256;
#pragma unroll
        for (int ti = 0; ti < 2; ++ti) {
            float tot = 0.f;
#pragma unroll
            for (int w = 0; w < 8; ++w) tot += ssq[(32 * ti + j) * 8 + w];
            const float rstd = rsqrtf(tot * (1.0f / 256.0f) + EPS);
            bf16_t* rp = proj + (size_t)(row0 + 32 * ti + j) * PW + C_RC + h * 256 + 32 * wid + 16 * g;
            const u32x4 ra = *(const u32x4*)rp, rb = *(const u32x4*)(rp + 8);
            const unsigned rw[8] = {ra.x, ra.y, ra.z, ra.w, rb.x, rb.y, rb.z, rb.w};
            float yv[16];
#pragma unroll
            for (int q = 0; q < 8; ++q) {
                const float r0 = bf_lo(rw[q]), r1 = bf_hi(rw[q]);
                const float g0 = gn[32 * wid + 16 * g + 2 * q], g1 = gn[32 * wid + 16 * g + 2 * q + 1];
                yv[2 * q] = O[ti][2 * q] * rstd * g0 * r0 * sigmoidf_(r0); yv[2 * q + 1] = O[ti][2 * q + 1] * rstd * g1 * r1 * sigmoidf_(r1);
            }
            if (ci < 256) {
                u32x4 w8;
#pragma unroll
                for (int q = 0; q < 4; ++q) w8[q] = pack4_fp8(yv[4 * q] * O8_SCALE, yv[4 * q + 1] * O8_SCALE, yv[4 * q + 2] * O8_SCALE, yv[4 * q + 3] * O8_SCALE);
                *(u32x4*)(ws + WS_O8 + (size_t)(row0 + 32 * ti + j) * 2048 + 1024 + h * 256 + 32 * wid + 16 * g) = w8;
            } else {
                unsigned ow[8];
#pragma unroll
                for (int q = 0; q < 8; ++q) ow[q] = pack2(yv[2 * q], yv[2 * q + 1]);
                *(u32x4*)rp = (u32x4){ow[0], ow[1], ow[2], ow[3]}; *(u32x4*)(rp + 8) = (u32x4){ow[4], ow[5], ow[6], ow[7]}; }
        }
        __syncthreads();
    }
}

#define CE_DESC(a, b) do { const float _hi = fmaxf(a, b), _lo = fminf(a, b); a = _hi; b = _lo; } while (0)
template <int N> DI void sort_desc(float (&v)[N]) {
#pragma unroll
    for (int k = 2; k <= N; k <<= 1)
#pragma unroll
        for (int jj = k >> 1; jj > 0; jj >>= 1)
#pragma unroll
            for (int i = 0; i < N; ++i) { const int x = i ^ jj; if (x > i) { if ((i & k) == 0) CE_DESC(v[i], v[x]); else CE_DESC(v[x], v[i]); } }
}
DI void merge_top16(float (&a)[16], const float (&b)[16]) {
#pragma unroll
    for (int i = 0; i < 16; ++i) a[i] = fmaxf(a[i], b[15 - i]);
#pragma unroll
    for (int jj = 8; jj > 0; jj >>= 1)
#pragma unroll
        for (int i = 0; i < 16; ++i) { const int x = i ^ jj; if (x > i) CE_DESC(a[i], a[x]); }
}
DI void merge_partner16(float (&a)[16]) {
    float b[16];
#pragma unroll
    for (int i = 0; i < 16; ++i) b[i] = __shfl_xor(a[i], 32);
    merge_top16(a, b);
}
DI void top16_of_64(float (&v)[64], float (&o)[16]) {
    float a[16], b[16];
#pragma unroll
    for (int i = 0; i < 16; ++i) { a[i] = v[i]; b[i] = v[16 + i]; }
    sort_desc<16>(a); sort_desc<16>(b); merge_top16(a, b);
#pragma unroll
    for (int i = 0; i < 16; ++i) { o[i] = v[32 + i]; b[i] = v[48 + i]; }
    sort_desc<16>(o); sort_desc<16>(b); merge_top16(o, b);
    merge_top16(o, a);
}
DI float bsel(int c, float a, float b) { const unsigned m = (unsigned)-(c != 0); return __uint_as_float((__float_as_uint(a) & m) | (__float_as_uint(b) & ~m)); }
DI float msel(unsigned long long m, float a, float b) { float r; asm("v_cndmask_b32 %0, %1, %2, %3" : "=v"(r) : "v"(b), "v"(a), "s"(m)); return r; }
DI float set_low(float f, unsigned mask, unsigned val) { return __uint_as_float((__float_as_uint(f) & ~mask) | val); }

DI void phase_peer_select(const Params& p, int l, LAS unsigned char* lds) {
    unsigned char* const ws = ws_ptr();
    const int tid = otid(), lane = tid & 63, wid = tid >> 6, j = lane & 31, g = lane >> 5;
    const bf16_t* pq = (const bf16_t*)(ws + WS_PQ);
    const bf16_t* subk = (const bf16_t*)(ws + WS_SUBK);
    unsigned short* pidx = (unsigned short*)(ws + WS_PIDX); float* pgw = (float*)(ws + WS_PG);
    LAS unsigned* tab = (LAS unsigned*)lds + wid * 2048;
    LAS unsigned char* kimg = lds + 65536;
    const int ngroups = (l == DEPTH - 1 ? NLAT : NROW) / 32, noct = (ngroups + 7) / 8;
    int cur_ph = -1;
    for (int w = blockIdx.x; w < 8 * noct; w += gridDim.x) {
        const int ph = w & 7, grp = (w >> 3) * 8 + wid;
        if (ph != cur_ph) {
            __syncthreads();
#pragma unroll
            for (int k = 0; k < 8; ++k) { const int pc = tid + 512 * k, row = pc >> 4, c = pc & 15;
                *(LAS u32x4*)(kimg + row * 256 + ((c ^ (row & 15)) << 4)) = *(const u32x4*)(subk + (size_t)(ph * 256 + row) * 128 + c * 8); }
            __syncthreads();
            cur_ph = ph;
        }
        if (grp >= ngroups) continue;
        const int r0 = grp * 32;
        float top[2][16];
#pragma unroll
        for (int half = 0; half < 2; ++half) {
            bf16x8 Bq[8]; float ss = 0.f;
            const bf16_t* qp = pq + (size_t)(r0 + j) * 2048 + ph * 256 + half * 128 + 8 * g;
#pragma unroll
            for (int s = 0; s < 8; ++s) { const u32x4 w4 = *(const u32x4*)(qp + 16 * s); Bq[s] = __builtin_bit_cast(bf16x8, w4);
                const float e0 = bf_lo(w4.x), e1 = bf_hi(w4.x), e2 = bf_lo(w4.y), e3 = bf_hi(w4.y), e4 = bf_lo(w4.z), e5 = bf_hi(w4.z), e6 = bf_lo(w4.w), e7 = bf_hi(w4.w);
                ss += e0 * e0 + e1 * e1 + e2 * e2 + e3 * e3 + e4 * e4 + e5 * e5 + e6 * e6 + e7 * e7; }
            ss += __shfl_xor(ss, 32);
            const float rstd = rsqrtf(ss * (1.0f / 128.0f) + EPS);
#pragma unroll
            for (int r = 0; r < 16; ++r) top[half][r] = -INFINITY;
#pragma unroll 1
            for (int kt = 0; kt < 4; ++kt) {
                f32x16 acc = zero16();
#pragma unroll
                for (int s = 0; s < 8; ++s) { const int row = half * 128 + kt * 32 + j; const bf16x8 Af = *(const LAS bf16x8*)(kimg + row * 256 + (((2 * s + g) ^ (row & 15)) << 4)); acc = MFMA32(Af, Bq[s], acc); }
                float sc[16];
#pragma unroll
                for (int r = 0; r < 16; ++r) sc[r] = set_low(acc[r] * rstd, 127u, (unsigned)(32 * kt + (r & 3) + 8 * (r >> 2) + 4 * g));
                sort_desc<16>(sc);
                merge_top16(top[half], sc);
            }
            __builtin_amdgcn_sched_barrier(0);
            merge_partner16(top[half]);
        }
        float va[16], vb[16];
#pragma unroll
        for (int i = 0; i < 16; ++i) { va[i] = set_low(top[0][i], 127u, 0u); vb[i] = set_low(top[1][i], 127u, 0u);
            tab[i * 64 + lane] = __float_as_uint(top[0][i]) & 127u; tab[(16 + i) * 64 + lane] = __float_as_uint(top[1][i]) & 127u; }
        float cand[32];
#pragma unroll
        for (int i = 0; i < 27; ++i) {
            const int a = i < 16 ? 0 : (i < 23 ? 1 : (i < 26 ? 2 : 3));
            const int bb = i < 16 ? i : (i < 23 ? i - 15 : (i < 26 ? i - 21 : 3));
            const float s0 = va[a] + vb[bb], s1 = va[bb] + vb[a];
            float c = g ? s1 : s0;
            c = set_low(c, 255u, g ? (unsigned)(bb * 16 + a) : (unsigned)(a * 16 + bb));
            if (a == bb) c = g ? -INFINITY : c;
            cand[i] = c;
        }
#pragma unroll
        for (int i = 27; i < 32; ++i) cand[i] = -INFINITY;
        float ca[16], cb[16];
#pragma unroll
        for (int i = 0; i < 16; ++i) { ca[i] = cand[i]; cb[i] = cand[16 + i]; }
        sort_desc<16>(ca); sort_desc<16>(cb); merge_top16(ca, cb);
        merge_partner16(ca);
        const float mx = set_low(ca[0], 255u, 0u);
        float ev[16], sum = 0.f;
#pragma unroll
        for (int i = 0; i < 16; ++i) { ev[i] = __expf(set_low(ca[i], 255u, 0u) - mx); sum += ev[i]; }
        const float inv = 1.0f / sum;
        const size_t ob = (size_t)(r0 + j) * 128 + ph * 16 + 8 * g;
#pragma unroll
        for (int k = 0; k < 8; ++k) {
            const float cv = bsel(g, ca[8 + k], ca[k]); const float e = bsel(g, ev[8 + k], ev[k]);
            const unsigned pos = __float_as_uint(cv) & 255u;
            const unsigned i1 = tab[(pos >> 4) * 64 + lane], i2 = tab[(16 + (pos & 15)) * 64 + lane];
            pidx[ob + k] = (unsigned short)(i1 * 128u + i2); pgw[ob + k] = e * inv;
        }
    }
}

constexpr int PEER_CHUNK_ROWS = 64;
#define FP4PAIR(w, b) __builtin_amdgcn_cvt_scalef32_pk_f32_fp4((w), 1.0f, (b))
template <int PHASE_V>
DI void phase_peer_uv(const Params& p, int l, LAS unsigned char* lds, float* xo_lat, float* xo_ctx) {
    unsigned char* const ws = ws_ptr();
    const int tid = otid(), lane = tid & 63, wid = tid >> 6, tsub = lane >> 3, c8 = lane & 7;
    const bf16_t* h2 = (const bf16_t*)(ws + WS_H2);
    const unsigned char* tabl = ws + (PHASE_V ? WS_TV : WS_TU);
    const unsigned short* pidx = (const unsigned short*)(ws + WS_PIDX);
    const float* pgw = (const float*)(ws + WS_PG);
    float* part = (float*)(ws + WS_PART);
    const float* mod = (const float*)(ws + WS_MOD) + (size_t)l * 3 * 6144;
    unsigned* qh = (unsigned*)(ws + WS_CTL) + CW_QUEUE + ((l * 2 + PHASE_V) * 8) * 64;
    LAS unsigned* sh = (LAS unsigned*)lds;
    const int nchunks = (l == DEPTH - 1 ? NLAT : NROW) / PEER_CHUNK_ROWS;
    int s = (int)(xb_xcc_id() & (unsigned)(PSL - 1)), tried = 0, par = 0;
    if (tid == 0) sh[0] = __hip_atomic_fetch_add(&qh[s * 64], 1u, __ATOMIC_RELAXED, __HIP_MEMORY_SCOPE_AGENT);
    __syncthreads();
    unsigned cur = sh[0];
    for (;;) {
        if ((int)cur >= nchunks) {
            s = (s + 1) & (PSL - 1); if (++tried == PSL) break;
            if (tid == 0) sh[par ^ 1] = __hip_atomic_fetch_add(&qh[s * 64], 1u, __ATOMIC_RELAXED, __HIP_MEMORY_SCOPE_AGENT);
            __syncthreads(); cur = sh[par ^ 1]; par ^= 1; continue;
        }
        unsigned nxt = 0u;
        if (tid == 0) nxt = __hip_atomic_fetch_add(&qh[s * 64], 1u, __ATOMIC_RELAXED, __HIP_MEMORY_SCOPE_AGENT);
        const int row = (int)cur * PEER_CHUNK_ROWS + wid * 8 + tsub;
        const unsigned char* tb = tabl + (size_t)s * ((size_t)16384 * 128);
        const unsigned c8o = 16u * (unsigned)c8;
        const unsigned short* ip = pidx + (size_t)row * 128;
        auto ldrows = [&](u32x4 (&r)[16], const u32x4& a, const u32x4& c) {
            const unsigned iw[8] = {a.x, a.y, a.z, a.w, c.x, c.y, c.z, c.w};
#pragma unroll
            for (int k = 0; k < 16; ++k) { const unsigned e = (k & 1) ? (iw[k >> 1] >> 16) : (iw[k >> 1] & 0xffffu); r[k] = *(const u32x4*)(tb + (size_t)((e << 7) | c8o)); } };
        if (!PHASE_V) {
            const bf16_t* hp = h2 + (size_t)row * 1024 + 256 * s + 32 * c8;
            f32x2 hv[16];
#pragma unroll
            for (int q = 0; q < 4; ++q) { const u32x4 hw = *(const u32x4*)(hp + 8 * q);
                hv[4 * q] = (f32x2){bf_lo(hw.x), bf_hi(hw.x)}; hv[4 * q + 1] = (f32x2){bf_lo(hw.y), bf_hi(hw.y)}; hv[4 * q + 2] = (f32x2){bf_lo(hw.z), bf_hi(hw.z)}; hv[4 * q + 3] = (f32x2){bf_lo(hw.w), bf_hi(hw.w)}; }
            float* pp = part + ((size_t)s * NROW + row) * 128 + 2 * c8;
            const unsigned long long m4 = __builtin_amdgcn_ballot_w64((lane & 4) != 0), m2 = __builtin_amdgcn_ballot_w64((lane & 2) != 0), m1 = __builtin_amdgcn_ballot_w64((lane & 1) != 0);
            auto reduce = [&](const u32x4 (&uw)[16], int kb) {
                float d[16];
#pragma unroll
                for (int k = 0; k < 16; ++k) { f32x2 a2 = FP4PAIR(uw[k][0], 0) * hv[0];
                    a2 += FP4PAIR(uw[k][0], 1) * hv[1]; a2 += FP4PAIR(uw[k][0], 2) * hv[2]; a2 += FP4PAIR(uw[k][0], 3) * hv[3];
#pragma unroll
                    for (int q = 1; q < 4; ++q) { a2 += FP4PAIR(uw[k][q], 0) * hv[4 * q]; a2 += FP4PAIR(uw[k][q], 1) * hv[4 * q + 1]; a2 += FP4PAIR(uw[k][q], 2) * hv[4 * q + 2]; a2 += FP4PAIR(uw[k][q], 3) * hv[4 * q + 3]; }
                    d[k] = a2[0] + a2[1]; }
                float t8[8], t4[4], t2[2];
#pragma unroll
                for (int k = 0; k < 8; ++k) { const float keep = msel(m4, d[k + 8], d[k]), send = msel(m4, d[k], d[k + 8]); t8[k] = keep + __shfl_xor(send, 4); }
#pragma unroll
                for (int k = 0; k < 4; ++k) { const float keep = msel(m2, t8[k + 4], t8[k]), send = msel(m2, t8[k], t8[k + 4]); t4[k] = keep + __shfl_xor(send, 2); }
#pragma unroll
                for (int k = 0; k < 2; ++k) { const float keep = msel(m1, t4[k + 2], t4[k]), send = msel(m1, t4[k], t4[k + 2]); t2[k] = keep + __shfl_xor(send, 1); }
                *(f32x2*)(pp + kb * 16) = (f32x2){t2[0], t2[1]}; };
            u32x4 ia0 = *(const u32x4*)ip, ia1 = *(const u32x4*)(ip + 8), ib0 = *(const u32x4*)(ip + 16), ib1 = *(const u32x4*)(ip + 24);
            u32x4 RA[16], RB[16];
            ldrows(RA, ia0, ia1);
#pragma unroll 1
            for (int kb = 0; kb < 8; kb += 2) {
                ldrows(RB, ib0, ib1);
                { const int kn = kb + 2 < 8 ? kb + 2 : 7; ia0 = *(const u32x4*)(ip + kn * 16); ia1 = *(const u32x4*)(ip + kn * 16 + 8); }
                reduce(RA, kb);
                ldrows(RA, ia0, ia1);
                { const int kn = kb + 3 < 8 ? kb + 3 : 7; ib0 = *(const u32x4*)(ip + kn * 16); ib1 = *(const u32x4*)(ip + kn * 16 + 8); }
                reduce(RB, kb + 1);
            }
        } else {
            const float* wp = pgw + (size_t)row * 128;
            f32x2 o2[16];
#pragma unroll
            for (int i = 0; i < 16; ++i) o2[i] = (f32x2){0.f, 0.f};
            auto accum = [&](const u32x4 (&vw)[16], const f32x4 (&wq)[4]) {
#pragma unroll
                for (int k = 0; k < 16; ++k) { const float w = wq[k >> 2][k & 3]; const f32x2 w2 = (f32x2){w, w};
#pragma unroll
                    for (int q = 0; q < 4; ++q) { o2[4 * q] += w2 * FP4PAIR(vw[k][q], 0); o2[4 * q + 1] += w2 * FP4PAIR(vw[k][q], 1); o2[4 * q + 2] += w2 * FP4PAIR(vw[k][q], 2); o2[4 * q + 3] += w2 * FP4PAIR(vw[k][q], 3); } } };
            auto ldw = [&](f32x4 (&wq)[4], int kb) {
#pragma unroll
                for (int q = 0; q < 4; ++q) wq[q] = *(const f32x4*)(wp + kb * 16 + 4 * q); };
            u32x4 ia0 = *(const u32x4*)ip, ia1 = *(const u32x4*)(ip + 8), ib0 = *(const u32x4*)(ip + 16), ib1 = *(const u32x4*)(ip + 24);
            f32x4 wa[4], wb[4]; ldw(wa, 0); ldw(wb, 1);
            u32x4 RA[16], RB[16];
            ldrows(RA, ia0, ia1);
#pragma unroll 1
            for (int kb = 0; kb < 8; kb += 2) {
                ldrows(RB, ib0, ib1);
                { const int kn = kb + 2 < 8 ? kb + 2 : 7; ia0 = *(const u32x4*)(ip + kn * 16); ia1 = *(const u32x4*)(ip + kn * 16 + 8); }
                accum(RA, wa);
                { const int kn = kb + 2 < 8 ? kb + 2 : 7; ldw(wa, kn); }
                ldrows(RA, ia0, ia1);
                { const int kn = kb + 3 < 8 ? kb + 3 : 7; ib0 = *(const u32x4*)(ip + kn * 16); ib1 = *(const u32x4*)(ip + kn * 16 + 8); }
                accum(RB, wb);
                { const int kn = kb + 3 < 8 ? kb + 3 : 7; ldw(wb, kn); }
            }
            if (DBG_ZERO & 8) {
#pragma unroll
                for (int i = 0; i < 16; ++i) o2[i] = (f32x2){0.f, 0.f}; }
            const bool lat = row < NLAT;
            const int mv = lat ? (row >> 14) : 2;
            const float* g2 = mod + mv * 6144 + 5 * 1024 + 256 * s + 32 * c8;
            float* xo = (lat ? xo_lat + (size_t)row * 1024 : xo_ctx + (size_t)(row - NLAT) * 1024) + 256 * s + 32 * c8;
#pragma unroll
            for (int q = 0; q < 8; ++q) { const f32x4 xv = *(const f32x4*)(xo + 4 * q), gv = *(const f32x4*)(g2 + 4 * q);
                f32x4 o; o[0] = xv[0] + gv[0] * o2[2 * q][0]; o[1] = xv[1] + gv[1] * o2[2 * q][1]; o[2] = xv[2] + gv[2] * o2[2 * q + 1][0]; o[3] = xv[3] + gv[3] * o2[2 * q + 1][1];
                *(f32x4*)(xo + 4 * q) = o; }
        }
        if (tid == 0) sh[par ^ 1] = nxt;
        __syncthreads();
        cur = sh[par ^ 1]; par ^= 1;
    }
    __syncthreads();
}
DI void phase_peer_w(const Params& p, int l) {
    unsigned char* const ws = ws_ptr();
    const float* part = (const float*)(ws + WS_PART);
    float* pgw = (float*)(ws + WS_PG);
    const int n = (l == DEPTH - 1 ? NLAT : NROW) * 128;
    for (int i = (blockIdx.x * 512 + otid()) * 4; i < n; i += gridDim.x * 2048) {
        f32x4 sm = *(const f32x4*)(part + i);
#pragma unroll
        for (int x = 1; x < PSL; ++x) sm += *(const f32x4*)(part + (size_t)x * NROW * 128 + i);
        const f32x4 g = *(const f32x4*)(pgw + i);
        f32x4 o;
#pragma unroll
        for (int q = 0; q < 4; ++q) { const float t = sm[q] * (1.0f / PU_SCALE); o[q] = g[q] * 0.5f * t * (1.0f + erff(t * 0.70710678118654752f)) * (1.0f / PV_SCALE); }
        *(f32x4*)(pgw + i) = o;
    }
}

__global__ void __launch_bounds__(512, 2) hybrid_fwd(Params p) {
    LAS unsigned char* const ldsc = (LAS unsigned char*)lds_raw;
    LAS unsigned char* lds = ldsc + LDS_CTRL;
    if (threadIdx.x == 0) { *(LAS u32x4*)(ldsc + LDS_BARW) = (u32x4){0u, 0u, 0u, 0u}; *(LAS unsigned long long*)(ldsc + 512) = 0ull;
        LAS unsigned long long* pt = (LAS unsigned long long*)(ldsc + LDS_PTRS);
#pragma unroll
        for (int i = 0; i < 29; ++i) pt[i] = (unsigned long long)(uintptr_t)p.in[i]; }
    __syncthreads();
    XcdBarrier bar; bar.bar = (unsigned*)(p.ws + WS_CTL); bar.x = 0; bar.st = (volatile LAS unsigned*)(ldsc + LDS_BARW);
    if (p.use_bar) bar = xcd_barrier_post((unsigned*)(p.ws + WS_CTL), (volatile LAS unsigned*)(ldsc + LDS_BARW));
#define IN(ph) ((ph) >= p.gp_lo && (ph) < p.gp_hi)
#define SEAM() do { if (p.use_bar) { XcdBarrier b2; b2.bar = (unsigned*)(ws_ptr() + WS_CTL); b2.x = bar.x; b2.st = (volatile LAS unsigned*)(ldsc + LDS_BARW); xcd_barrier(b2); } else __syncthreads(); } while (0)
    unsigned long long pr_acc = 0, pr_t0 = 0;
#define PT0() do { if (PROBE_MASK) pr_t0 = __builtin_amdgcn_s_memrealtime(); } while (0)
#define PT1(k) do { if (PROBE_MASK & (1 << (k))) pr_acc += __builtin_amdgcn_s_memrealtime() - pr_t0; } while (0)
    if (IN(0)) { PT0(); phase_mod(p, (LAS float*)lds); SEAM(); PT1(15); }
    for (int l = 0; l < DEPTH; ++l) {
        const int gb = 1 + l * NPH;
        unsigned char* const ws = ws_ptr();
        float* const outp = (float*)(GAS float*)p.out;
        bf16_t* const proj = (bf16_t*)(ws + WS_PROJ);
        float* const ctxr = (float*)(ws + WS_CTX);
        const float* xin_lat = l == 0 ? PIN(I_X) : outp;
        const float* xin_ctx = l == 0 ? PIN(I_CTX) : ctxr;
        if (IN(gb + 0)) { PT0(); phase_convert(p, l, (LAS float*)lds); phase_norm(p, l, 0, xin_lat, xin_ctx, (bf16_t*)(ws + WS_H), NROW); SEAM(); PT1(0); }
        if (IN(gb + 1)) { PT0();
            pg8::Gemm g{}; g.A = (const bf16_t*)(ws + WS_H); g.Bt = (const bf16_t*)(ws + WS_WIN); g.lda = 512; g.ldb = 512; g.K = 512; g.bseg = 0;
            pg8::Order<1> so; so.init(NROW, 8704, gridDim.x, blockIdx.x);
            pg8::EpiBf16 e; e.O = proj; e.ldc = PW; e.ncols = PW; e.oscale = 1.0f / (H8_SCALE * WIN8_SCALE);
            pg8::gemm_phase<1>(lds, g, so, e, 1); SEAM(); PT1(1);
        }
        if (IN(gb + 2)) { PT0(); phase_post(p, l, lds); SEAM(); PT1(2); }
        if (IN(gb + 3)) { PT0(); phase_gla1(p, l, lds); __syncthreads(); phase_attn(p, l, lds); SEAM(); PT1(3); }
        if (IN(gb + 5)) { PT0(); phase_gla2(p); SEAM(); PT1(5); }
        if (IN(gb + 6)) { PT0(); phase_gla3(p, l, lds); SEAM(); PT1(6); }
        if (IN(gb + 7)) { PT0();
            pg8::Gemm g{}; g.A = (const bf16_t*)(ws + WS_O8); g.Bt = (const bf16_t*)(ws + WS_WO8); g.lda = 1024; g.ldb = 512; g.K = 256; g.bseg = (size_t)1024 * 512;
            g.ac0 = 0; g.ac1 = 256; g.ac2 = 512; g.ac3 = 0; g.k0 = 256; g.k1 = 256; g.k2 = 512; g.k3 = 0;
            if (l != DEPTH - 1) phase_ctx_gemm(p, l, 0, xin_ctx);
            pg8::Order<3> so; so.init(NLAT, 1024, gridDim.x, blockIdx.x);
            pg8::EpiMerge e; e.proj = proj; e.Mo = (bf16_t*)(ws + WS_M); e.oscale = 1.0f / (O8_SCALE * WO8_SCALE);
            pg8::gemm_phase<1>(lds, g, so, e, 2); SEAM(); PT1(7);
        }
        if (IN(gb + 8)) { PT0();
            pg8::Gemm g{}; g.A = (const bf16_t*)(ws + WS_M); g.Bt = (const bf16_t*)(ws + WS_WOUT); g.lda = 1024; g.ldb = 1024; g.K = 1024; g.bseg = 0;
            if (l != DEPTH - 1) phase_ctx_gemm(p, l, 1, xin_ctx);
            pg8::Order<1> so; so.init(NLAT, 1024, gridDim.x, blockIdx.x);
            pg8::EpiResid e; e.xin_lat = xin_lat; e.xin_ctx = xin_ctx; e.xout_lat = outp; e.xout_ctx = ctxr; e.gate = (const float*)(ws + WS_MOD) + (size_t)l * 3 * 6144 + 2 * 1024;
            pg8::gemm_phase<0>(lds, g, so, e, 3); SEAM(); PT1(8);
        }
        if (IN(gb + 9)) { PT0(); phase_norm(p, l, 1, outp, ctxr, (bf16_t*)(ws + WS_H2), l == DEPTH - 1 ? NLAT : NROW); SEAM(); PT1(9); }
        if (IN(gb + 10)) { PT0();
            pg8::Gemm g{}; g.A = (const bf16_t*)(ws + WS_H2); g.Bt = (const bf16_t*)(ws + WS_WPQ); g.lda = 1024; g.ldb = 1024; g.K = 1024; g.bseg = 0;
            pg8::Order<1> so; so.init(l == DEPTH - 1 ? NLAT : NROW, 2048, gridDim.x, blockIdx.x);
            pg8::EpiBf16 e; e.O = (bf16_t*)(ws + WS_PQ); e.ldc = 2048; e.ncols = 2048; e.oscale = 1.0f;
            pg8::gemm_phase<0>(lds, g, so, e, 4); SEAM(); PT1(10);
        }
        if (IN(gb + 11)) { PT0(); phase_peer_select(p, l, lds); SEAM(); PT1(11); }
        if (IN(gb + 12)) { PT0(); phase_peer_uv<0>(p, l, lds, outp, ctxr); SEAM(); PT1(12); }
        if (IN(gb + 13)) { PT0(); phase_peer_w(p, l); SEAM(); PT1(13); }
        if (IN(gb + 14)) { PT0(); phase_peer_uv<1>(p, l, lds, outp, ctxr); SEAM(); PT1(14); }
    }
    if (RPROBE && blockIdx.x == 0) { __syncthreads(); const unsigned long long acc_t = *(LAS unsigned long long*)(ldsc + 512); const unsigned long long t0 = __builtin_amdgcn_s_memrealtime(); while (__builtin_amdgcn_s_memrealtime() - t0 < acc_t) __builtin_amdgcn_s_sleep(16); }
    if (PROBE_MASK && blockIdx.x == 0) { const unsigned long long t0 = __builtin_amdgcn_s_memrealtime(); while (__builtin_amdgcn_s_memrealtime() - t0 < pr_acc * PROBE_MULT) __builtin_amdgcn_s_sleep(16); }
#undef IN
#undef SEAM
}

#ifndef MK_LAUNCHES
#define MK_LAUNCHES 0
#endif
extern "C" void kernel_launch(void* const* d_in, const int* in_sizes, int n_in, void* d_out, int out_size, void* d_ws, size_t ws_size, hipStream_t stream) {
    static int grid = 0;
    if (grid == 0) {
        if (n_in != 29 || in_sizes[0] != NLAT * D || out_size != NLAT * D || ws_size < WS_END) {
            fprintf(stderr, "kernel_launch: unexpected problem (n_in %d, in0 %d, out %d, ws %zu, need %zu); nothing launched\n", n_in, n_in > 0 ? in_sizes[0] : -1, out_size, ws_size, (size_t)WS_END); grid = -1; return; }
        int dev = 0, cus = 0, per_cu = 0;
        if (hipGetDevice(&dev) != hipSuccess || hipDeviceGetAttribute(&cus, hipDeviceAttributeMultiprocessorCount, dev) != hipSuccess) { grid = -1; return; }
        if (hipFuncSetAttribute((const void*)hybrid_fwd, hipFuncAttributeMaxDynamicSharedMemorySize, LDS_BYTES) != hipSuccess) { fprintf(stderr, "kernel_launch: hipFuncSetAttribute failed\n"); grid = -1; return; }
        if (hipOccupancyMaxActiveBlocksPerMultiprocessor(&per_cu, (const void*)hybrid_fwd, 512, LDS_BYTES) != hipSuccess || per_cu < 1) { fprintf(stderr, "kernel_launch: occupancy query says %d\n", per_cu); grid = -1; return; }
        (void)hipGetLastError();
        grid = cus;
    }
    if (grid < 0) return;
    (void)hipMemsetAsync((char*)d_ws + WS_CTL, 0, 65536, stream);
    Params p{};
    for (int i = 0; i < 29; ++i) p.in[i] = (const float*)d_in[i];
    p.out = (float*)d_out; p.ws = (unsigned char*)d_ws; p.pad0 = 0;
#if MK_LAUNCHES == 0
    p.gp_lo = 0; p.gp_hi = NGPH; p.use_bar = 1;
    hipLaunchKernelGGL(hybrid_fwd, dim3(grid), dim3(512), LDS_BYTES, stream, p);
#else
    p.use_bar = 0;
    for (int gp = 0; gp < NGPH; ++gp) { p.gp_lo = gp; p.gp_hi = gp + 1; hipLaunchKernelGGL(hybrid_fwd, dim3(grid), dim3(512), LDS_BYTES, stream, p); }
#endif
}
```

```cpp
#include <hip/hip_runtime.h>
#include <stdint.h>
#include <stdio.h>

#define DBG_ZERO 0
#define PROBE_MASK 0
#define PROBE_MULT 1
#define RPROBE 0
#define LAS __attribute__((address_space(3)))
#define DI __device__ __forceinline__
#define GAS __attribute__((address_space(1)))
typedef unsigned short bf16_t;
typedef short bf16x8 __attribute__((ext_vector_type(8)));
typedef float f32x4 __attribute__((ext_vector_type(4)));
typedef float f32x16 __attribute__((ext_vector_type(16)));
typedef unsigned u32x4 __attribute__((ext_vector_type(4)));
typedef unsigned u32x2 __attribute__((ext_vector_type(2)));

constexpr int D = 1024, NB = 2, S = 16384, LC = 256, DEPTH = 4;
constexpr int NLAT = NB * S;
constexpr int NROW = NLAT + NB * LC;
constexpr int PW = 8480;
constexpr int C_KA = 0, C_VA = 128, C_KB = 256, C_VB = 768, C_KC = 1280, C_VC = 1792, C_AC = 2816, C_QA = 2848, C_QB = 3360, C_QC = 3872, C_RC = 4384, C_GT = 5408;
constexpr int TOKB = S + LC;
constexpr int VTR = 1664;
constexpr int NCH = 260;
constexpr float EPS = 1e-6f;
constexpr float LOG2E = 1.4426950408889634f;
constexpr float O8_SCALE = 8.0f, WO8_SCALE = 64.0f;
constexpr float H8_SCALE = 8.0f, WIN8_SCALE = 64.0f;
constexpr int NPH = 15;
constexpr int NGPH = 1 + DEPTH * NPH;

constexpr size_t WS_CTL = 0;
constexpr size_t WS_MOD = 65536;
constexpr size_t WS_CTX = WS_MOD + 512 * 1024;
constexpr size_t WS_WIN = WS_CTX + 2 * 1024 * 1024;
constexpr size_t WS_WO = WS_WIN + (size_t)8704 * 1024 * 2;
constexpr size_t WS_WOUT = WS_WO + (size_t)3 * 1024 * 1024 * 2;
constexpr size_t WS_WPQ = WS_WOUT + (size_t)1024 * 1024 * 2;
constexpr size_t WS_SUBK = WS_WPQ + (size_t)2048 * 1024 * 2;
constexpr size_t WS_PU = WS_SUBK + 512 * 1024;
constexpr size_t WS_PV = WS_PU + (size_t)16384 * 1024 * 2;
constexpr size_t WS_PROJ = WS_PV + (size_t)16384 * 1024 * 2;
constexpr size_t WS_VT = WS_PROJ + (size_t)NROW * PW * 2;
constexpr size_t WS_DEC = WS_VT + (size_t)NB * VTR * TOKB * 2;
constexpr size_t WS_ST = WS_DEC + (size_t)16 * NCH * 128 * 4;
constexpr size_t WS_TU = WS_ST + (size_t)16 * NCH * 32768 * 2;
constexpr size_t WS_TV = WS_TU + (size_t)8 * 1024 * 1024;
constexpr size_t WS_WO8 = WS_TV + (size_t)8 * 1024 * 1024;
constexpr size_t WS_END = WS_WO8 + (size_t)3 * 1024 * 1024;
constexpr size_t WS_O8 = WS_PU;
constexpr size_t WS_H = WS_ST;
constexpr size_t WS_M = WS_ST + (size_t)NROW * 2048 * 2;
constexpr size_t WS_H2 = WS_VT;
constexpr size_t WS_PQ = WS_ST;
constexpr size_t WS_PART = WS_ST;
constexpr int CW_QUEUE = 4096;
constexpr size_t WS_PIDX = WS_PROJ;
constexpr size_t WS_PG = WS_PROJ + (size_t)NROW * 128 * 4;
constexpr size_t WS_H2F8 = WS_PROJ + (size_t)64 * 1024 * 1024;
constexpr float H2F8_SCALE = 8.0f;
static_assert(WS_M + (size_t)NROW * 1024 * 2 <= WS_END && (size_t)NROW * 1024 * 2 <= (size_t)NB * VTR * TOKB * 2 && WS_END <= ((size_t)1 << 30), "workspace map");

constexpr int LDS_CTRL = 1024;
constexpr int LDS_BYTES = 163840;
constexpr int LDS_BARW = 0;

DI float bf_lo(unsigned w) { return __uint_as_float(w << 16); }
DI float bf_hi(unsigned w) { return __uint_as_float(w & 0xffff0000u); }
DI float bf2f(bf16_t b) { return __uint_as_float((unsigned)b << 16); }
typedef __bf16 bf16v2 __attribute__((ext_vector_type(2)));
DI unsigned pack2(float lo, float hi) { bf16v2 v; v.x = (__bf16)lo; v.y = (__bf16)hi; return __builtin_bit_cast(unsigned, v); }
DI void unpack4_fp8(unsigned w, float& a, float& b, float& c, float& d) { const auto lo = __builtin_amdgcn_cvt_pk_f32_fp8((int)w, false), hi = __builtin_amdgcn_cvt_pk_f32_fp8((int)w, true); a = lo[0]; b = lo[1]; c = hi[0]; d = hi[1]; }
DI unsigned pack4_fp8(float a, float b, float c, float d) { int r = 0; r = __builtin_amdgcn_cvt_pk_fp8_f32(a, b, r, false); r = __builtin_amdgcn_cvt_pk_fp8_f32(c, d, r, true); return (unsigned)r; }
DI bf16_t f2bf(float f) { return (bf16_t)(pack2(f, 0.f) & 0xffffu); }
DI float wave_sum(float v) {
#pragma unroll
    for (int o = 32; o > 0; o >>= 1) v += __shfl_xor(v, o);
    return v;
}
DI int otid() { int t = threadIdx.x; asm volatile("" : "+v"(t)); return t; }
template <class T> DI T* opq(T* ptr) { const unsigned slo = (unsigned)(uintptr_t)ptr, shi = (unsigned)((uintptr_t)ptr >> 32); unsigned lo, hi;
    asm volatile("v_mov_b32 %0, %2\n\tv_mov_b32 %1, %3" : "=v"(lo), "=v"(hi) : "s"(slo), "s"(shi));
    lo = (unsigned)__builtin_amdgcn_readfirstlane((int)lo); hi = (unsigned)__builtin_amdgcn_readfirstlane((int)hi); return (T*)(GAS T*)(((uintptr_t)hi << 32) | (uintptr_t)lo); }
DI float sigmoidf_(float x) { return __builtin_amdgcn_rcpf(1.0f + __builtin_amdgcn_exp2f(x * -LOG2E)); }
DI f32x16 zero16() { f32x16 z; for (int i = 0; i < 16; ++i) z[i] = 0.f; return z; }
#define MFMA32(a, b, c) __builtin_amdgcn_mfma_f32_32x32x16_bf16((a), (b), (c), 0, 0, 0)
DI int pi32(int i) { return (i & 0x13) | ((i & 8) >> 1) | ((i & 4) << 1); }

#define XB_TMO      128
#define XB_XCNT(j)  (256  + 64 * (j))
#define XB_XSUB(j)  (1280 + 64 * (j))
#define XB_XGEN(j)  (2304 + 64 * (j))
#define XB_TOP      3328
#define XB_TOPGEN   3392
#define XCD_BAR_WORDS 3456
#define XB_SPIN_CAP (1u << 22)
DI unsigned xb_ld(unsigned* p)              { return __hip_atomic_load(p, __ATOMIC_RELAXED, __HIP_MEMORY_SCOPE_AGENT); }
DI unsigned xb_add(unsigned* p, unsigned v) { return __hip_atomic_fetch_add(p, v, __ATOMIC_RELAXED, __HIP_MEMORY_SCOPE_AGENT); }
DI unsigned xb_xcc_id() { return (unsigned)__builtin_amdgcn_s_getreg((3 << 11) | 20) & 0xFu; }
#define XB_SPIN(cond, bar) do { unsigned _sp = 0; while (cond) { __builtin_amdgcn_s_sleep(1); \
    if ((++_sp & 255u) == 0u) { if (xb_ld(&(bar)[XB_TMO])) break; if (_sp > XB_SPIN_CAP) { atomicAdd(&(bar)[XB_TMO], 1u); break; } } } } while (0)
struct XcdBarrier { unsigned* bar; unsigned x; volatile LAS unsigned* st; };
DI XcdBarrier xcd_barrier_post(unsigned* bar, volatile LAS unsigned* st) {
    XcdBarrier b; b.bar = bar; b.x = xb_xcc_id(); b.st = st;
    if (threadIdx.x == 0) (void)xb_add(&bar[XB_XCNT(b.x)], 1u);
    return b;
}
DI void xcd_barrier_complete(unsigned* bar, unsigned x, unsigned& nloc, unsigned& nx) {
    const unsigned G = gridDim.x * gridDim.y * gridDim.z;
    unsigned sum, cnt, mine, sp = 0u;
    for (;;) {
        sum = 0u; cnt = 0u; mine = 0u;
#pragma unroll
        for (unsigned j = 0; j < 16; ++j) { const unsigned c = xb_ld(&bar[XB_XCNT(j)]); sum += c; cnt += (c > 0u) ? 1u : 0u; mine = (j == x) ? c : mine; }
        if (sum == G) break;
        __builtin_amdgcn_s_sleep(1);
        if ((++sp & 255u) == 0u) { if (xb_ld(&bar[XB_TMO])) break; if (sp > XB_SPIN_CAP) { atomicAdd(&bar[XB_TMO], 1u); break; } }
    }
    nloc = mine > 0u ? mine : 1u; nx = cnt > 0u ? cnt : 1u;
}
DI void xcd_barrier(const XcdBarrier& b) {
    asm volatile("s_waitcnt vmcnt(0)" ::: "memory");
    __syncthreads();
    if (threadIdx.x == 0) {
        unsigned* bar = b.bar;
        __builtin_amdgcn_s_waitcnt(0);
        unsigned nloc = b.st[0], nx = b.st[1];
        if (nloc == 0u) { xcd_barrier_complete(bar, b.x, nloc, nx); b.st[0] = nloc; b.st[1] = nx; }
        const unsigned old = xb_add(&bar[XB_XSUB(b.x)], 1u);
        const unsigned gen = old / nloc;
        if (old + 1u == (gen + 1u) * nloc) {
            __builtin_amdgcn_fence(__ATOMIC_RELEASE, "agent");
            asm volatile("s_waitcnt vmcnt(0)" ::: "memory");
            const unsigned og = xb_add(&bar[XB_TOP], 1u);
            const unsigned tg = og / nx;
            if (og + 1u == (tg + 1u) * nx) xb_add(&bar[XB_TOPGEN], 1u);
            else XB_SPIN(xb_ld(&bar[XB_TOPGEN]) == tg, bar);
            __builtin_amdgcn_fence(__ATOMIC_ACQUIRE, "agent");
            xb_add(&bar[XB_XGEN(b.x)], 1u);
            asm volatile("s_waitcnt vmcnt(0)" ::: "memory");
        } else {
            XB_SPIN(xb_ld(&bar[XB_XGEN(b.x)]) == gen, bar);
            __builtin_amdgcn_fence(__ATOMIC_ACQUIRE, "agent");
            asm volatile("s_waitcnt vmcnt(0)" ::: "memory");
        }
    }
    __syncthreads();
}

struct Params {
    const float* in[29];
    float* out;
    unsigned char* ws;
    int gp_lo, gp_hi;
    int use_bar, pad0;
};
extern __shared__ __attribute__((aligned(16))) unsigned char lds_raw[];
constexpr int LDS_PTRS = LDS_BARW + 64;
DI const float* pin_ld(int i) { const LAS unsigned* t = (const LAS unsigned*)((LAS unsigned char*)lds_raw + LDS_PTRS) + 2 * i;
    const unsigned lo = (unsigned)__builtin_amdgcn_readfirstlane((int)t[0]), hi = (unsigned)__builtin_amdgcn_readfirstlane((int)t[1]); return (const float*)(GAS const float*)(((uintptr_t)hi << 32) | (uintptr_t)lo); }
#define PIN(i) pin_ld(i)
DI unsigned long long rp_now() { return RPROBE ? __builtin_amdgcn_s_memrealtime() : 0ull; }
DI void rp_add(int id, unsigned long long t0) { if (RPROBE != 0 && RPROBE == id && threadIdx.x == 0) { LAS unsigned long long* a = (LAS unsigned long long*)((LAS unsigned char*)lds_raw + 512); *a += __builtin_amdgcn_s_memrealtime() - t0; } }
DI unsigned char* ws_ptr() {
    typedef __attribute__((address_space(4))) const unsigned char* kptr;
    kptr ka = (kptr)__builtin_amdgcn_kernarg_segment_ptr();
    unsigned off = (unsigned)__builtin_offsetof(Params, ws); asm volatile("" : "+s"(off));
    const unsigned long long v = *(__attribute__((address_space(4))) const unsigned long long*)(ka + off);
    return (unsigned char*)(GAS unsigned char*)v; }
enum { I_X = 0, I_C, I_CTX, I_CCTX, I_WMOD, I_BMOD, I_NORM1, I_NORM2, I_WIN, I_QNA, I_KNA, I_SINKA, I_QNB, I_KNB, I_RPB, I_WA2F, I_BAF, I_WA2B, I_BAB, I_GNC, I_WOA, I_WOB, I_WOC, I_WOUT, I_WPQ, I_PQG, I_SUBK, I_PU, I_PV };

namespace pg8 {
constexpr int BM = 256, BK = 64, HALF = 128, HTB = HALF * BK * 2, STAGE_BYTES = 8 * HTB, NXCD = 8, WGM = 8;
DI int lds_byte(int r, int c) { const int st = (r >> 4) * 2 + (c >> 5), rr = r & 15, cc = c & 31, ob = rr * 64 + cc * 2; return st * 1024 + (ob ^ (((ob >> 9) & 1) << 5)); }
DI void stage_rc(int b, int& R, int& C) { const int st = b / 1024, sb = b % 1024, swz = sb ^ (((sb >> 9) & 1) << 5); R = (st >> 1) * 16 + swz / 64; C = (st & 1) * 32 + (swz % 64) / 2; }
DI int perm32(int rho) { const int n = rho >> 4, i = rho & 15; return 8 * (i >> 2) + 4 * n + (i & 3); }
struct Unit { int pm, pn, seg; };
struct Gemm { const bf16_t* A; const bf16_t* Bt; int lda, ldb, K; int ac0, ac1, ac2, ac3; int k0, k1, k2, k3; size_t bseg; };
DI int gemm_kseg(const Gemm& g, int seg) { const int k = seg == 0 ? g.k0 : (seg == 1 ? g.k1 : (seg == 2 ? g.k2 : g.k3)); return k ? k : g.K; }
DI int gemm_acol(const Gemm& g, int seg) { return seg == 0 ? g.ac0 : (seg == 1 ? g.ac1 : (seg == 2 ? g.ac2 : g.ac3)); }
template <int NSEG> struct Order {
    int nM, nN, nwg, G, c;
    DI void init(int M, int N, int G_, int c_) { nM = M / BM; nN = N / BM; nwg = nM * nN; G = G_; c = c_; }
    DI bool next(int i, Unit& u) const {
        const int t = i / NSEG; u.seg = i - t * NSEG;
        const long L = (long)t * G + c; if (L >= nwg) return false;
        int wgid = (int)L; { const int q = nwg / NXCD, r = nwg % NXCD, xcd = wgid % NXCD, off = wgid / NXCD; wgid = (xcd < r ? xcd * (q + 1) : r * (q + 1) + (xcd - r) * q) + off; }
        const int nig = WGM * nN, gid = wgid / nig, fm = gid * WGM, gsz = (nM - fm) < WGM ? (nM - fm) : WGM;
        u.pm = fm + ((wgid % nig) % gsz); u.pn = (wgid % nig) / gsz; return true;
    }
};
DI unsigned cvt_pk_bf16(float lo, float hi) { unsigned r; asm volatile("v_cvt_pk_bf16_f32 %0, %1, %2" : "=v"(r) : "v"(lo), "v"(hi)); return r; }

template <int FP8, class Epi, class Sched>
DI void gemm_phase(LAS unsigned char* lds, const Gemm g, const Sched& S, const Epi& E, int rpid) {
    const int tid = otid(), wid = __builtin_amdgcn_readfirstlane(tid >> 6), lane = tid & 63, wr = wid >> 2, wc = wid & 3, fr = lane & 15, fq = lane >> 4;
    unsigned voffA[2], voffB[2];
#pragma unroll
    for (int i = 0; i < 2; ++i) { int R, C; stage_rc(tid * 16 + i * 8192, R, C); const int Rb = Epi::PERM ? ((R & ~31) + perm32(R & 31)) : R;
        voffA[i] = (unsigned)(R * g.lda + C) * 2u; voffB[i] = (unsigned)(Rb * g.ldb + C) * 2u; }
    const size_t kstep = (size_t)(BK * 2);
    const size_t hstepA = (size_t)HALF * g.lda * 2, hstepB = (size_t)HALF * g.ldb * 2;
    const unsigned ldsw = (unsigned)wid * 1024u;
    const int aoff = lds_byte(wr * 64 + fr, fq * 8), boff = lds_byte(wc * 32 + fr, fq * 8);
#define PG8_SA(b, h) (((b) * 2 + (h)) * HTB)
#define PG8_SB(b, h) ((4 + (b) * 2 + (h)) * HTB)
#define PG8_STAGE(bufoff, gbase, voff) do { _Pragma("unroll") for (int _i = 0; _i < 2; ++_i) \
        __builtin_amdgcn_global_load_lds((const unsigned*)((const char*)(gbase) + (voff)[_i]), (LAS unsigned*)(lds + (bufoff) + ldsw + _i * 8192), 16, 0, 0); } while (0)
#define PG8_FRAG(off) (*(const LAS bf16x8*)(lds + (off)))
#define PG8_LDA(dst, b, h) do { _Pragma("unroll") for (int m = 0; m < 4; ++m) { if (FP8) dst##8[m] = __builtin_shufflevector(__builtin_bit_cast(i32x4_, PG8_FRAG(PG8_SA(b, h) + aoff + m * 2048)), __builtin_bit_cast(i32x4_, PG8_FRAG(PG8_SA(b, h) + aoff + m * 2048 + 1024)), 0, 1, 2, 3, 4, 5, 6, 7); \
        else { _Pragma("unroll") for (int k = 0; k < 2; ++k) dst[m][k] = PG8_FRAG(PG8_SA(b, h) + aoff + m * 2048 + k * 1024); } } } while (0)
#define PG8_LDB(dst, b, h) do { _Pragma("unroll") for (int n = 0; n < 2; ++n) { if (FP8) dst##8[n] = __builtin_shufflevector(__builtin_bit_cast(i32x4_, PG8_FRAG(PG8_SB(b, h) + boff + n * 2048)), __builtin_bit_cast(i32x4_, PG8_FRAG(PG8_SB(b, h) + boff + n * 2048 + 1024)), 0, 1, 2, 3, 4, 5, 6, 7); \
        else { _Pragma("unroll") for (int k = 0; k < 2; ++k) dst[n][k] = PG8_FRAG(PG8_SB(b, h) + boff + n * 2048 + k * 1024); } } } while (0)
#define PG8_MMA(ai, bj, At, Bt) do { __builtin_amdgcn_s_setprio(1); _Pragma("unroll") for (int m = 0; m < 4; ++m) _Pragma("unroll") for (int n = 0; n < 2; ++n) { \
        if (FP8) asm volatile("v_mfma_scale_f32_16x16x128_f8f6f4 %0, %1, %2, %0, %3, %3 op_sel_hi:[0,0,0]" : "+v"(acc[ai][bj][m][n]) : "v"(Bt##8[n]), "v"(At##8[m]), "v"(sc127));   \
        else { _Pragma("unroll") for (int k = 0; k < 2; ++k) acc[ai][bj][m][n] = __builtin_amdgcn_mfma_f32_16x16x32_bf16(Bt[n][k], At[m][k], acc[ai][bj][m][n], 0, 0, 0); } } \
        __builtin_amdgcn_s_setprio(0); } while (0)
#define PG8_WAIT_V(n) asm volatile("s_waitcnt vmcnt(" #n ")" ::: "memory")
#define PG8_WAIT_L(n) asm volatile("s_waitcnt lgkmcnt(" #n ")" ::: "memory")
#define PG8_BAR __builtin_amdgcn_s_barrier()
#define PG8_SCHED __builtin_amdgcn_sched_barrier(0)
#define PG8_APTR(u) ((const char*)g.A + ((size_t)(u).pm * BM * g.lda + (size_t)gemm_acol(g, (u).seg)) * 2)
#define PG8_BPTR(u) ((const char*)g.Bt + ((size_t)(u).seg * g.bseg + (size_t)(u).pn * BM * g.ldb) * 2)
    Unit cur, nxt; int ui = 0;
    if (!S.next(0, cur)) return;
    f32x4 acc[2][2][4][2];
#pragma unroll
    for (int a = 0; a < 2; ++a)
#pragma unroll
        for (int b = 0; b < 2; ++b)
#pragma unroll
            for (int m = 0; m < 4; ++m)
#pragma unroll
                for (int n = 0; n < 2; ++n) acc[a][b][m][n] = (f32x4){0.f, 0.f, 0.f, 0.f};
    typedef int i32x4_ __attribute__((ext_vector_type(4))); typedef int i32x8_ __attribute__((ext_vector_type(8)));
    bf16x8 At[4][2], B0[2][2], B1[2][2];
    i32x8_ At8[4], B08[2], B18[2];
    int sc127 = 127; asm volatile("" : "+v"(sc127));
    const char* cA = PG8_APTR(cur); const char* cB = PG8_BPTR(cur);
    PG8_STAGE(PG8_SB(0, 0), cB, voffB); PG8_STAGE(PG8_SA(0, 0), cA, voffA); PG8_STAGE(PG8_SB(0, 1), cB + hstepB, voffB); PG8_STAGE(PG8_SA(0, 1), cA + hstepA, voffA);
    if (wr == 1) PG8_BAR;
    PG8_WAIT_V(4); PG8_BAR;
    PG8_STAGE(PG8_SB(1, 0), cB + kstep, voffB); PG8_STAGE(PG8_SA(1, 0), cA + kstep, voffA); PG8_STAGE(PG8_SB(1, 1), cB + hstepB + kstep, voffB);
    PG8_WAIT_V(6); PG8_BAR;
    for (;;) {
        const bool has_next = S.next(ui + 1, nxt);
        const int nt = gemm_kseg(g, cur.seg) / BK;
        const char* nA = has_next ? PG8_APTR(nxt) : cA; const char* nB = has_next ? PG8_BPTR(nxt) : cB;
        for (int t = 0; t < nt; t += 2) {
            const bool last = (t == nt - 2);
            const char* a1 = cA + (size_t)(t + 1) * kstep;
            const char* a2 = last ? nA : cA + (size_t)(t + 2) * kstep; const char* b2 = last ? nB : cB + (size_t)(t + 2) * kstep;
            const char* a3 = a2 + kstep; const char* b3 = b2 + kstep;
            PG8_LDB(B0, 0, 0); PG8_SCHED; PG8_LDA(At, 0, 0); PG8_STAGE(PG8_SA(1, 1), a1 + hstepA, voffA);
            PG8_WAIT_L(8); PG8_BAR; PG8_WAIT_L(0); PG8_MMA(0, 0, At, B0); PG8_BAR; PG8_SCHED;
            PG8_LDB(B1, 0, 1); PG8_STAGE(PG8_SB(0, 0), b2, voffB);
            PG8_BAR; PG8_WAIT_L(0); PG8_MMA(0, 1, At, B1); PG8_BAR;
            PG8_LDA(At, 0, 1); PG8_STAGE(PG8_SA(0, 0), a2, voffA);
            PG8_BAR; PG8_WAIT_L(0); PG8_MMA(1, 0, At, B0); PG8_BAR; PG8_SCHED;
            PG8_STAGE(PG8_SB(0, 1), b2 + hstepB, voffB);
            PG8_WAIT_V(6); PG8_BAR; PG8_MMA(1, 1, At, B1); PG8_BAR;
            PG8_LDB(B0, 1, 0); PG8_SCHED; PG8_LDA(At, 1, 0); PG8_STAGE(PG8_SA(0, 1), a2 + hstepA, voffA);
            PG8_WAIT_L(8); PG8_BAR; PG8_WAIT_L(0); PG8_MMA(0, 0, At, B0); PG8_BAR; PG8_SCHED;
            PG8_LDB(B1, 1, 1); PG8_STAGE(PG8_SB(1, 0), b3, voffB);
            PG8_BAR; PG8_WAIT_L(0); PG8_MMA(0, 1, At, B1); PG8_BAR;
            PG8_LDA(At, 1, 1); PG8_STAGE(PG8_SA(1, 0), a3, voffA);
            PG8_BAR; PG8_WAIT_L(0); PG8_MMA(1, 0, At, B0); PG8_BAR; PG8_SCHED;
            PG8_STAGE(PG8_SB(1, 1), b3 + hstepB, voffB);
            PG8_WAIT_V(6); PG8_BAR; PG8_MMA(1, 1, At, B1); PG8_BAR;
        }
        if (FP8) asm volatile("s_nop 15\n\ts_nop 15" ::: "memory");
        { const unsigned long long rt = rp_now(); E(acc, cur, wr, wc, fr, fq); if (RPROBE) asm volatile("s_waitcnt vmcnt(0)" ::: "memory"); rp_add(rpid, rt); }
        if (!has_next) break;
#pragma unroll
        for (int a = 0; a < 2; ++a)
#pragma unroll
            for (int b = 0; b < 2; ++b)
#pragma unroll
                for (int m = 0; m < 4; ++m)
#pragma unroll
                    for (int n = 0; n < 2; ++n) acc[a][b][m][n] = (f32x4){0.f, 0.f, 0.f, 0.f};
        cur = nxt; cA = nA; cB = nB; ++ui;
    }
    PG8_WAIT_V(0);
    if (wr == 0) PG8_BAR;
    PG8_BAR;
#undef PG8_SA
#undef PG8_SB
#undef PG8_STAGE
#undef PG8_FRAG
#undef PG8_LDA
#undef PG8_LDB
#undef PG8_MMA
#undef PG8_WAIT_V
#undef PG8_WAIT_L
#undef PG8_BAR
#undef PG8_SCHED
#undef PG8_APTR
#undef PG8_BPTR
}

struct EpiBf16 {
    static constexpr bool PERM = true;
    bf16_t* O; int ldc, ncols; float oscale;
    DI void operator()(const f32x4 (&acc)[2][2][4][2], const Unit& u, int wr, int wc, int fr, int fq) const {
        const int row0 = u.pm * BM + wr * 64 + fr, col0 = u.pn * BM + wc * 32 + 8 * fq;
#pragma unroll
        for (int ai = 0; ai < 2; ++ai)
#pragma unroll
            for (int m = 0; m < 4; ++m) { bf16_t* rowp = O + (size_t)(row0 + ai * HALF + m * 16) * ldc + col0;
#pragma unroll
                for (int bj = 0; bj < 2; ++bj) { const f32x4 v0 = acc[ai][bj][m][0] * oscale, v1 = acc[ai][bj][m][1] * oscale;
                    u32x4 w; w.x = cvt_pk_bf16(v0[0], v0[1]); w.y = cvt_pk_bf16(v0[2], v0[3]); w.z = cvt_pk_bf16(v1[0], v1[1]); w.w = cvt_pk_bf16(v1[2], v1[3]);
                    if (col0 + bj * HALF < ncols) *(u32x4*)(rowp + bj * HALF) = w; } }
    }
};
struct EpiMerge {
    static constexpr bool PERM = true;
    const bf16_t* proj; bf16_t* Mo; float oscale;
    DI void operator()(const f32x4 (&acc)[2][2][4][2], const Unit& u, int wr, int wc, int fr, int fq) const {
        const int row0 = u.pm * BM + wr * 64 + fr, col0 = u.pn * BM + wc * 32 + 8 * fq;
        const int gsel = u.seg;
        const bf16_t* gbase = proj + (size_t)row0 * PW + C_GT + gsel * 1024 + col0;
        bf16_t* mbase = Mo + (size_t)row0 * 1024 + col0;
#pragma unroll
        for (int ai = 0; ai < 2; ++ai) {
            u32x4 gw[4][2], pw[4][2];
#pragma unroll
            for (int m = 0; m < 4; ++m)
#pragma unroll
                for (int bj = 0; bj < 2; ++bj) {
                    gw[m][bj] = *(const u32x4*)(gbase + (size_t)(ai * HALF + m * 16) * PW + bj * HALF);
                    pw[m][bj] = u.seg > 0 ? *(const u32x4*)(mbase + (size_t)(ai * HALF + m * 16) * 1024 + bj * HALF) : (u32x4){0u, 0u, 0u, 0u};
                }
#pragma unroll
            for (int m = 0; m < 4; ++m)
#pragma unroll
                for (int bj = 0; bj < 2; ++bj) {
                    const u32x4 g4 = gw[m][bj], p4 = pw[m][bj];
                    f32x4 v0 = acc[ai][bj][m][0] * oscale, v1 = acc[ai][bj][m][1] * oscale;
                    v0[0] *= sigmoidf_(bf_lo(g4.x)); v0[1] *= sigmoidf_(bf_hi(g4.x)); v0[2] *= sigmoidf_(bf_lo(g4.y)); v0[3] *= sigmoidf_(bf_hi(g4.y));
                    v1[0] *= sigmoidf_(bf_lo(g4.z)); v1[1] *= sigmoidf_(bf_hi(g4.z)); v1[2] *= sigmoidf_(bf_lo(g4.w)); v1[3] *= sigmoidf_(bf_hi(g4.w));
                    if (DBG_ZERO & (1 << gsel)) { v0 *= 0.f; v1 *= 0.f; }
                    v0[0] += bf_lo(p4.x); v0[1] += bf_hi(p4.x); v0[2] += bf_lo(p4.y); v0[3] += bf_hi(p4.y); v1[0] += bf_lo(p4.z); v1[1] += bf_hi(p4.z); v1[2] += bf_lo(p4.w); v1[3] += bf_hi(p4.w);
                    u32x4 w; w.x = cvt_pk_bf16(v0[0], v0[1]); w.y = cvt_pk_bf16(v0[2], v0[3]); w.z = cvt_pk_bf16(v1[0], v1[1]); w.w = cvt_pk_bf16(v1[2], v1[3]);
                    *(u32x4*)(mbase + (size_t)(ai * HALF + m * 16) * 1024 + bj * HALF) = w;
                }
        }
    }
};
struct EpiResid {
    static constexpr bool PERM = false;
    const float* xin_lat; const float* xin_ctx; float* xout_lat; float* xout_ctx; const float* gate;
    DI void operator()(const f32x4 (&acc)[2][2][4][2], const Unit& u, int wr, int wc, int fr, int fq) const {
        const int rowt = u.pm * BM;
        const bool lat = rowt < NLAT;
        const int mv = lat ? (rowt >> 14) : 2;
        const float* xin = lat ? xin_lat + (size_t)rowt * 1024 : xin_ctx + (size_t)(rowt - NLAT) * 1024;
        float* xo = lat ? xout_lat + (size_t)rowt * 1024 : xout_ctx + (size_t)(rowt - NLAT) * 1024;
        const int r0 = wr * 64 + fr, col0 = u.pn * BM + wc * 32 + 4 * fq;
        const float* gp = gate + mv * 6144 + col0;
        f32x4 gv[2][2];
#pragma unroll
        for (int bj = 0; bj < 2; ++bj)
#pragma unroll
            for (int n = 0; n < 2; ++n) gv[bj][n] = *(const f32x4*)(gp + bj * HALF + n * 16);
#pragma unroll
        for (int ai = 0; ai < 2; ++ai)
#pragma unroll
            for (int mh = 0; mh < 2; ++mh) {
                f32x4 xv[2][2][2];
#pragma unroll
                for (int m2 = 0; m2 < 2; ++m2)
#pragma unroll
                    for (int bj = 0; bj < 2; ++bj)
#pragma unroll
                        for (int n = 0; n < 2; ++n) xv[m2][bj][n] = *(const f32x4*)(xin + (unsigned)(r0 + ai * HALF + (mh * 2 + m2) * 16) * 1024u + (unsigned)(col0 + bj * HALF + n * 16));
#pragma unroll
                for (int m2 = 0; m2 < 2; ++m2)
#pragma unroll
                    for (int bj = 0; bj < 2; ++bj)
#pragma unroll
                        for (int n = 0; n < 2; ++n) *(f32x4*)(xo + (unsigned)(r0 + ai * HALF + (mh * 2 + m2) * 16) * 1024u + (unsigned)(col0 + bj * HALF + n * 16)) = xv[m2][bj][n] + gv[bj][n] * acc[ai][bj][mh * 2 + m2][n];
            }
    }
};
}

DI f32x4 ctx_tile16(const bf16_t* A, int lda, const bf16_t* Bt, int ldb, int K, int lane) {
    const bf16_t* ap = A + (size_t)(lane & 15) * lda + 8 * (lane >> 4);
    const bf16_t* bp = Bt + (size_t)(lane & 15) * ldb + 8 * (lane >> 4);
    f32x4 acc0 = (f32x4){0.f, 0.f, 0.f, 0.f}, acc1 = acc0;
#pragma unroll 1
    for (int k = 0; k < K; k += 512) {
        bf16x8 a[16], b[16];
#pragma unroll
        for (int i = 0; i < 16; ++i) { a[i] = *(const bf16x8*)(ap + k + 32 * i); b[i] = *(const bf16x8*)(bp + k + 32 * i); }
#pragma unroll
        for (int i = 0; i < 16; i += 2) { acc0 = __builtin_amdgcn_mfma_f32_16x16x32_bf16(a[i], b[i], acc0, 0, 0, 0); acc1 = __builtin_amdgcn_mfma_f32_16x16x32_bf16(a[i + 1], b[i + 1], acc1, 0, 0, 0); }
    }
    return acc0 + acc1;
}
DI void phase_ctx_gemm(const Params& p, int l, int which, const float* xin_ctx) {
    unsigned char* const ws = ws_ptr();
    const int tid = otid(), lane = tid & 63, wid = tid >> 6;
    const bf16_t* proj = (const bf16_t*)(ws + WS_PROJ);
    bf16_t* Mo = (bf16_t*)(ws + WS_M);
    const int ncolt = which == 2 ? 128 : 64, ntile = 32 * ncolt;
    for (int wt = blockIdx.x * 8 + wid; wt < ntile; wt += gridDim.x * 8) {
        const int tr = wt / ncolt, tc = wt - tr * ncolt;
        const int r0 = NLAT + 16 * tr, c0 = 16 * tc;
        const int rowq = r0 + (lane >> 4) * 4, col = c0 + (lane & 15);
        if (which == 0) {
            f32x4 tot = (f32x4){0.f, 0.f, 0.f, 0.f};
#pragma unroll
            for (int seg = 0; seg < 3; ++seg) {
                const int acol = seg == 0 ? C_QA : (seg == 1 ? C_QB : C_RC), kk = seg == 2 ? 1024 : 512;
                const f32x4 acc = ctx_tile16(proj + (size_t)r0 * PW + acol, PW, (const bf16_t*)(ws + WS_WO) + (size_t)seg * 1024 * 1024 + (size_t)c0 * 1024, 1024, kk, lane);
#pragma unroll
                for (int q = 0; q < 4; ++q) tot[q] += sigmoidf_(bf2f(proj[(size_t)(rowq + q) * PW + C_GT + seg * 1024 + col])) * acc[q];
            }
#pragma unroll
            for (int q = 0; q < 4; ++q) Mo[(size_t)(rowq + q) * 1024 + col] = f2bf(tot[q]);
        } else if (which == 1) {
            const f32x4 acc = ctx_tile16(Mo + (size_t)r0 * 1024, 1024, (const bf16_t*)(ws + WS_WOUT) + (size_t)c0 * 1024, 1024, 1024, lane);
            const float g1 = ((const float*)(ws + WS_MOD))[((size_t)l * 3 + 2) * 6144 + 2 * 1024 + col];
            float* xo = (float*)(ws + WS_CTX);
#pragma unroll
            for (int q = 0; q < 4; ++q) { const size_t o = (size_t)(rowq + q - NLAT) * 1024 + col; xo[o] = xin_ctx[o] + g1 * acc[q]; }
        } else {
            const f32x4 acc = ctx_tile16((const bf16_t*)(ws + WS_H2) + (size_t)r0 * 1024, 1024, (const bf16_t*)(ws + WS_WPQ) + (size_t)c0 * 1024, 1024, 1024, lane);
            bf16_t* pq = (bf16_t*)(ws + WS_PQ);
#pragma unroll
            for (int q = 0; q < 4; ++q) pq[(size_t)(rowq + q) * 2048 + col] = f2bf(acc[q]);
        }
    }
}

DI void phase_mod(const Params& p, LAS float* lds) {
    unsigned char* const ws = ws_ptr();
    const int tid = otid();
    LAS float* act = lds;
    LAS float* red = lds + 3072;
    for (int i = tid; i < 3072; i += 512) { const int v = i >> 10, k = i & 1023; const float x = v < 2 ? PIN(I_C)[v * 1024 + k] : PIN(I_CCTX)[k]; act[i] = x / (1.0f + __expf(-x)); }
    __syncthreads();
    float* mod = (float*)(ws + WS_MOD);
    const int c4 = tid & 7, kg = tid >> 3;
    for (int cb = blockIdx.x; cb < 768; cb += gridDim.x) {
        const int l = cb / 192, col0 = (cb - l * 192) * 32;
        const float* W = PIN(I_WMOD) + (size_t)l * 1024 * 6144 + col0 + 4 * c4;
        f32x4 a0 = (f32x4){0.f, 0.f, 0.f, 0.f}, a1 = a0, a2 = a0;
#pragma unroll 8
        for (int k = kg; k < 1024; k += 64) { const f32x4 w = *(const f32x4*)(W + (size_t)k * 6144); a0 += w * act[k]; a1 += w * act[1024 + k]; a2 += w * act[2048 + k]; }
        *(LAS f32x4*)(red + (kg * 3 + 0) * 32 + 4 * c4) = a0; *(LAS f32x4*)(red + (kg * 3 + 1) * 32 + 4 * c4) = a1; *(LAS f32x4*)(red + (kg * 3 + 2) * 32 + 4 * c4) = a2;
        __syncthreads();
        if (tid < 96) { const int v = tid >> 5, cc = tid & 31; float sm = 0.f;
#pragma unroll 16
            for (int q = 0; q < 64; ++q) sm += red[(q * 3 + v) * 32 + cc];
            const int cj = col0 + cc;
            mod[((size_t)l * 3 + v) * 6144 + cj] = sm + PIN(I_BMOD)[l * 6144 + cj]; }
        __syncthreads();
    }

}

DI void tcvt_load(const float* src, int N, int kt, int nt, int tid, f32x4 (&v)[2]) {
    const int r = tid >> 4, c4 = (tid & 15) * 4;
#pragma unroll
    for (int i = 0; i < 2; ++i) { const int kk = kt * 64 + r + 32 * i, nn = nt * 64 + c4;
        v[i] = (f32x4){0.f, 0.f, 0.f, 0.f};
        if (nn < N) v[i] = *(const f32x4*)(src + (size_t)kk * N + nn); }
}
DI void tcvt_job(const float* src, int K, int N, int Npad, bf16_t* dst, int ldd, LAS float* tile, int& base, float fp8scale = 0.f) {
    const int tid = otid();
    const int nkt = K / 64, nnt = Npad / 64, ntl = nkt * nnt, G = gridDim.x;
    const int first = ((int)blockIdx.x - (base % G) + G) % G;
    f32x4 v[2];
    if (first < ntl) tcvt_load(src, N, first % nkt, first / nkt, tid, v);
    for (int t = first; t < ntl; t += G) {
        const int kt = t % nkt, nt = t / nkt;
        { const int r = tid >> 4, c4 = (tid & 15) * 4;
#pragma unroll
            for (int i = 0; i < 2; ++i) { LAS float* tp = tile + (r + 32 * i) * 65 + c4; tp[0] = v[i][0]; tp[1] = v[i][1]; tp[2] = v[i][2]; tp[3] = v[i][3]; } }
        if (t + G < ntl) tcvt_load(src, N, (t + G) % nkt, (t + G) / nkt, tid, v);
        __syncthreads();
        { const int n = tid >> 3, kc = (tid & 7) * 8; float x[8];
#pragma unroll
            for (int jj = 0; jj < 8; ++jj) x[jj] = tile[(kc + jj) * 65 + n];
            if (fp8scale != 0.f) { u32x2 w8; w8.x = pack4_fp8(x[0] * fp8scale, x[1] * fp8scale, x[2] * fp8scale, x[3] * fp8scale); w8.y = pack4_fp8(x[4] * fp8scale, x[5] * fp8scale, x[6] * fp8scale, x[7] * fp8scale);
                *(u32x2*)((unsigned char*)dst + (size_t)(nt * 64 + n) * ldd + kt * 64 + kc) = w8; }
            else { u32x4 w; w.x = pack2(x[0], x[1]); w.y = pack2(x[2], x[3]); w.z = pack2(x[4], x[5]); w.w = pack2(x[6], x[7]);
                *(u32x4*)(dst + (size_t)(nt * 64 + n) * ldd + kt * 64 + kc) = w; } }
        __syncthreads();
    }
    base += ntl;
}
DI void cvt_copy(const float* src, bf16_t* dst, size_t n) {
    const size_t nth = (size_t)gridDim.x * 512;
    for (size_t i = ((size_t)blockIdx.x * 512 + otid()) * 8; i < n; i += nth * 8) {
        const f32x4 a = *(const f32x4*)(src + i), b = *(const f32x4*)(src + i + 4);
        u32x4 w; w.x = pack2(a[0], a[1]); w.y = pack2(a[2], a[3]); w.z = pack2(b[0], b[1]); w.w = pack2(b[2], b[3]);
        *(u32x4*)(dst + i) = w;
    }
}
typedef float f32x2 __attribute__((ext_vector_type(2)));
constexpr float PU_SCALE = 64.0f, PV_SCALE = 4.0f;
constexpr int PSL = 4;
DI unsigned fp4_code(float x) {
    const float a = fabsf(x);
    const unsigned c = (unsigned)(a > 0.25f) + (unsigned)(a > 0.75f) + (unsigned)(a > 1.25f) + (unsigned)(a > 1.75f) + (unsigned)(a > 2.5f) + (unsigned)(a > 3.5f) + (unsigned)(a > 5.0f);
    return c | ((__float_as_uint(x) >> 28) & 8u);
}
DI unsigned pack8_fp4(const f32x4& a, const f32x4& b) {
    return fp4_code(a[0]) | (fp4_code(a[1]) << 4) | (fp4_code(a[2]) << 8) | (fp4_code(a[3]) << 12) | (fp4_code(b[0]) << 16) | (fp4_code(b[1]) << 20) | (fp4_code(b[2]) << 24) | (fp4_code(b[3]) << 28);
}
DI void cvt_copy_fp4(const float* src, unsigned char* dst, size_t n, float scale) {
    const size_t nth = (size_t)gridDim.x * 512;
    for (size_t i = ((size_t)blockIdx.x * 512 + otid()) * 32; i < n; i += nth * 32) {
        u32x4 w;
#pragma unroll
        for (int q = 0; q < 4; ++q) { const f32x4 a = *(const f32x4*)(src + i + 8 * q) * scale, b = *(const f32x4*)(src + i + 8 * q + 4) * scale; w[q] = pack8_fp4(a, b); }
        const size_t e = i >> 10, c0 = i & 1023;
        *(u32x4*)(dst + (c0 >> 8) * ((size_t)16384 * 128) + e * 128 + ((c0 & 255) >> 1)) = w;
    }
}
DI void phase_convert(const Params& p, int l, LAS float* lds) {
    unsigned char* const ws = ws_ptr();
    int base = 0;
    tcvt_job(PIN(I_WIN) + (size_t)l * 1024 * PW, 1024, PW, 8704, (bf16_t*)(ws + WS_WIN), 1024, lds, base, WIN8_SCALE);
    tcvt_job(PIN(I_WOA) + (size_t)l * 512 * 1024, 512, 1024, 1024, (bf16_t*)(ws + WS_WO), 1024, lds, base);
    tcvt_job(PIN(I_WOB) + (size_t)l * 512 * 1024, 512, 1024, 1024, (bf16_t*)(ws + WS_WO) + (size_t)1 * 1024 * 1024, 1024, lds, base);
    tcvt_job(PIN(I_WOC) + (size_t)l * 1024 * 1024, 1024, 1024, 1024, (bf16_t*)(ws + WS_WO) + (size_t)2 * 1024 * 1024, 1024, lds, base);
    tcvt_job(PIN(I_WOA) + (size_t)l * 512 * 1024, 512, 1024, 1024, (bf16_t*)(ws + WS_WO8), 1024, lds, base, WO8_SCALE);
    tcvt_job(PIN(I_WOB) + (size_t)l * 512 * 1024, 512, 1024, 1024, (bf16_t*)(ws + WS_WO8 + (size_t)1024 * 1024), 1024, lds, base, WO8_SCALE);
    tcvt_job(PIN(I_WOC) + (size_t)l * 1024 * 1024, 1024, 1024, 1024, (bf16_t*)(ws + WS_WO8 + (size_t)2 * 1024 * 1024), 1024, lds, base, WO8_SCALE);
    tcvt_job(PIN(I_WOUT) + (size_t)l * 1024 * 1024, 1024, 1024, 1024, (bf16_t*)(ws + WS_WOUT), 1024, lds, base);
    tcvt_job(PIN(I_WPQ) + (size_t)l * 1024 * 2048, 1024, 2048, 2048, (bf16_t*)(ws + WS_WPQ), 1024, lds, base);
    { const float* sk = PIN(I_SUBK) + (size_t)l * 262144; const float* pg = PIN(I_PQG) + l * 128; bf16_t* dst = (bf16_t*)(ws + WS_SUBK);
        for (int i = (blockIdx.x * 512 + otid()) * 2; i < 262144; i += gridDim.x * 1024) {
            const int d = i & 127; *(unsigned*)(dst + i) = pack2(sk[i] * pg[d], sk[i + 1] * pg[d + 1]); } }
    cvt_copy_fp4(PIN(I_PU) + (size_t)l * 16384 * 1024, ws + WS_TU, (size_t)16384 * 1024, PU_SCALE);
    cvt_copy_fp4(PIN(I_PV) + (size_t)l * 16384 * 1024, ws + WS_TV, (size_t)16384 * 1024, PV_SCALE);
}

DI void phase_norm(const Params& p, int l, int which, const float* xlat, const float* xctx, bf16_t* dst, int nrows) {
    unsigned char* const ws = ws_ptr();
    const int tid = otid(), lane = tid & 63, wid = tid >> 6;
    const float* gain = PIN(which ? I_NORM2 : I_NORM1) + l * 1024;
    const float* mod = (const float*)(ws + WS_MOD) + (size_t)l * 3 * 6144;
    for (int r0 = (blockIdx.x * 8 + wid) * 2; r0 < nrows; r0 += gridDim.x * 16) {
        f32x4 v[2][4];
#pragma unroll
        for (int rr = 0; rr < 2; ++rr) { const int r = r0 + rr; const float* x = r < NLAT ? xlat + (size_t)r * 1024 : xctx + (size_t)(r - NLAT) * 1024;
#pragma unroll
            for (int i = 0; i < 4; ++i) v[rr][i] = *(const f32x4*)(x + i * 256 + lane * 4); }
#pragma unroll
        for (int rr = 0; rr < 2; ++rr) { const int r = r0 + rr;
            const int mv = r < NLAT ? (r >> 14) : 2;
            const float* sh = mod + mv * 6144 + (which ? 3 : 0) * 1024; const float* sc = sh + 1024;
            float ss = 0.f;
#pragma unroll
            for (int i = 0; i < 4; ++i) ss += v[rr][i][0] * v[rr][i][0] + v[rr][i][1] * v[rr][i][1] + v[rr][i][2] * v[rr][i][2] + v[rr][i][3] * v[rr][i][3];
            ss = wave_sum(ss);
            const float rstd = rsqrtf(ss * (1.0f / 1024.0f) + EPS);
#pragma unroll
            for (int i = 0; i < 4; ++i) { const int c = i * 256 + lane * 4;
                const f32x4 g4 = *(const f32x4*)(gain + c), s4 = *(const f32x4*)(sc + c), h4 = *(const f32x4*)(sh + c);
                float y[4];
#pragma unroll
                for (int jj = 0; jj < 4; ++jj) y[jj] = v[rr][i][jj] * rstd * g4[jj] * (1.0f + s4[jj]) + h4[jj];
                if (which == 0) *(unsigned*)((unsigned char*)dst + (size_t)r * 1024 + c) = pack4_fp8(y[0] * H8_SCALE, y[1] * H8_SCALE, y[2] * H8_SCALE, y[3] * H8_SCALE);
                else { u32x2 w; w.x = pack2(y[0], y[1]); w.y = pack2(y[2], y[3]); *(u32x2*)(dst + (size_t)r * 1024 + c) = w;
                    const unsigned hi = pack4_fp8(y[0] * H2F8_SCALE, y[1] * H2F8_SCALE, y[2] * H2F8_SCALE, y[3] * H2F8_SCALE);
                    float hf[4]; unpack4_fp8(hi, hf[0], hf[1], hf[2], hf[3]);
                    const unsigned lo = pack4_fp8((y[0] * H2F8_SCALE - hf[0]) * 16.0f, (y[1] * H2F8_SCALE - hf[1]) * 16.0f, (y[2] * H2F8_SCALE - hf[2]) * 16.0f, (y[3] * H2F8_SCALE - hf[3]) * 16.0f);
                    unsigned char* h8 = ws + WS_H2F8 + (size_t)r * 2048 + c;
                    *(unsigned*)h8 = hi; *(unsigned*)(h8 + 1024) = lo; } } }
    }
}

DI void phase_post(const Params& p, int l, LAS unsigned char* lds) {
    unsigned char* const ws = ws_ptr();
    const int tid = otid(), lane = tid & 63, wid = tid >> 6;
    bf16_t* proj = (bf16_t*)(ws + WS_PROJ);
    {
        LAS float* tab = (LAS float*)lds;
        LAS float* gn = (LAS float*)(lds + 32768);
        for (int i = tid; i < 4096; i += 512) { const int pos = i >> 4, f = i & 15;
            const float inv = exp2f(-(float)f * (13.287712379549449f / 16.0f));
            const float ang = (float)pos * inv;
            const float n = rintf(ang * 0.15915494309189535f); float rr = fmaf(-n, 6.28125f, ang); rr = fmaf(-n, 1.9353071795864769e-3f, rr);
            tab[2 * i] = __cosf(rr); tab[2 * i + 1] = __sinf(rr); }
        if (tid < 256) { const int w = tid >> 6, d = tid & 63; gn[tid] = PIN(w == 0 ? I_QNA : (w == 1 ? I_QNB : (w == 2 ? I_KNB : I_KNA)))[l * 64 + d]; }
        __syncthreads();
        const int c8 = lane & 7;
        const float sgn = (c8 & 2) ? 1.0f : -1.0f;
        for (int r = blockIdx.x * 8 + wid; r < NROW; r += gridDim.x * 8) {
            bf16_t* row = proj + (size_t)r * PW;
            const bool lat = r < NLAT;
            const int t = r & (S - 1);
            const int pos = (c8 < 4) ? (t >> 6) : (t & 63);
            u32x4 wpre[4];
#pragma unroll
            for (int ps = 0; ps < 4; ++ps) { const int col = (ps == 0 ? C_QA : (ps == 1 ? C_QB : (ps == 2 ? C_KB : C_KA))) + 8 * (ps == 3 ? (lane & 15) : lane); wpre[ps] = *(const u32x4*)(row + col); }
#pragma unroll
            for (int ps = 0; ps < 4; ++ps) {
                const int col = (ps == 0 ? C_QA : (ps == 1 ? C_QB : (ps == 2 ? C_KB : C_KA))) + 8 * lane;
                if (ps == 3 && lane >= 16) continue;
                const u32x4 w = wpre[ps];
                float v[8] = {bf_lo(w.x), bf_hi(w.x), bf_lo(w.y), bf_hi(w.y), bf_lo(w.z), bf_hi(w.z), bf_lo(w.w), bf_hi(w.w)};
                float ss = 0.f;
#pragma unroll
                for (int i = 0; i < 8; ++i) ss += v[i] * v[i];
                ss += __shfl_xor(ss, 1); ss += __shfl_xor(ss, 2); ss += __shfl_xor(ss, 4);
                const float rstd = rsqrtf(ss * (1.0f / 64.0f) + EPS);
#pragma unroll
                for (int i = 0; i < 8; ++i) v[i] *= rstd * gn[ps * 64 + 8 * c8 + i];
                if ((ps == 0 || ps == 3) && lat) {
#pragma unroll
                    for (int i = 0; i < 8; ++i) { const float yp = __shfl_xor(v[i], 2); const int f = 8 * (c8 & 1) + i;
                        const float cs = tab[(pos * 16 + f) * 2], sn = tab[(pos * 16 + f) * 2 + 1];
                        v[i] = v[i] * cs + sgn * yp * sn; }
                }
                u32x4 o; o.x = pack2(v[0], v[1]); o.y = pack2(v[2], v[3]); o.z = pack2(v[4], v[5]); o.w = pack2(v[6], v[7]);
                *(u32x4*)(row + col) = o;
            }
        }
        __syncthreads();
    }
    {
        bf16_t* vt = (bf16_t*)(ws + WS_VT);
        const int ntl = (NROW / 64) * 13;
        const int rr = tid >> 3, ch = (tid & 7) * 16;
        auto src_of = [&](int it) -> const bf16_t* {
            const int tt = it / 13, cg = it - tt * 13;
            const int row0 = tt < 512 ? ((tt >> 8) * S + (tt & 255) * 64) : (NLAT + ((tt - 512) >> 2) * LC + ((tt - 512) & 3) * 64);
            const int vr0 = cg * 128;
            const int scol = vr0 < 128 ? C_VA + vr0 : (vr0 < 640 ? C_VB + (vr0 - 128) : C_VC + (vr0 - 640));
            return proj + (size_t)(row0 + rr) * PW + scol + ch; };
        int par = 0;
        u32x4 w0 = (u32x4){0u, 0u, 0u, 0u}, w1 = w0;
        if ((int)blockIdx.x < ntl) { const bf16_t* sp = src_of(blockIdx.x); w0 = *(const u32x4*)sp; w1 = *(const u32x4*)(sp + 8); }
        for (int it = blockIdx.x; it < ntl; it += gridDim.x, par ^= 1) {
            LAS bf16_t* tile = (LAS bf16_t*)(lds + par * 17408);
            const int tt = it / 13, cg = it - tt * 13;
            int b, tok0;
            if (tt < 512) { b = tt >> 8; tok0 = (tt & 255) * 64; } else { b = (tt - 512) >> 2; tok0 = S + ((tt - 512) & 3) * 64; }
            const int vr0 = cg * 128;
            *(LAS u32x4*)(tile + rr * 136 + ch) = w0; *(LAS u32x4*)(tile + rr * 136 + ch + 8) = w1;
            { const int nx = it + gridDim.x; if (nx < ntl) { const bf16_t* sp = src_of(nx); w0 = *(const u32x4*)sp; w1 = *(const u32x4*)(sp + 8); } }
            __syncthreads();
            { const int cc = tid >> 2, tk = (tid & 3) * 16; unsigned short v[16];
#pragma unroll
                for (int jj = 0; jj < 16; ++jj) v[jj] = tile[(tk + jj) * 136 + cc];
                u32x4 o0, o1;
                o0.x = v[0] | ((unsigned)v[1] << 16); o0.y = v[2] | ((unsigned)v[3] << 16); o0.z = v[4] | ((unsigned)v[5] << 16); o0.w = v[6] | ((unsigned)v[7] << 16);
                o1.x = v[8] | ((unsigned)v[9] << 16); o1.y = v[10] | ((unsigned)v[11] << 16); o1.z = v[12] | ((unsigned)v[13] << 16); o1.w = v[14] | ((unsigned)v[15] << 16);
                bf16_t* dp = vt + ((size_t)b * VTR + vr0 + cc) * TOKB + tok0 + tk;
                *(u32x4*)dp = o0; *(u32x4*)(dp + 8) = o1; }
        }
        __syncthreads();
    }
}

struct AttnState { bf16x8 Q[2][4]; f32x16 O[2][2]; float m[2], l[2]; };
struct TileRef { unsigned ku, vu; int kpos0; const LAS float* brow; };
struct AttnLane { const char* pb; const char* vb;
    unsigned ksrc, vsrc;
    LAS unsigned char* kbuf; LAS unsigned char* vbuf;
    unsigned krd, vrd; };
DI void attn_dma_k(const AttnLane& al, unsigned ku, int par) {
    const char* src = al.pb + (size_t)(ku + al.ksrc);
#pragma unroll
    for (int q = 0; q < 4; ++q) __builtin_amdgcn_global_load_lds((const unsigned*)(src + (size_t)q * (8 * PW * 2)), (LAS unsigned*)(al.kbuf + par * 8192 + q * 1024), 16, 0, 0);
}
DI void attn_dma_v(const AttnLane& al, unsigned vu, int par) {
    const char* src = al.vb + (size_t)(vu + al.vsrc);
#pragma unroll
    for (int q = 0; q < 4; ++q) __builtin_amdgcn_global_load_lds((const unsigned*)(src + (size_t)q * (16 * TOKB * 2)), (LAS unsigned*)(al.vbuf + par * 8192 + q * 1024), 16, 0, 0);
}
template <int MODE>
DI void attn_tile(AttnState& st, const AttnLane& al, int par, const TileRef& tr, unsigned kunext, unsigned vunext, int qpos0, int g, bool domask) {
    asm volatile("s_waitcnt vmcnt(12)" ::: "memory");
    f32x16 sc[2];
    {
        bf16x8 Kf[4];
#pragma unroll
        for (int s = 0; s < 4; ++s) Kf[s] = *(const LAS bf16x8*)(al.kbuf + par * 8192 + (al.krd ^ (unsigned)(s << 4)));
#pragma unroll
        for (int u = 0; u < 2; ++u) {
            sc[u] = zero16();
#pragma unroll
            for (int s = 0; s < 4; ++s) sc[u] = MFMA32(Kf[s], st.Q[u][s], sc[u]);
        }
    }
    asm volatile("s_waitcnt lgkmcnt(0)" ::: "memory");
    attn_dma_k(al, kunext, par);
    const int kpos0 = tr.kpos0;
    bf16x8 Vf[2][2];
#pragma unroll
    for (int u = 0; u < 2; ++u) {
        const int qp = qpos0 + 32 * u;
        if (MODE == 1 && domask) {
            const int base = kpos0 + 8 * g - qp + 128;
#pragma unroll
            for (int r = 0; r < 16; ++r) sc[u][r] = ((unsigned)(base + 16 * (r >> 3) + (r & 7)) <= 256u) ? sc[u][r] : -INFINITY;
        } else if (MODE == 2 && domask) {
            int cs = qp - 8; cs = cs < 0 ? 0 : (cs > 48 ? 48 : cs);
            const int vb = kpos0 + 8 * g - cs;
            const LAS float* bp = tr.brow + (kpos0 + 8 * g - qp + 15);
            float bv[16];
#pragma unroll
            for (int r = 0; r < 16; ++r) bv[r] = bp[16 * (r >> 3) + (r & 7)];
            asm volatile("" ::: "memory");
#pragma unroll
            for (int r = 0; r < 16; ++r) { const int o = 16 * (r >> 3) + (r & 7); const float t = sc[u][r] + bv[r]; sc[u][r] = ((unsigned)(vb + o) < 16u) ? t : -INFINITY; }
        }
        float mx = sc[u][0];
#pragma unroll
        for (int r = 1; r < 16; ++r) mx = fmaxf(mx, sc[u][r]);
        mx = fmaxf(mx, __shfl_xor(mx, 32));
        const float mn = fmaxf(st.m[u], mx);
        float rs = 0.f;
#pragma unroll
        for (int r = 0; r < 16; ++r) { const float pv = __builtin_amdgcn_exp2f(sc[u][r] - mn); rs += pv; sc[u][r] = pv; }
        if (__builtin_amdgcn_ballot_w64(mn > st.m[u]) != 0ull) {
            const float alpha = __builtin_amdgcn_exp2f(st.m[u] - mn);
            st.l[u] *= alpha;
#pragma unroll
            for (int r = 0; r < 16; ++r) { st.O[0][u][r] *= alpha; st.O[1][u][r] *= alpha; }
        }
        st.m[u] = mn;
        st.l[u] += rs;
        bf16x8 P[2];
#pragma unroll
        for (int s = 0; s < 2; ++s) { u32x4 w; w.x = pack2(sc[u][8 * s], sc[u][8 * s + 1]); w.y = pack2(sc[u][8 * s + 2], sc[u][8 * s + 3]); w.z = pack2(sc[u][8 * s + 4], sc[u][8 * s + 5]); w.w = pack2(sc[u][8 * s + 6], sc[u][8 * s + 7]);
            P[s] = __builtin_bit_cast(bf16x8, w); }
        if (u == 0) {
            asm volatile("s_waitcnt vmcnt(12)" ::: "memory");
#pragma unroll
            for (int dt = 0; dt < 2; ++dt)
#pragma unroll
                for (int s = 0; s < 2; ++s) Vf[dt][s] = *(const LAS bf16x8*)(al.vbuf + par * 8192 + dt * 2048 + (al.vrd ^ (unsigned)(s << 5)));
        }
#pragma unroll
        for (int dt = 0; dt < 2; ++dt)
#pragma unroll
            for (int s = 0; s < 2; ++s) st.O[dt][u] = MFMA32(Vf[dt][s], P[s], st.O[dt][u]);
    }
    asm volatile("s_waitcnt lgkmcnt(0)" ::: "memory");
    attn_dma_v(al, vunext, par);
}
DI void attn_load_q(AttnState& st, const bf16_t* proj, int qrow0, int qcol, int j, int g) {
    const float qs = 0.125f * LOG2E;
#pragma unroll
    for (int u = 0; u < 2; ++u) {
        const bf16_t* qp = proj + (size_t)(qrow0 + 32 * u + j) * PW + qcol + 32 * g;
#pragma unroll
        for (int s = 0; s < 4; ++s) { const u32x4 w = *(const u32x4*)(qp + 8 * s); u32x4 o;
            o.x = pack2(bf_lo(w.x) * qs, bf_hi(w.x) * qs); o.y = pack2(bf_lo(w.y) * qs, bf_hi(w.y) * qs); o.z = pack2(bf_lo(w.z) * qs, bf_hi(w.z) * qs); o.w = pack2(bf_lo(w.w) * qs, bf_hi(w.w) * qs);
            st.Q[u][s] = __builtin_bit_cast(bf16x8, o); }
        st.O[0][u] = zero16(); st.O[1][u] = zero16();
    }
}
DI void attn_store(const AttnState& st, bf16_t* proj, int qrow0, int ocol, int j, int g) {
#pragma unroll
    for (int u = 0; u < 2; ++u) {
        const float lt = st.l[u] + __shfl_xor(st.l[u], 32);
        const float inv = 1.0f / lt;
        bf16_t* op = proj + (size_t)(qrow0 + 32 * u + j) * PW + ocol + 4 * g;
#pragma unroll
        for (int dt = 0; dt < 2; ++dt)
#pragma unroll
            for (int q = 0; q < 4; ++q) { u32x2 w; w.x = pack2(st.O[dt][u][4 * q] * inv, st.O[dt][u][4 * q + 1] * inv); w.y = pack2(st.O[dt][u][4 * q + 2] * inv, st.O[dt][u][4 * q + 3] * inv);
                *(u32x2*)(op + 32 * dt + 8 * q) = w; }
    }
}
DI void attn_store8(const AttnState& st, unsigned char* o8, int qrow0, int obyte, int j, int g) {
#pragma unroll
    for (int u = 0; u < 2; ++u) {
        const float lt = st.l[u] + __shfl_xor(st.l[u], 32);
        const float inv = O8_SCALE / lt;
        unsigned char* op = o8 + (size_t)(qrow0 + 32 * u + j) * 2048 + obyte + 4 * g;
#pragma unroll
        for (int dt = 0; dt < 2; ++dt)
#pragma unroll
            for (int q = 0; q < 4; ++q) *(unsigned*)(op + 32 * dt + 8 * q) = pack4_fp8(st.O[dt][u][4 * q] * inv, st.O[dt][u][4 * q + 1] * inv, st.O[dt][u][4 * q + 2] * inv, st.O[dt][u][4 * q + 3] * inv);
    }
}
struct CtxTiles { unsigned k0, v0;
    DI TileRef operator()(int t) const { TileRef r; r.ku = k0 + (unsigned)(32 * t) * (PW * 2); r.vu = v0 + 64 * t; r.kpos0 = 0; r.brow = nullptr; return r; } };
struct LocATiles { unsigned k0, v0; int p0;
    DI TileRef operator()(int t) const { TileRef r; const int kp0 = p0 + 32 * t; r.ku = k0 + (unsigned)kp0 * (PW * 2); r.vu = v0 + 2 * kp0; r.kpos0 = kp0; r.brow = nullptr; return r; } };
struct LocBTiles { unsigned k0, v0; int rs; const LAS float* rpbh; int r;
    DI TileRef operator()(int t) const { TileRef q; const int kr = rs + (t >> 1), c0 = (t & 1) * 32; q.ku = k0 + (unsigned)(kr * 64 + c0) * (PW * 2); q.vu = v0 + 2 * (kr * 64 + c0); q.kpos0 = c0; q.brow = rpbh + (kr - r + 7) * 31; return q; } };
struct NoTiles { DI TileRef operator()(int) const { TileRef r; r.ku = 0; r.vu = 0; r.kpos0 = 0; r.brow = nullptr; return r; } };
template <int MODE, class LT>
DI void attn_run(AttnState& st, const AttnLane& al, const CtxTiles& ct, const LT& lt, int lo, int hi, int ulo, int uhi, int qpos0, int g) {
    const int ntot = 8 + (hi - lo);
    TileRef cur = ct(0), n1 = ct(1);
    attn_dma_k(al, cur.ku, 0); attn_dma_v(al, cur.vu, 0); attn_dma_k(al, n1.ku, 1); attn_dma_v(al, n1.vu, 1);
#pragma unroll 1
    for (int tt = 0; tt < ntot; ++tt) {
        int t2 = tt + 2; if (t2 > ntot - 1) t2 = ntot - 1;
        TileRef n2; if (t2 < 8) n2 = ct(t2); else n2 = lt(lo + t2 - 8);
        const int tl = lo + tt - 8;
        const bool domask = (tt >= 8) && !(tl >= ulo && tl < uhi);
        attn_tile<MODE>(st, al, tt & 1, cur, n2.ku, n2.vu, qpos0, g, domask);
        cur = n1; n1 = n2;
    }
}
DI void phase_attn(const Params& p, int l, LAS unsigned char* lds) {
    unsigned char* const ws = ws_ptr();
    const int tid = otid(), lane = tid & 63, wid = tid >> 6, j = lane & 31, g = lane >> 5;
    bf16_t* proj = (bf16_t*)(ws + WS_PROJ);
    LAS float* rpb = (LAS float*)(lds + 256);
    for (int i = tid; i < 8 * 15 * 31; i += 512) rpb[i] = PIN(I_RPB)[l * 3720 + i] * LOG2E;
    __syncthreads();
    const bool last = (l == DEPTH - 1);
    const int nitems = 8192 + (last ? 0 : 128);
    AttnLane al; al.pb = (const char*)(ws + WS_PROJ); al.vb = (const char*)(ws + WS_VT);
    { const int kr = lane >> 3, kc = (lane & 7) ^ (kr & 7); al.ksrc = (unsigned)(kr * PW * 2 + kc * 16);
        const int vr = lane >> 2, vc = (lane & 3) ^ ((vr >> 2) & 3); al.vsrc = (unsigned)(vr * TOKB * 2 + vc * 16);
        const int wu = __builtin_amdgcn_readfirstlane(wid);
        al.kbuf = lds + 16384 + wu * 16384; al.vbuf = lds + 16384 + wu * 16384 + 4096;
        const int rho = pi32(j); al.krd = (unsigned)(rho * 128 + (((4 * g) ^ (rho & 7)) << 4));
        al.vrd = (unsigned)(j * 64 + ((g ^ ((j >> 2) & 3)) << 4)); }
    for (int it = blockIdx.x * 8 + wid; it < nitems; it += gridDim.x * 8) {
        AttnState st;
        if (it < 4096) {
            const int half = it & 1, hh = (it >> 1) & 7, n = (it >> 4) & 127, b = it >> 11;
            const int q0 = n * 128 + half * 64, qrow0 = b * S + q0, g2 = hh >> 2;
            attn_load_q(st, proj, qrow0, C_QA + hh * 64, j, g);
            const float sk = PIN(I_SINKA)[l * 8 + hh] * LOG2E;
            st.m[0] = st.m[1] = sk; st.l[0] = st.l[1] = (g == 0) ? 1.0f : 0.0f;
            CtxTiles ct; ct.k0 = (unsigned)((NLAT + b * LC) * PW + C_KA + g2 * 64) * 2u; ct.v0 = (unsigned)((b * VTR + g2 * 64) * TOKB + S) * 2u;
            LocATiles la; la.k0 = (unsigned)(b * S * PW + C_KA + g2 * 64) * 2u; la.v0 = (unsigned)((b * VTR + g2 * 64) * TOKB) * 2u; la.p0 = (n - 1) * 128;
            int lo = half ? 2 : 0, hi = half ? 12 : 10;
            if (n == 0 && lo < 4) lo = 4;
            if (n == 127 && hi > 8) hi = 8;
            attn_run<1>(st, al, ct, la, lo, hi, 2 + 2 * half, 8 + 2 * half, q0 + j, g);
            attn_store8(st, ws + WS_O8, qrow0, hh * 64, j, g);
        } else if (it < 8192) {
            const int i2 = it - 4096, h = i2 & 7, r = (i2 >> 3) & 255, b = i2 >> 11;
            const int qrow0 = b * S + r * 64;
            attn_load_q(st, proj, qrow0, C_QB + h * 64, j, g);
            st.m[0] = st.m[1] = -INFINITY; st.l[0] = st.l[1] = 0.f;
            CtxTiles ct; ct.k0 = (unsigned)((NLAT + b * LC) * PW + C_KB + h * 64) * 2u; ct.v0 = (unsigned)((b * VTR + 128 + h * 64) * TOKB + S) * 2u;
            int rs = r - 4; rs = rs < 0 ? 0 : (rs > 248 ? 248 : rs);
            LocBTiles lb; lb.k0 = (unsigned)(b * S * PW + C_KB + h * 64) * 2u; lb.v0 = (unsigned)((b * VTR + 128 + h * 64) * TOKB) * 2u; lb.rs = rs; lb.rpbh = rpb + h * 15 * 31; lb.r = r;
            attn_run<2>(st, al, ct, lb, 0, 16, 0, 0, j, g);
            attn_store8(st, ws + WS_O8, qrow0, 512 + h * 64, j, g);
        } else {
            const int i2 = it - 8192, qt = i2 & 3, h = (i2 >> 2) & 7, b = (i2 >> 5) & 1, mixer = i2 >> 6;
            const int qrow0 = NLAT + b * LC + qt * 64;
            const int qcol = mixer == 0 ? C_QA + h * 64 : C_QB + h * 64;
            const int kcol = mixer == 0 ? C_KA + (h >> 2) * 64 : C_KB + h * 64;
            const int vr0 = mixer == 0 ? (h >> 2) * 64 : 128 + h * 64;
            attn_load_q(st, proj, qrow0, qcol, j, g);
            const float sk = PIN(I_SINKA)[l * 8 + h] * LOG2E;
            st.m[0] = st.m[1] = mixer == 0 ? sk : -INFINITY; st.l[0] = st.l[1] = (mixer == 0 && g == 0) ? 1.0f : 0.0f;
            CtxTiles ct; ct.k0 = (unsigned)((NLAT + b * LC) * PW + kcol) * 2u; ct.v0 = (unsigned)((b * VTR + vr0) * TOKB + S) * 2u;
            NoTiles nt;
            attn_run<0>(st, al, ct, nt, 0, 0, 0, 0, 0, g);
            attn_store(st, proj, qrow0, qcol, j, g);
        }
    }
}

DI void gla_chunk_rows(int b, int ci, int& row0, int& tok0) {
    if (ci < 256) { tok0 = ci * 64; row0 = b * S + tok0; } else { const int cc = ci - 256; tok0 = S + cc * 64; row0 = NLAT + b * LC + cc * 64; }
}
constexpr int GL_A = 0;
constexpr int GL_W = 8192;
constexpr int GL_B = 24576;
constexpr int GL_QT = 27648;
constexpr int GL_SSQ = 25600;
constexpr int GL_LA = 30720;
constexpr int GL_QH = 63488;
constexpr int GL_KT = 79872;
constexpr int GL_SB = 96256;
constexpr int GL_OUT = GL_QH + 18432;
constexpr int GL_ATT = GL_LA;
DI u32x4 gla_load_a(const bf16_t* proj, int row0, int) {
    const int tid = otid();
    u32x4 w = (u32x4){0u, 0u, 0u, 0u};
    if (tid < 256) w = *(const u32x4*)(proj + (size_t)(row0 + (tid >> 2)) * PW + C_AC + (tid & 3) * 8);
    return w;
}
DI void gla_stage_gate(const Params& p, int l, const u32x4& w, int h, LAS unsigned char* lds, int& cur_h) {
    const int tid = otid();
    LAS float* a_s = (LAS float*)(lds + GL_A); LAS float* w_s = (LAS float*)(lds + GL_W); LAS float* b_s = (LAS float*)(lds + GL_B);
    if (tid < 256) { const int tok = tid >> 2, c8 = (tid & 3) * 8;
        LAS float* d = a_s + tok * 32 + c8; d[0] = bf_lo(w.x); d[1] = bf_hi(w.x); d[2] = bf_lo(w.y); d[3] = bf_hi(w.y); d[4] = bf_lo(w.z); d[5] = bf_hi(w.z); d[6] = bf_lo(w.w); d[7] = bf_hi(w.w); }
    if (h != cur_h) {
        cur_h = h;
#pragma unroll
        for (int q = 0; q < 8; ++q) { const int i = tid + q * 512, dir = i >> 11, rr = (i >> 7) & 15, ch = i & 127;
            w_s[i] = PIN(dir ? I_WA2B : I_WA2F)[(size_t)l * 16 * 512 + rr * 512 + h * 128 + ch]; }
        if (tid < 256) { const int dir = tid >> 7, ch = tid & 127; b_s[tid] = PIN(dir ? I_BAB : I_BAF)[l * 512 + h * 128 + ch]; }
    }
}
DI void gla_logdecay(int dir, LAS unsigned char* lds) {
    const int tid = otid();
    const LAS float* a_s = (const LAS float*)(lds + GL_A); const LAS float* w_s = (const LAS float*)(lds + GL_W) + dir * 2048; const LAS float* b_s = (const LAS float*)(lds + GL_B) + dir * 128;
    LAS float* la = (LAS float*)(lds + GL_LA);
    LAS float* qt = (LAS float*)(lds + GL_QT);
    const int ch = tid & 127, tq = tid >> 7; float w[16];
#pragma unroll
    for (int i = 0; i < 16; ++i) w[i] = w_s[i * 128 + ch];
    const float bb = b_s[ch];
    float run = 0.f;
#pragma unroll 4
    for (int t = 0; t < 16; ++t) { const int tok = tq * 16 + (dir ? 15 - t : t); float z = bb;
        const LAS f32x4* ap = (const LAS f32x4*)(a_s + tok * 32 + dir * 16);
#pragma unroll
        for (int i = 0; i < 4; ++i) { const f32x4 av = ap[i]; z += av[0] * w[4 * i] + av[1] * w[4 * i + 1] + av[2] * w[4 * i + 2] + av[3] * w[4 * i + 3]; }
        run += (fminf(z, 0.f) - __logf(1.0f + __expf(-fabsf(z)))) * (1.0f / 16.0f);
        la[tok * 128 + ch] = run; }
    qt[tq * 128 + ch] = run;
    __syncthreads();
    float off = 0.f;
#pragma unroll
    for (int q = 0; q < 4; ++q) { const float v = qt[q * 128 + ch]; off += (dir ? (q > tq) : (q < tq)) ? v : 0.f; }
#pragma unroll
    for (int t = 0; t < 16; ++t) la[(tq * 16 + t) * 128 + ch] += off;
    __syncthreads();
}
DI void phase_gla1(const Params& p, int l, LAS unsigned char* lds) {
    unsigned char* const ws = ws_ptr();
    const int tid = otid(), lane = tid & 63, wid = tid >> 6, j = lane & 31, g = lane >> 5;
    const bf16_t* proj = (const bf16_t*)(ws + WS_PROJ);
    const bf16_t* vt = (const bf16_t*)(ws + WS_VT);
    unsigned char* stt = ws + WS_ST; float* dec = (float*)(ws + WS_DEC);
    const LAS float* la = (const LAS float*)(lds + GL_LA);
    LAS bf16_t* ktT = (LAS bf16_t*)(lds + GL_QH);
    int cur_h = -1;
    u32x4 a_pre = (u32x4){0u, 0u, 0u, 0u};
    if ((int)blockIdx.x < NB * NCH * 4) { int r0_, t0_; gla_chunk_rows(((int)blockIdx.x >> 2) / NCH, ((int)blockIdx.x >> 2) % NCH, r0_, t0_); a_pre = gla_load_a(proj, r0_, tid); }
    for (int un = blockIdx.x; un < NB * NCH * 4; un += gridDim.x) {
        const int h = un & 3, ci = (un >> 2) % NCH, b = (un >> 2) / NCH;
        int row0, tok0; gla_chunk_rows(b, ci, row0, tok0);
        gla_stage_gate(p, l, a_pre, h, lds, cur_h);
        { const int un2 = un + gridDim.x; if (un2 < NB * NCH * 4) { int r0_, t0_; gla_chunk_rows((un2 >> 2) / NCH, (un2 >> 2) % NCH, r0_, t0_); a_pre = gla_load_a(proj, r0_, tid); } }
        bf16x8 Vf[4];
#pragma unroll
        for (int s = 0; s < 4; ++s) Vf[s] = *(const bf16x8*)(vt + ((size_t)b * VTR + 640 + h * 256 + 32 * wid + j) * TOKB + tok0 + 16 * s + 8 * g);
        const u32x4 k0 = *(const u32x4*)(proj + (size_t)(row0 + (tid >> 3)) * PW + C_KC + h * 128 + (tid & 7) * 16), k1 = *(const u32x4*)(proj + (size_t)(row0 + (tid >> 3)) * PW + C_KC + h * 128 + (tid & 7) * 16 + 8);
        __syncthreads();
        for (int dir = 0; dir < 2; ++dir) {
            gla_logdecay(dir, lds);
            const int chain = (b * 4 + h) * 2 + dir;
            { const int tok = tid >> 3, cc = (tid & 7) * 16;
                const unsigned kw[8] = {k0.x, k0.y, k0.z, k0.w, k1.x, k1.y, k1.z, k1.w};
                const int te = dir ? 0 : 63;
#pragma unroll
                for (int q = 0; q < 8; ++q) { const int ch = cc + 2 * q;
                    const float w0 = __expf(la[te * 128 + ch] - la[tok * 128 + ch]), w1 = __expf(la[te * 128 + ch + 1] - la[tok * 128 + ch + 1]);
                    const int tr_ = (tok + 8 * (ch >> 4)) & 63;
                    ktT[ch * 72 + tr_] = f2bf(bf_lo(kw[q]) * w0); ktT[(ch + 1) * 72 + tr_] = f2bf(bf_hi(kw[q]) * w1); } }
            if (tid < 128) dec[((size_t)chain * NCH + ci) * 128 + tid] = __expf(la[(dir ? 0 : 63) * 128 + tid]);
            __syncthreads();
            unsigned char* so = stt + ((size_t)chain * NCH + ci) * 32768 + (size_t)(32 * wid) * 128;
            LAS unsigned char* ob = lds + GL_OUT + wid * 8704;
            const int prow = 16 * ((j >> 2) & 1) + 4 * (j >> 3) + (j & 3);
#pragma unroll
            for (int dk = 0; dk < 4; ++dk) {
                f32x16 acc = zero16();
                const int krow = 32 * dk + prow;
#pragma unroll
                for (int s = 0; s < 4; ++s) { const bf16x8 Af = *(const LAS bf16x8*)(ktT + krow * 72 + (((2 * s + g + (krow >> 4)) & 7) << 3)); acc = MFMA32(Af, Vf[s], acc); }
                u32x4 w0;
                w0.x = pack4_fp8(acc[0], acc[1], acc[2], acc[3]); w0.y = pack4_fp8(acc[4], acc[5], acc[6], acc[7]); w0.z = pack4_fp8(acc[8], acc[9], acc[10], acc[11]); w0.w = pack4_fp8(acc[12], acc[13], acc[14], acc[15]);
                *(LAS u32x4*)(ob + j * 144 + 32 * dk + 16 * g) = w0;
            }
#pragma unroll
            for (int q = 0; q < 4; ++q) { const int row = 8 * q + (lane >> 3), chk = lane & 7;
                *(u32x4*)(so + (size_t)row * 128 + chk * 16) = *(const LAS u32x4*)(ob + row * 144 + chk * 16); }
            __syncthreads();
        }
    }
}
DI void phase_gla2(const Params& p) {
    unsigned char* const ws = ws_ptr();
    const char* sb = (const char*)(ws + WS_ST); const char* db = (const char*)(ws + WS_DEC);
    for (int gt = blockIdx.x * 512 + otid(); gt < 16 * 8192; gt += gridDim.x * 512) {
        const int chain = gt >> 13, e = gt & 8191, dv = e >> 5, dk0 = (e & 31) * 4, dir = chain & 1;
        const unsigned so = (unsigned)(chain * NCH * 32768 + dv * 128 + dk0), dof = (unsigned)((chain * NCH * 128 + dk0) * 4);
        float s0, s1, s2, s3;
        asm volatile("v_mov_b32 %0, 0\n\tv_mov_b32 %1, 0\n\tv_mov_b32 %2, 0\n\tv_mov_b32 %3, 0" : "=v"(s0), "=v"(s1), "=v"(s2), "=v"(s3));
        auto chunk_of = [&](int step) -> int { return dir ? (NCH - 1 - step) : (step < 4 ? 256 + step : step - 4); };
        unsigned dS[4], dSn[4]; f32x4 dd[4], ddn[4];
#pragma unroll
        for (int q = 0; q < 4; ++q) { const unsigned c = (unsigned)chunk_of(q); dS[q] = *(const unsigned*)(sb + (size_t)(so + c * 32768u)); dd[q] = *(const f32x4*)(db + (size_t)(dof + c * 512u)); }
        for (int st = 0; st < NCH; st += 4) {
            const int sn = st + 4 < NCH ? st + 4 : st;
#pragma unroll
            for (int q = 0; q < 4; ++q) { const unsigned c = (unsigned)chunk_of(sn + q); dSn[q] = *(const unsigned*)(sb + (size_t)(so + c * 32768u)); ddn[q] = *(const f32x4*)(db + (size_t)(dof + c * 512u)); }
#pragma unroll
            for (int q = 0; q < 4; ++q) {
                *(unsigned*)((char*)sb + (size_t)(so + (unsigned)chunk_of(st + q) * 32768u)) = pack4_fp8(s0, s1, s2, s3);
                float e0, e1, e2, e3; unpack4_fp8(dS[q], e0, e1, e2, e3);
                s0 = dd[q][0] * s0 + e0; s1 = dd[q][1] * s1 + e1; s2 = dd[q][2] * s2 + e2; s3 = dd[q][3] * s3 + e3;
            }
#pragma unroll
            for (int q = 0; q < 4; ++q) { dS[q] = dSn[q]; dd[q] = ddn[q]; }
        }
    }
}
DI int gl_swz(int tok, int chunk) { return tok * 256 + ((chunk ^ (tok & 15)) << 4); }
template <int DIR>
DI void gla3_dir(const Params& p, LAS unsigned char* lds, const u32x4 (&qk)[4], const unsigned char* state, const bf16x8 (&Vf)[2][2], f32x16 (&O)[2]) {
    const int tid = otid(), lane = tid & 63, wid = tid >> 6, j = lane & 31, g = lane >> 5;
    LAS unsigned char* sb = lds + GL_SB + __builtin_amdgcn_readfirstlane(wid) * 8192;
    { const char* src = (const char*)(state + (size_t)(32 * wid) * 128);
#pragma unroll
        for (int q = 0; q < 4; ++q) { const int r = 8 * q + (lane >> 3), c = (lane & 7) ^ (r & 7);
            __builtin_amdgcn_global_load_lds((const unsigned*)(src + r * 128 + c * 16), (LAS unsigned*)(sb + q * 1024), 16, 0, 0); } }
    gla_logdecay(DIR, lds);

    const LAS float* la = (const LAS float*)(lds + GL_LA);
    { const int tok = tid >> 3, cc = (tid & 7) * 16;
        u32x4 q0 = qk[0], q1 = qk[1], k0 = qk[2], k1 = qk[3];
        asm volatile("" : "+v"(q0), "+v"(q1), "+v"(k0), "+v"(k1));
        const unsigned qw[8] = {q0.x, q0.y, q0.z, q0.w, q1.x, q1.y, q1.z, q1.w}, kw[8] = {k0.x, k0.y, k0.z, k0.w, k1.x, k1.y, k1.z, k1.w};
        unsigned qo[8], ko[8];
#pragma unroll
        for (int q = 0; q < 8; ++q) { const float b0 = la[tok * 128 + cc + 2 * q], b1 = la[tok * 128 + cc + 2 * q + 1];
            qo[q] = pack2(bf_lo(qw[q]) * 0.08838834764831845f * __expf(b0), bf_hi(qw[q]) * 0.08838834764831845f * __expf(b1));
            ko[q] = pack2(bf_lo(kw[q]) * __expf(fminf(-b0, 80.f)), bf_hi(kw[q]) * __expf(fminf(-b1, 80.f))); }
        const int c0 = (tid & 7) * 2;
        *(LAS u32x4*)(lds + GL_QH + gl_swz(tok, c0)) = (u32x4){qo[0], qo[1], qo[2], qo[3]}; *(LAS u32x4*)(lds + GL_QH + gl_swz(tok, c0 + 1)) = (u32x4){qo[4], qo[5], qo[6], qo[7]};
        *(LAS u32x4*)(lds + GL_KT + gl_swz(tok, c0)) = (u32x4){ko[0], ko[1], ko[2], ko[3]}; *(LAS u32x4*)(lds + GL_KT + gl_swz(tok, c0 + 1)) = (u32x4){ko[4], ko[5], ko[6], ko[7]}; }
    __syncthreads();
    if (wid < 4) {
        const int tj = wid >> 1, ti = wid & 1;
        const bool skip = DIR == 0 ? (tj > ti) : (tj < ti);
        if (!skip) {
            f32x16 acc = zero16();
            const int ktok = 32 * tj + pi32(j), qtok = 32 * ti + j;
#pragma unroll
            for (int s = 0; s < 8; ++s) { const bf16x8 Af = *(const LAS bf16x8*)(lds + GL_KT + gl_swz(ktok, 2 * s + g)), Bf = *(const LAS bf16x8*)(lds + GL_QH + gl_swz(qtok, 2 * s + g)); acc = MFMA32(Af, Bf, acc); }
#pragma unroll
            for (int r = 0; r < 16; ++r) { const int kt = 32 * tj + 16 * (r >> 3) + 8 * g + (r & 7); const bool keep = DIR == 0 ? (kt <= qtok) : (kt >= qtok); acc[r] = keep ? acc[r] : 0.f; }
            asm volatile("s_waitcnt lgkmcnt(0)" ::: "memory");
#pragma unroll
            for (int s = 0; s < 2; ++s) { u32x4 w; w.x = pack2(acc[8 * s], acc[8 * s + 1]); w.y = pack2(acc[8 * s + 2], acc[8 * s + 3]); w.z = pack2(acc[8 * s + 4], acc[8 * s + 5]); w.w = pack2(acc[8 * s + 6], acc[8 * s + 7]);
                *(LAS u32x4*)(lds + GL_ATT + ((wid * 2 + s) * 64 + lane) * 16) = w; }
        }
    }
    asm volatile("s_waitcnt vmcnt(0)" ::: "memory");
    u32x2 S8[8];
    { const int r = 16 * ((j >> 2) & 1) + 4 * (j >> 3) + (j & 3);
#pragma unroll
        for (int s = 0; s < 8; ++s) S8[s] = *(const LAS u32x2*)(sb + r * 128 + ((s ^ (r & 7)) << 4) + 8 * g); }
    __syncthreads();
#pragma unroll
    for (int ti = 0; ti < 2; ++ti) {
#pragma unroll
        for (int tj = 0; tj < 2; ++tj) {
            const bool skip = DIR == 0 ? (tj > ti) : (tj < ti);
            if (!skip) {
#pragma unroll
                for (int s = 0; s < 2; ++s) { const bf16x8 Bf = *(const LAS bf16x8*)(lds + GL_ATT + (((tj * 2 + ti) * 2 + s) * 64 + lane) * 16); O[ti] = MFMA32(Vf[tj][s], Bf, O[ti]); }
            }
        }
#pragma unroll
        for (int s = 0; s < 8; ++s) { const bf16x8 Bf = *(const LAS bf16x8*)(lds + GL_QH + gl_swz(32 * ti + j, 2 * s + g));
            float e[8]; unpack4_fp8(S8[s].x, e[0], e[1], e[2], e[3]); unpack4_fp8(S8[s].y, e[4], e[5], e[6], e[7]);
            const u32x4 wb = (u32x4){pack2(e[0], e[1]), pack2(e[2], e[3]), pack2(e[4], e[5]), pack2(e[6], e[7])};
            O[ti] = MFMA32(__builtin_bit_cast(bf16x8, wb), Bf, O[ti]); }
    }
    __syncthreads();
}
DI void phase_gla3(const Params& p, int l, LAS unsigned char* lds) {
    unsigned char* const ws = ws_ptr();
    const int tid = otid(), lane = tid & 63, wid = tid >> 6, j = lane & 31, g = lane >> 5;
    bf16_t* proj = (bf16_t*)(ws + WS_PROJ);
    const bf16_t* vt = (const bf16_t*)(ws + WS_VT);
    const unsigned char* stt = ws + WS_ST;
    LAS float* ssq = (LAS float*)(lds + GL_SSQ);
    const bool last = (l == DEPTH - 1);
    int cur_h = -1, a_for = -1;
    u32x4 a_pre = (u32x4){0u, 0u, 0u, 0u};
    for (int un = blockIdx.x; un < NB * NCH * 4; un += gridDim.x) {
        const int h = un & 3, ci = (un >> 2) % NCH, b = (un >> 2) / NCH;
        if (last && ci >= 256) continue;
        int row0, tok0; gla_chunk_rows(b, ci, row0, tok0);
        const int prow = 16 * ((j >> 2) & 1) + 4 * (j >> 3) + (j & 3);
        if (a_for != un) a_pre = gla_load_a(proj, row0, tid);
        gla_stage_gate(p, l, a_pre, h, lds, cur_h);
        { const int un2 = un + gridDim.x; if (un2 < NB * NCH * 4) { int r0_, t0_; gla_chunk_rows((un2 >> 2) / NCH, (un2 >> 2) % NCH, r0_, t0_); a_pre = gla_load_a(proj, r0_, tid); a_for = un2; } }
        bf16x8 Vf[2][2];
        const int t2 = otid(), vrow = 32 * (t2 >> 6) + 16 * ((t2 >> 2) & 1) + 4 * ((t2 & 31) >> 3) + (t2 & 3), vg8 = 8 * ((t2 >> 5) & 1);
#pragma unroll
        for (int tj = 0; tj < 2; ++tj)
#pragma unroll
            for (int s = 0; s < 2; ++s) Vf[tj][s] = *(const bf16x8*)(vt + ((size_t)b * VTR + 640 + h * 256 + vrow) * TOKB + tok0 + 32 * tj + 16 * s + vg8);
        f32x16 O[2]; O[0] = zero16(); O[1] = zero16();
        u32x4 qk[4];
        { const bf16_t* rp = proj + (size_t)(row0 + (tid >> 3)) * PW + h * 128 + (tid & 7) * 16;
            qk[0] = *(const u32x4*)(rp + C_QC); qk[1] = *(const u32x4*)(rp + C_QC + 8); qk[2] = *(const u32x4*)(rp + C_KC); qk[3] = *(const u32x4*)(rp + C_KC + 8); }
        __syncthreads();
        const size_t chain0 = (size_t)(b * 4 + h) * 2;
        gla3_dir<0>(p, lds, qk, stt + ((chain0 + 0) * NCH + ci) * 32768, Vf, O);
        gla3_dir<1>(p, lds, qk, stt + ((chain0 + 1) * NCH + ci) * 32768, Vf, O);
#pragma unroll
        for (int ti = 0; ti < 2; ++ti) { float s = 0.f;
#pragma unroll
            for (int r = 0; r < 16; ++r) s += O[ti][r] * O[ti][r];
            s += __shfl_xor(s, 32);
            if (g == 0) ssq[(32 * ti + j) * 8 + wid] = s; }
        __syncthreads();
        const float* gn = PIN(I_GNC) + l * 256;
#pragma unroll
        for (int ti = 0; ti < 2; ++ti) {
            float tot = 0.f;
#pragma unroll
            for (int w = 0; w < 8; ++w) tot += ssq[(32 * ti + j) * 8 + w];
            const float rstd = rsqrtf(tot * (1.0f / 256.0f) + EPS);
            bf16_t* rp = proj + (size_t)(row0 + 32 * ti + j) * PW + C_RC + h * 256 + 32 * wid + 16 * g;
            const u32x4 ra = *(const u32x4*)rp, rb = *(const u32x4*)(rp + 8);
            const unsigned rw[8] = {ra.x, ra.y, ra.z, ra.w, rb.x, rb.y, rb.z, rb.w};
            float yv[16];
#pragma unroll
            for (int q = 0; q < 8; ++q) {
                const float r0 = bf_lo(rw[q]), r1 = bf_hi(rw[q]);
                const float g0 = gn[32 * wid + 16 * g + 2 * q], g1 = gn[32 * wid + 16 * g + 2 * q + 1];
                yv[2 * q] = O[ti][2 * q] * rstd * g0 * r0 * sigmoidf_(r0); yv[2 * q + 1] = O[ti][2 * q + 1] * rstd * g1 * r1 * sigmoidf_(r1);
            }
            if (ci < 256) {
                u32x4 w8;
#pragma unroll
                for (int q = 0; q < 4; ++q) w8[q] = pack4_fp8(yv[4 * q] * O8_SCALE, yv[4 * q + 1] * O8_SCALE, yv[4 * q + 2] * O8_SCALE, yv[4 * q + 3] * O8_SCALE);
                *(u32x4*)(ws + WS_O8 + (size_t)(row0 + 32 * ti + j) * 2048 + 1024 + h * 256 + 32 * wid + 16 * g) = w8;
            } else {
                unsigned ow[8];
#pragma unroll
                for (int q = 0; q < 8; ++q) ow[q] = pack2(yv[2 * q], yv[2 * q + 1]);
                *(u32x4*)rp = (u32x4){ow[0], ow[1], ow[2], ow[3]}; *(u32x4*)(rp + 8) = (u32x4){ow[4], ow[5], ow[6], ow[7]}; }
        }
        __syncthreads();
    }
}

#define CE_DESC(a, b) do { const float _hi = fmaxf(a, b), _lo = fminf(a, b); a = _hi; b = _lo; } while (0)
template <int N> DI void sort_desc(float (&v)[N]) {
#pragma unroll
    for (int k = 2; k <= N; k <<= 1)
#pragma unroll
        for (int jj = k >> 1; jj > 0; jj >>= 1)
#pragma unroll
            for (int i = 0; i < N; ++i) { const int x = i ^ jj; if (x > i) { if ((i & k) == 0) CE_DESC(v[i], v[x]); else CE_DESC(v[x], v[i]); } }
}
DI void merge_top16(float (&a)[16], const float (&b)[16]) {
#pragma unroll
    for (int i = 0; i < 16; ++i) a[i] = fmaxf(a[i], b[15 - i]);
#pragma unroll
    for (int jj = 8; jj > 0; jj >>= 1)
#pragma unroll
        for (int i = 0; i < 16; ++i) { const int x = i ^ jj; if (x > i) CE_DESC(a[i], a[x]); }
}
DI void merge_partner16(float (&a)[16]) {
    float b[16];
#pragma unroll
    for (int i = 0; i < 16; ++i) b[i] = __shfl_xor(a[i], 32);
    merge_top16(a, b);
}
DI void top16_of_64(float (&v)[64], float (&o)[16]) {
    float a[16], b[16];
#pragma unroll
    for (int i = 0; i < 16; ++i) { a[i] = v[i]; b[i] = v[16 + i]; }
    sort_desc<16>(a); sort_desc<16>(b); merge_top16(a, b);
#pragma unroll
    for (int i = 0; i < 16; ++i) { o[i] = v[32 + i]; b[i] = v[48 + i]; }
    sort_desc<16>(o); sort_desc<16>(b); merge_top16(o, b);
    merge_top16(o, a);
}
DI float bsel(int c, float a, float b) { const unsigned m = (unsigned)-(c != 0); return __uint_as_float((__float_as_uint(a) & m) | (__float_as_uint(b) & ~m)); }
DI float msel(unsigned long long m, float a, float b) { float r; asm("v_cndmask_b32 %0, %1, %2, %3" : "=v"(r) : "v"(b), "v"(a), "s"(m)); return r; }
DI float set_low(float f, unsigned mask, unsigned val) { return __uint_as_float((__float_as_uint(f) & ~mask) | val); }

DI void phase_peer_select(const Params& p, int l, LAS unsigned char* lds) {
    unsigned char* const ws = ws_ptr();
    const int tid = otid(), lane = tid & 63, wid = tid >> 6, j = lane & 31, g = lane >> 5;
    const bf16_t* pq = (const bf16_t*)(ws + WS_PQ);
    const bf16_t* subk = (const bf16_t*)(ws + WS_SUBK);
    unsigned short* pidx = (unsigned short*)(ws + WS_PIDX); float* pgw = (float*)(ws + WS_PG);
    LAS unsigned* tab = (LAS unsigned*)lds + wid * 2048;
    LAS unsigned char* kimg = lds + 65536;
    const int ngroups = (l == DEPTH - 1 ? NLAT : NROW) / 32, noct = (ngroups + 7) / 8;
    int cur_ph = -1;
    for (int w = blockIdx.x; w < 8 * noct; w += gridDim.x) {
        const int ph = w & 7, grp = (w >> 3) * 8 + wid;
        if (ph != cur_ph) {
            __syncthreads();
#pragma unroll
            for (int k = 0; k < 8; ++k) { const int pc = tid + 512 * k, row = pc >> 4, c = pc & 15;
                *(LAS u32x4*)(kimg + row * 256 + ((c ^ (row & 15)) << 4)) = *(const u32x4*)(subk + (size_t)(ph * 256 + row) * 128 + c * 8); }
            __syncthreads();
            cur_ph = ph;
        }
        if (grp >= ngroups) continue;
        const int r0 = grp * 32;
        float top[2][16];
#pragma unroll
        for (int half = 0; half < 2; ++half) {
            bf16x8 Bq[8]; float ss = 0.f;
            const bf16_t* qp = pq + (size_t)(r0 + j) * 2048 + ph * 256 + half * 128 + 8 * g;
#pragma unroll
            for (int s = 0; s < 8; ++s) { const u32x4 w4 = *(const u32x4*)(qp + 16 * s); Bq[s] = __builtin_bit_cast(bf16x8, w4);
                const float e0 = bf_lo(w4.x), e1 = bf_hi(w4.x), e2 = bf_lo(w4.y), e3 = bf_hi(w4.y), e4 = bf_lo(w4.z), e5 = bf_hi(w4.z), e6 = bf_lo(w4.w), e7 = bf_hi(w4.w);
                ss += e0 * e0 + e1 * e1 + e2 * e2 + e3 * e3 + e4 * e4 + e5 * e5 + e6 * e6 + e7 * e7; }
            ss += __shfl_xor(ss, 32);
            const float rstd = rsqrtf(ss * (1.0f / 128.0f) + EPS);
#pragma unroll
            for (int r = 0; r < 16; ++r) top[half][r] = -INFINITY;
#pragma unroll 1
            for (int kt = 0; kt < 4; ++kt) {
                f32x16 acc = zero16();
#pragma unroll
                for (int s = 0; s < 8; ++s) { const int row = half * 128 + kt * 32 + j; const bf16x8 Af = *(const LAS bf16x8*)(kimg + row * 256 + (((2 * s + g) ^ (row & 15)) << 4)); acc = MFMA32(Af, Bq[s], acc); }
                float sc[16];
#pragma unroll
                for (int r = 0; r < 16; ++r) sc[r] = set_low(acc[r] * rstd, 127u, (unsigned)(32 * kt + (r & 3) + 8 * (r >> 2) + 4 * g));
                sort_desc<16>(sc);
                merge_top16(top[half], sc);
            }
            __builtin_amdgcn_sched_barrier(0);
            merge_partner16(top[half]);
        }
        float va[16], vb[16];
#pragma unroll
        for (int i = 0; i < 16; ++i) { va[i] = set_low(top[0][i], 127u, 0u); vb[i] = set_low(top[1][i], 127u, 0u);
            tab[i * 64 + lane] = __float_as_uint(top[0][i]) & 127u; tab[(16 + i) * 64 + lane] = __float_as_uint(top[1][i]) & 127u; }
        float cand[32];
#pragma unroll
        for (int i = 0; i < 27; ++i) {
            const int a = i < 16 ? 0 : (i < 23 ? 1 : (i < 26 ? 2 : 3));
            const int bb = i < 16 ? i : (i < 23 ? i - 15 : (i < 26 ? i - 21 : 3));
            const float s0 = va[a] + vb[bb], s1 = va[bb] + vb[a];
            float c = g ? s1 : s0;
            c = set_low(c, 255u, g ? (unsigned)(bb * 16 + a) : (unsigned)(a * 16 + bb));
            if (a == bb) c = g ? -INFINITY : c;
            cand[i] = c;
        }
#pragma unroll
        for (int i = 27; i < 32; ++i) cand[i] = -INFINITY;
        float ca[16], cb[16];
#pragma unroll
        for (int i = 0; i < 16; ++i) { ca[i] = cand[i]; cb[i] = cand[16 + i]; }
        sort_desc<16>(ca); sort_desc<16>(cb); merge_top16(ca, cb);
        merge_partner16(ca);
        const float mx = set_low(ca[0], 255u, 0u);
        float ev[16], sum = 0.f;
#pragma unroll
        for (int i = 0; i < 16; ++i) { ev[i] = __expf(set_low(ca[i], 255u, 0u) - mx); sum += ev[i]; }
        const float inv = 1.0f / sum;
        const size_t ob = (size_t)(r0 + j) * 128 + ph * 16 + 8 * g;
#pragma unroll
        for (int k = 0; k < 8; ++k) {
            const float cv = bsel(g, ca[8 + k], ca[k]); const float e = bsel(g, ev[8 + k], ev[k]);
            const unsigned pos = __float_as_uint(cv) & 255u;
            const unsigned i1 = tab[(pos >> 4) * 64 + lane], i2 = tab[(16 + (pos & 15)) * 64 + lane];
            pidx[ob + k] = (unsigned short)(i1 * 128u + i2); pgw[ob + k] = e * inv;
        }
    }
}

constexpr int PEER_CHUNK_ROWS = 64;
#define FP4PAIR(w, b) __builtin_amdgcn_cvt_scalef32_pk_f32_fp4((w), 1.0f, (b))
template <int PHASE_V>
DI void phase_peer_uv(const Params& p, int l, LAS unsigned char* lds, float* xo_lat, float* xo_ctx) {
    unsigned char* const ws = ws_ptr();
    const int tid = otid(), lane = tid & 63, wid = tid >> 6, tsub = lane >> 3, c8 = lane & 7;
    const bf16_t* h2 = (const bf16_t*)(ws + WS_H2);
    const unsigned char* tabl = ws + (PHASE_V ? WS_TV : WS_TU);
    const unsigned short* pidx = (const unsigned short*)(ws + WS_PIDX);
    const float* pgw = (const float*)(ws + WS_PG);
    float* part = (float*)(ws + WS_PART);
    const float* mod = (const float*)(ws + WS_MOD) + (size_t)l * 3 * 6144;
    unsigned* qh = (unsigned*)(ws + WS_CTL) + CW_QUEUE + ((l * 2 + PHASE_V) * 8) * 64;
    LAS unsigned* sh = (LAS unsigned*)lds;
    const int nchunks = (l == DEPTH - 1 ? NLAT : NROW) / PEER_CHUNK_ROWS;
    int s = (int)(xb_xcc_id() & (unsigned)(PSL - 1)), tried = 0, par = 0;
    if (tid == 0) sh[0] = __hip_atomic_fetch_add(&qh[s * 64], 1u, __ATOMIC_RELAXED, __HIP_MEMORY_SCOPE_AGENT);
    __syncthreads();
    unsigned cur = sh[0];
    for (;;) {
        if ((int)cur >= nchunks) {
            s = (s + 1) & (PSL - 1); if (++tried == PSL) break;
            if (tid == 0) sh[par ^ 1] = __hip_atomic_fetch_add(&qh[s * 64], 1u, __ATOMIC_RELAXED, __HIP_MEMORY_SCOPE_AGENT);
            __syncthreads(); cur = sh[par ^ 1]; par ^= 1; continue;
        }
        unsigned nxt = 0u;
        if (tid == 0) nxt = __hip_atomic_fetch_add(&qh[s * 64], 1u, __ATOMIC_RELAXED, __HIP_MEMORY_SCOPE_AGENT);
        const int row = (int)cur * PEER_CHUNK_ROWS + wid * 8 + tsub;
        const unsigned char* tb = tabl + (size_t)s * ((size_t)16384 * 128);
        const unsigned c8o = 16u * (unsigned)c8;
        const unsigned short* ip = pidx + (size_t)row * 128;
        auto ldrows = [&](u32x4 (&r)[16], const u32x4& a, const u32x4& c) {
            const unsigned iw[8] = {a.x, a.y, a.z, a.w, c.x, c.y, c.z, c.w};
#pragma unroll
            for (int k = 0; k < 16; ++k) { const unsigned e = (k & 1) ? (iw[k >> 1] >> 16) : (iw[k >> 1] & 0xffffu); r[k] = *(const u32x4*)(tb + (size_t)((e << 7) | c8o)); } };
        if (!PHASE_V) {
            typedef int i32x8 __attribute__((ext_vector_type(8)));
            typedef int i32x4 __attribute__((ext_vector_type(4)));
            const int pi = lane & 15, kg = lane >> 4, r8 = lane >> 3, sl = lane & 7;
            const unsigned char* h2f8 = ws + WS_H2F8;
            LAS unsigned char* wb = lds + 4096 + __builtin_amdgcn_readfirstlane(wid) * 19456;
            const int rbase = (int)cur * PEER_CHUNK_ROWS + wid * 8;
            const unsigned fsw = (unsigned)((r8 & 2) << 1);
            const unsigned a0 = (unsigned)((pi & 3) * 1024 + (pi >> 2) * 128), ax = (unsigned)((pi & 3) | (((pi >> 3) & 1) << 2));
            auto tokdma = [&](int T) {
                const unsigned char* src = lane < 32 ? h2f8 + (size_t)(rbase + T) * 2048 + (lane >> 4) * 1024 + 256 * s + 16 * (lane & 15) : (const unsigned char*)(pidx + (size_t)(rbase + T) * 128) + 16 * (lane & 15);
                __builtin_amdgcn_global_load_lds((const unsigned*)src, (LAS unsigned*)(wb + 16384 + (T % 3) * 1024), 16, 0, 0); };
            auto dma = [&](int gg) {
                const u32x2 iw = *(const LAS u32x2*)(wb + 16384 + ((gg >> 2) % 3) * 1024 + 512 + (32 * (gg & 3) + 4 * r8) * 2);
                LAS unsigned char* bb = wb + (gg & 3) * 4096;
#pragma unroll
                for (int q = 0; q < 4; ++q) { const unsigned e = (q & 1) ? (iw[q >> 1] >> 16) : (iw[q >> 1] & 0xffffu); const unsigned c = (unsigned)sl ^ ((unsigned)q | fsw);
                    __builtin_amdgcn_global_load_lds((const unsigned*)(tb + (size_t)((e << 7) | (c << 4))), (LAS unsigned*)(bb + q * 1024), 16, 0, 0); } };
            tokdma(0); tokdma(1);
            asm volatile("s_waitcnt vmcnt(0)" ::: "memory");
            dma(0); dma(1); dma(2);
            i32x8 B0, B1;
#pragma unroll
            for (int g = 0; g < 32; ++g) {
                const int t = g >> 2, qt = g & 3;
                if (t == 0) asm volatile("s_waitcnt vmcnt(8)" ::: "memory"); else if (g >= 30) asm volatile("s_waitcnt vmcnt(6)" ::: "memory"); else asm volatile("s_waitcnt vmcnt(14)" ::: "memory");
                if (qt == 2 && t + 2 < 8) tokdma(t + 2);
                if (g + 3 < 32) dma(g + 3);
                if (qt == 0) { const LAS unsigned char* tk = wb + 16384 + (t % 3) * 1024 + (pi & 1) * 256 + 16 * kg;
                    const u32x4 b0 = *(const LAS u32x4*)tk, b1 = *(const LAS u32x4*)(tk + 64), b2 = *(const LAS u32x4*)(tk + 128), b3 = *(const LAS u32x4*)(tk + 192);
                    B0 = (i32x8){(int)b0.x, (int)b0.y, (int)b0.z, (int)b0.w, (int)b1.x, (int)b1.y, (int)b1.z, (int)b1.w};
                    B1 = (i32x8){(int)b2.x, (int)b2.y, (int)b2.z, (int)b2.w, (int)b3.x, (int)b3.y, (int)b3.z, (int)b3.w}; }
                const LAS unsigned char* bb = wb + (g & 3) * 4096;
                f32x4 acc[2];
#pragma unroll
                for (int m = 0; m < 2; ++m) {
                    const i32x4 a0v = __builtin_bit_cast(i32x4, *(const LAS u32x4*)(bb + a0 + m * 512 + ((((unsigned)kg) ^ ax) << 4)));
                    const i32x4 a1v = __builtin_bit_cast(i32x4, *(const LAS u32x4*)(bb + a0 + m * 512 + ((((unsigned)(4 + kg)) ^ ax) << 4)));
                    const i32x8 A0 = __builtin_shufflevector(a0v, a0v, 0, 1, 2, 3, -1, -1, -1, -1), A1 = __builtin_shufflevector(a1v, a1v, 0, 1, 2, 3, -1, -1, -1, -1);
                    acc[m] = __builtin_amdgcn_mfma_scale_f32_16x16x128_f8f6f4(A0, B0, (f32x4){0.f, 0.f, 0.f, 0.f}, 4, 0, 0, 127, 0, 127);
                    acc[m] = __builtin_amdgcn_mfma_scale_f32_16x16x128_f8f6f4(A1, B1, acc[m], 4, 0, 0, 127, 0, 127);
                }
                float* pp = part + ((size_t)s * NROW + rbase + t) * 128 + 32 * qt + 4 * kg;
#pragma unroll
                for (int m = 0; m < 2; ++m) { f32x4 o;
#pragma unroll
                    for (int r = 0; r < 4; ++r) o[r] = (acc[m][r] + __shfl_xor(acc[m][r], 1) * (1.0f / 16.0f)) * (1.0f / H2F8_SCALE);
                    if (pi == 0) *(f32x4*)(pp + 16 * m) = o; }
            }
        } else {
            const float* wp = pgw + (size_t)row * 128;
            f32x2 o2[16];
#pragma unroll
            for (int i = 0; i < 16; ++i) o2[i] = (f32x2){0.f, 0.f};
            auto accum = [&](const u32x4 (&vw)[16], const f32x4 (&wq)[4]) {
#pragma unroll
                for (int k = 0; k < 16; ++k) { const float w = wq[k >> 2][k & 3]; const f32x2 w2 = (f32x2){w, w};
#pragma unroll
                    for (int q = 0; q < 4; ++q) { o2[4 * q] += w2 * FP4PAIR(vw[k][q], 0); o2[4 * q + 1] += w2 * FP4PAIR(vw[k][q], 1); o2[4 * q + 2] += w2 * FP4PAIR(vw[k][q], 2); o2[4 * q + 3] += w2 * FP4PAIR(vw[k][q], 3); } } };
            auto ldw = [&](f32x4 (&wq)[4], int kb) {
#pragma unroll
                for (int q = 0; q < 4; ++q) wq[q] = *(const f32x4*)(wp + kb * 16 + 4 * q); };
            u32x4 ia0 = *(const u32x4*)ip, ia1 = *(const u32x4*)(ip + 8), ib0 = *(const u32x4*)(ip + 16), ib1 = *(const u32x4*)(ip + 24);
            f32x4 wa[4], wb[4]; ldw(wa, 0); ldw(wb, 1);
            u32x4 RA[16], RB[16];
            ldrows(RA, ia0, ia1);
#pragma unroll 1
            for (int kb = 0; kb < 8; kb += 2) {
                ldrows(RB, ib0, ib1);
                { const int kn = kb + 2 < 8 ? kb + 2 : 7; ia0 = *(const u32x4*)(ip + kn * 16); ia1 = *(const u32x4*)(ip + kn * 16 + 8); }
                accum(RA, wa);
                { const int kn = kb + 2 < 8 ? kb + 2 : 7; ldw(wa, kn); }
                ldrows(RA, ia0, ia1);
                { const int kn = kb + 3 < 8 ? kb + 3 : 7; ib0 = *(const u32x4*)(ip + kn * 16); ib1 = *(const u32x4*)(ip + kn * 16 + 8); }
                accum(RB, wb);
                { const int kn = kb + 3 < 8 ? kb + 3 : 7; ldw(wb, kn); }
            }
            if (DBG_ZERO & 8) {
#pragma unroll
                for (int i = 0; i < 16; ++i) o2[i] = (f32x2){0.f, 0.f}; }
            const bool lat = row < NLAT;
            const int mv = lat ? (row >> 14) : 2;
            const float* g2 = mod + mv * 6144 + 5 * 1024 + 256 * s + 32 * c8;
            float* xo = (lat ? xo_lat + (size_t)row * 1024 : xo_ctx + (size_t)(row - NLAT) * 1024) + 256 * s + 32 * c8;
#pragma unroll
            for (int q = 0; q < 8; ++q) { const f32x4 xv = *(const f32x4*)(xo + 4 * q), gv = *(const f32x4*)(g2 + 4 * q);
                f32x4 o; o[0] = xv[0] + gv[0] * o2[2 * q][0]; o[1] = xv[1] + gv[1] * o2[2 * q][1]; o[2] = xv[2] + gv[2] * o2[2 * q + 1][0]; o[3] = xv[3] + gv[3] * o2[2 * q + 1][1];
                *(f32x4*)(xo + 4 * q) = o; }
        }
        if (tid == 0) sh[par ^ 1] = nxt;
        __syncthreads();
        cur = sh[par ^ 1]; par ^= 1;
    }
    __syncthreads();
}
DI void phase_peer_w(const Params& p, int l) {
    unsigned char* const ws = ws_ptr();
    const float* part = (const float*)(ws + WS_PART);
    float* pgw = (float*)(ws + WS_PG);
    const int n = (l == DEPTH - 1 ? NLAT : NROW) * 128;
    for (int i = (blockIdx.x * 512 + otid()) * 4; i < n; i += gridDim.x * 2048) {
        f32x4 sm = *(const f32x4*)(part + i);
#pragma unroll
        for (int x = 1; x < PSL; ++x) sm += *(const f32x4*)(part + (size_t)x * NROW * 128 + i);
        const f32x4 g = *(const f32x4*)(pgw + i);
        f32x4 o;
#pragma unroll
        for (int q = 0; q < 4; ++q) { const float t = sm[q] * (1.0f / PU_SCALE); o[q] = g[q] * 0.5f * t * (1.0f + erff(t * 0.70710678118654752f)) * (1.0f / PV_SCALE); }
        *(f32x4*)(pgw + i) = o;
    }
}

__global__ void __launch_bounds__(512, 2) hybrid_fwd(Params p) {
    LAS unsigned char* const ldsc = (LAS unsigned char*)lds_raw;
    LAS unsigned char* lds = ldsc + LDS_CTRL;
    if (threadIdx.x == 0) { *(LAS u32x4*)(ldsc + LDS_BARW) = (u32x4){0u, 0u, 0u, 0u}; *(LAS unsigned long long*)(ldsc + 512) = 0ull;
        LAS unsigned long long* pt = (LAS unsigned long long*)(ldsc + LDS_PTRS);
#pragma unroll
        for (int i = 0; i < 29; ++i) pt[i] = (unsigned long long)(uintptr_t)p.in[i]; }
    __syncthreads();
    XcdBarrier bar; bar.bar = (unsigned*)(p.ws + WS_CTL); bar.x = 0; bar.st = (volatile LAS unsigned*)(ldsc + LDS_BARW);
    if (p.use_bar) bar = xcd_barrier_post((unsigned*)(p.ws + WS_CTL), (volatile LAS unsigned*)(ldsc + LDS_BARW));
#define IN(ph) ((ph) >= p.gp_lo && (ph) < p.gp_hi)
#define SEAM() do { if (p.use_bar) { XcdBarrier b2; b2.bar = (unsigned*)(ws_ptr() + WS_CTL); b2.x = bar.x; b2.st = (volatile LAS unsigned*)(ldsc + LDS_BARW); xcd_barrier(b2); } else __syncthreads(); } while (0)
    unsigned long long pr_acc = 0, pr_t0 = 0;
#define PT0() do { if (PROBE_MASK) pr_t0 = __builtin_amdgcn_s_memrealtime(); } while (0)
#define PT1(k) do { if (PROBE_MASK & (1 << (k))) pr_acc += __builtin_amdgcn_s_memrealtime() - pr_t0; } while (0)
    if (IN(0)) { PT0(); phase_mod(p, (LAS float*)lds); SEAM(); PT1(15); }
    for (int l = 0; l < DEPTH; ++l) {
        const int gb = 1 + l * NPH;
        unsigned char* const ws = ws_ptr();
        float* const outp = (float*)(GAS float*)p.out;
        bf16_t* const proj = (bf16_t*)(ws + WS_PROJ);
        float* const ctxr = (float*)(ws + WS_CTX);
        const float* xin_lat = l == 0 ? PIN(I_X) : outp;
        const float* xin_ctx = l == 0 ? PIN(I_CTX) : ctxr;
        if (IN(gb + 0)) { PT0(); phase_convert(p, l, (LAS float*)lds); phase_norm(p, l, 0, xin_lat, xin_ctx, (bf16_t*)(ws + WS_H), NROW); SEAM(); PT1(0); }
        if (IN(gb + 1)) { PT0();
            pg8::Gemm g{}; g.A = (const bf16_t*)(ws + WS_H); g.Bt = (const bf16_t*)(ws + WS_WIN); g.lda = 512; g.ldb = 512; g.K = 512; g.bseg = 0;
            pg8::Order<1> so; so.init(NROW, 8704, gridDim.x, blockIdx.x);
            pg8::EpiBf16 e; e.O = proj; e.ldc = PW; e.ncols = PW; e.oscale = 1.0f / (H8_SCALE * WIN8_SCALE);
            pg8::gemm_phase<1>(lds, g, so, e, 1); SEAM(); PT1(1);
        }
        if (IN(gb + 2)) { PT0(); phase_post(p, l, lds); SEAM(); PT1(2); }
        if (IN(gb + 3)) { PT0(); phase_gla1(p, l, lds); __syncthreads(); phase_attn(p, l, lds); SEAM(); PT1(3); }
        if (IN(gb + 5)) { PT0(); phase_gla2(p); SEAM(); PT1(5); }
        if (IN(gb + 6)) { PT0(); phase_gla3(p, l, lds); SEAM(); PT1(6); }
        if (IN(gb + 7)) { PT0();
            pg8::Gemm g{}; g.A = (const bf16_t*)(ws + WS_O8); g.Bt = (const bf16_t*)(ws + WS_WO8); g.lda = 1024; g.ldb = 512; g.K = 256; g.bseg = (size_t)1024 * 512;
            g.ac0 = 0; g.ac1 = 256; g.ac2 = 512; g.ac3 = 0; g.k0 = 256; g.k1 = 256; g.k2 = 512; g.k3 = 0;
            if (l != DEPTH - 1) phase_ctx_gemm(p, l, 0, xin_ctx);
            pg8::Order<3> so; so.init(NLAT, 1024, gridDim.x, blockIdx.x);
            pg8::EpiMerge e; e.proj = proj; e.Mo = (bf16_t*)(ws + WS_M); e.oscale = 1.0f / (O8_SCALE * WO8_SCALE);
            pg8::gemm_phase<1>(lds, g, so, e, 2); SEAM(); PT1(7);
        }
        if (IN(gb + 8)) { PT0();
            pg8::Gemm g{}; g.A = (const bf16_t*)(ws + WS_M); g.Bt = (const bf16_t*)(ws + WS_WOUT); g.lda = 1024; g.ldb = 1024; g.K = 1024; g.bseg = 0;
            if (l != DEPTH - 1) phase_ctx_gemm(p, l, 1, xin_ctx);
            pg8::Order<1> so; so.init(NLAT, 1024, gridDim.x, blockIdx.x);
            pg8::EpiResid e; e.xin_lat = xin_lat; e.xin_ctx = xin_ctx; e.xout_lat = outp; e.xout_ctx = ctxr; e.gate = (const float*)(ws + WS_MOD) + (size_t)l * 3 * 6144 + 2 * 1024;
            pg8::gemm_phase<0>(lds, g, so, e, 3); SEAM(); PT1(8);
        }
        if (IN(gb + 9)) { PT0(); phase_norm(p, l, 1, outp, ctxr, (bf16_t*)(ws + WS_H2), l == DEPTH - 1 ? NLAT : NROW); SEAM(); PT1(9); }
        if (IN(gb + 10)) { PT0();
            pg8::Gemm g{}; g.A = (const bf16_t*)(ws + WS_H2); g.Bt = (const bf16_t*)(ws + WS_WPQ); g.lda = 1024; g.ldb = 1024; g.K = 1024; g.bseg = 0;
            pg8::Order<1> so; so.init(l == DEPTH - 1 ? NLAT : NROW, 2048, gridDim.x, blockIdx.x);
            pg8::EpiBf16 e; e.O = (bf16_t*)(ws + WS_PQ); e.ldc = 2048; e.ncols = 2048; e.oscale = 1.0f;
            pg8::gemm_phase<0>(lds, g, so, e, 4); SEAM(); PT1(10);
        }
        if (IN(gb + 11)) { PT0(); phase_peer_select(p, l, lds); SEAM(); PT1(11); }
        if (IN(gb + 12)) { PT0(); phase_peer_uv<0>(p, l, lds, outp, ctxr); SEAM(); PT1(12); }
        if (IN(gb + 13)) { PT0(); phase_peer_w(p, l); SEAM(); PT1(13); }
        if (IN(gb + 14)) { PT0(); phase_peer_uv<1>(p, l, lds, outp, ctxr); SEAM(); PT1(14); }
    }
    if (RPROBE && blockIdx.x == 0) { __syncthreads(); const unsigned long long acc_t = *(LAS unsigned long long*)(ldsc + 512); const unsigned long long t0 = __builtin_amdgcn_s_memrealtime(); while (__builtin_amdgcn_s_memrealtime() - t0 < acc_t) __builtin_amdgcn_s_sleep(16); }
    if (PROBE_MASK && blockIdx.x == 0) { const unsigned long long t0 = __builtin_amdgcn_s_memrealtime(); while (__builtin_amdgcn_s_memrealtime() - t0 < pr_acc * PROBE_MULT) __builtin_amdgcn_s_sleep(16); }
#undef IN
#undef SEAM
}

#ifndef MK_LAUNCHES
#define MK_LAUNCHES 0
#endif
extern "C" void kernel_launch(void* const* d_in, const int* in_sizes, int n_in, void* d_out, int out_size, void* d_ws, size_t ws_size, hipStream_t stream) {
    static int grid = 0;
    if (grid == 0) {
        if (n_in != 29 || in_sizes[0] != NLAT * D || out_size != NLAT * D || ws_size < WS_END) {
            fprintf(stderr, "kernel_launch: unexpected problem (n_in %d, in0 %d, out %d, ws %zu, need %zu); nothing launched\n", n_in, n_in > 0 ? in_sizes[0] : -1, out_size, ws_size, (size_t)WS_END); grid = -1; return; }
        int dev = 0, cus = 0, per_cu = 0;
        if (hipGetDevice(&dev) != hipSuccess || hipDeviceGetAttribute(&cus, hipDeviceAttributeMultiprocessorCount, dev) != hipSuccess) { grid = -1; return; }
        if (hipFuncSetAttribute((const void*)hybrid_fwd, hipFuncAttributeMaxDynamicSharedMemorySize, LDS_BYTES) != hipSuccess) { fprintf(stderr, "kernel_launch: hipFuncSetAttribute failed\n"); grid = -1; return; }
        if (hipOccupancyMaxActiveBlocksPerMultiprocessor(&per_cu, (const void*)hybrid_fwd, 512, LDS_BYTES) != hipSuccess || per_cu < 1) { fprintf(stderr, "kernel_launch: occupancy query says %d\n", per_cu); grid = -1; return; }
        (void)hipGetLastError();
        grid = cus;
    }
    if (grid < 0) return;
    (void)hipMemsetAsync((char*)d_ws + WS_CTL, 0, 65536, stream);
    Params p{};
    for (int i = 0; i < 29; ++i) p.in[i] = (const float*)d_in[i];
    p.out = (float*)d_out; p.ws = (unsigned char*)d_ws; p.pad0 = 0;
#if MK_LAUNCHES == 0
    p.gp_lo = 0; p.gp_hi = NGPH; p.use_bar = 1;
    hipLaunchKernelGGL(hybrid_fwd, dim3(grid), dim3(512), LDS_BYTES, stream, p);
#else
    p.use_bar = 0;
    for (int gp = 0; gp < NGPH; ++gp) { p.gp_lo = gp; p.gp_hi = gp + 1; hipLaunchKernelGGL(hybrid_fwd, dim3(grid), dim3(512), LDS_BYTES, stream, p); }
#endif
}
```

```cpp
#include <hip/hip_runtime.h>
#include <stdint.h>
#include <stdio.h>

#define DBG_ZERO 0
#define PROBE_MASK 0
#define PROBE_MULT 1
#define RPROBE 0
#define LAS __attribute__((address_space(3)))
#define DI __device__ __forceinline__
#define GAS __attribute__((address_space(1)))
typedef unsigned short bf16_t;
typedef short bf16x8 __attribute__((ext_vector_type(8)));
typedef float f32x4 __attribute__((ext_vector_type(4)));
typedef float f32x16 __attribute__((ext_vector_type(16)));
typedef unsigned u32x4 __attribute__((ext_vector_type(4)));
typedef unsigned u32x2 __attribute__((ext_vector_type(2)));

constexpr int D = 1024, NB = 2, S = 16384, LC = 256, DEPTH = 4;
constexpr int NLAT = NB * S;
constexpr int NROW = NLAT + NB * LC;
constexpr int PW = 8480;
constexpr int C_KA = 0, C_VA = 128, C_KB = 256, C_VB = 768, C_KC = 1280, C_VC = 1792, C_AC = 2816, C_QA = 2848, C_QB = 3360, C_QC = 3872, C_RC = 4384, C_GT = 5408;
constexpr int TOKB = S + LC;
constexpr int VTR = 1664;
constexpr int NCH = 260;
constexpr float EPS = 1e-6f;
constexpr float LOG2E = 1.4426950408889634f;
constexpr float GT8_SCALE = 16.0f;
constexpr float O8_SCALE = 8.0f, WO8_SCALE = 64.0f;
constexpr float H8_SCALE = 8.0f, WIN8_SCALE = 64.0f;
constexpr int NPH = 15;
constexpr int NGPH = 1 + DEPTH * NPH;

constexpr size_t WS_CTL = 0;
constexpr size_t WS_MOD = 65536;
constexpr size_t WS_CTX = WS_MOD + 512 * 1024;
constexpr size_t WS_WIN = WS_CTX + 2 * 1024 * 1024;
constexpr size_t WS_WO = WS_WIN + (size_t)8704 * 1024 * 2;
constexpr size_t WS_WOUT = WS_WO + (size_t)3 * 1024 * 1024 * 2;
constexpr size_t WS_WPQ = WS_WOUT + (size_t)1024 * 1024 * 2;
constexpr size_t WS_SUBK = WS_WPQ + (size_t)2048 * 1024 * 2;
constexpr size_t WS_PU = WS_SUBK + 512 * 1024;
constexpr size_t WS_PV = WS_PU + (size_t)16384 * 1024 * 2;
constexpr size_t WS_PROJ = WS_PV + (size_t)16384 * 1024 * 2;
constexpr size_t WS_VT = WS_PROJ + (size_t)NROW * PW * 2;
constexpr size_t WS_DEC = WS_VT + (size_t)NB * VTR * TOKB * 2;
constexpr size_t WS_ST = WS_DEC + (size_t)16 * NCH * 128 * 4;
constexpr size_t WS_TU = WS_ST + (size_t)16 * NCH * 32768 * 2;
constexpr size_t WS_TV = WS_TU + (size_t)8 * 1024 * 1024;
constexpr size_t WS_WO8 = WS_TV + (size_t)8 * 1024 * 1024;
constexpr size_t WS_END = WS_WO8 + (size_t)3 * 1024 * 1024;
constexpr size_t WS_O8 = WS_PU;
constexpr size_t WS_H = WS_ST;
constexpr size_t WS_M = WS_ST + (size_t)NROW * 2048 * 2;
constexpr size_t WS_XB = WS_ST + (size_t)NROW * 3072 * 2;
constexpr size_t WS_H2 = WS_VT;
constexpr size_t WS_PQ = WS_ST;
constexpr size_t WS_PART = WS_ST;
constexpr size_t WS_PIDX = WS_PROJ;
constexpr size_t WS_PG = WS_PROJ + (size_t)NROW * 128 * 4;
constexpr size_t WS_H2F8 = WS_PROJ + (size_t)64 * 1024 * 1024;
constexpr float H2F8_SCALE = 8.0f;
constexpr size_t WS_W8 = WS_H2F8 + (size_t)NROW * 2048;
constexpr float W8_SCALE = 16.0f;
static_assert(WS_M + (size_t)NROW * 1024 * 2 <= WS_END && (size_t)NROW * 1024 * 2 <= (size_t)NB * VTR * TOKB * 2 && WS_END <= ((size_t)1 << 30), "workspace map");

constexpr int LDS_CTRL = 1024;
constexpr int LDS_BYTES = 163840;
constexpr int LDS_BARW = 0;

DI float bf_lo(unsigned w) { return __uint_as_float(w << 16); }
DI float bf_hi(unsigned w) { return __uint_as_float(w & 0xffff0000u); }
DI float bf2f(bf16_t b) { return __uint_as_float((unsigned)b << 16); }
typedef __bf16 bf16v2 __attribute__((ext_vector_type(2)));
DI unsigned pack2(float lo, float hi) { bf16v2 v; v.x = (__bf16)lo; v.y = (__bf16)hi; return __builtin_bit_cast(unsigned, v); }
DI void unpack4_fp8(unsigned w, float& a, float& b, float& c, float& d) { const auto lo = __builtin_amdgcn_cvt_pk_f32_fp8((int)w, false), hi = __builtin_amdgcn_cvt_pk_f32_fp8((int)w, true); a = lo[0]; b = lo[1]; c = hi[0]; d = hi[1]; }
DI unsigned pack4_fp8(float a, float b, float c, float d) { int r = 0; r = __builtin_amdgcn_cvt_pk_fp8_f32(a, b, r, false); r = __builtin_amdgcn_cvt_pk_fp8_f32(c, d, r, true); return (unsigned)r; }
DI bf16_t f2bf(float f) { return (bf16_t)(pack2(f, 0.f) & 0xffffu); }
DI int otid() { int t = threadIdx.x; asm volatile("" : "+v"(t)); return t; }
DI float shx(float v, int mask) { return __int_as_float(__builtin_amdgcn_ds_bpermute(((otid() & 63) ^ mask) << 2, __float_as_int(v))); }
#define DPPF(v, ctrl) __int_as_float(__builtin_amdgcn_update_dpp(0, __float_as_int(v), (ctrl), 0xf, 0xf, true))
DI float sum8(float v) { v += DPPF(v, 0xB1); v += DPPF(v, 0x4E); v += DPPF(v, 0x141); return v; }
DI float wave_sum(float v) { v = sum8(v); v += DPPF(v, 0x140); v += shx(v, 16); v += shx(v, 32); return v; }
template <class T> DI T* opq(T* ptr) { const unsigned slo = (unsigned)(uintptr_t)ptr, shi = (unsigned)((uintptr_t)ptr >> 32); unsigned lo, hi;
    asm volatile("v_mov_b32 %0, %2\n\tv_mov_b32 %1, %3" : "=v"(lo), "=v"(hi) : "s"(slo), "s"(shi));
    lo = (unsigned)__builtin_amdgcn_readfirstlane((int)lo); hi = (unsigned)__builtin_amdgcn_readfirstlane((int)hi); return (T*)(GAS T*)(((uintptr_t)hi << 32) | (uintptr_t)lo); }
DI float sigmoidf_(float x) { return __builtin_amdgcn_rcpf(1.0f + __builtin_amdgcn_exp2f(x * -LOG2E)); }
DI f32x16 zero16() { f32x16 z; for (int i = 0; i < 16; ++i) z[i] = 0.f; return z; }
#define MFMA32(a, b, c) __builtin_amdgcn_mfma_f32_32x32x16_bf16((a), (b), (c), 0, 0, 0)
DI int pi32(int i) { return (i & 0x13) | ((i & 8) >> 1) | ((i & 4) << 1); }

#define XB_TMO      128
#define XB_XCNT(j)  (256  + 64 * (j))
#define XB_XSUB(j)  (1280 + 64 * (j))
#define XB_XGEN(j)  (2304 + 64 * (j))
#define XB_TOP      3328
#define XB_TOPGEN   3392
#define XCD_BAR_WORDS 3456
#define XB_SPIN_CAP (1u << 22)
DI unsigned xb_ld(unsigned* p)              { return __hip_atomic_load(p, __ATOMIC_RELAXED, __HIP_MEMORY_SCOPE_AGENT); }
DI unsigned xb_add(unsigned* p, unsigned v) { return __hip_atomic_fetch_add(p, v, __ATOMIC_RELAXED, __HIP_MEMORY_SCOPE_AGENT); }
DI unsigned xb_xcc_id() { return (unsigned)__builtin_amdgcn_s_getreg((3 << 11) | 20) & 0xFu; }
#define XB_SPIN(cond, bar) do { unsigned _sp = 0; while (cond) { __builtin_amdgcn_s_sleep(1); \
    if ((++_sp & 255u) == 0u) { if (xb_ld(&(bar)[XB_TMO])) break; if (_sp > XB_SPIN_CAP) { atomicAdd(&(bar)[XB_TMO], 1u); break; } } } } while (0)
struct XcdBarrier { unsigned* bar; unsigned x; volatile LAS unsigned* st; };
DI XcdBarrier xcd_barrier_post(unsigned* bar, volatile LAS unsigned* st) {
    XcdBarrier b; b.bar = bar; b.x = xb_xcc_id(); b.st = st;
    if (threadIdx.x == 0) (void)xb_add(&bar[XB_XCNT(b.x)], 1u);
    return b;
}
DI void xcd_barrier_complete(unsigned* bar, unsigned x, unsigned& nloc, unsigned& nx) {
    const unsigned G = gridDim.x * gridDim.y * gridDim.z;
    unsigned sum, cnt, mine, sp = 0u;
    for (;;) {
        sum = 0u; cnt = 0u; mine = 0u;
#pragma unroll
        for (unsigned j = 0; j < 16; ++j) { const unsigned c = xb_ld(&bar[XB_XCNT(j)]); sum += c; cnt += (c > 0u) ? 1u : 0u; mine = (j == x) ? c : mine; }
        if (sum == G) break;
        __builtin_amdgcn_s_sleep(1);
        if ((++sp & 255u) == 0u) { if (xb_ld(&bar[XB_TMO])) break; if (sp > XB_SPIN_CAP) { atomicAdd(&bar[XB_TMO], 1u); break; } }
    }
    nloc = mine > 0u ? mine : 1u; nx = cnt > 0u ? cnt : 1u;
}
DI void xcd_barrier(const XcdBarrier& b) {
    asm volatile("s_waitcnt vmcnt(0)" ::: "memory");
    __syncthreads();
    if (threadIdx.x == 0) {
        unsigned* bar = b.bar;
        __builtin_amdgcn_s_waitcnt(0);
        unsigned nloc = b.st[0], nx = b.st[1];
        if (nloc == 0u) { xcd_barrier_complete(bar, b.x, nloc, nx); b.st[0] = nloc; b.st[1] = nx; }
        const unsigned old = xb_add(&bar[XB_XSUB(b.x)], 1u);
        const unsigned gen = old / nloc;
        if (old + 1u == (gen + 1u) * nloc) {
            __builtin_amdgcn_fence(__ATOMIC_RELEASE, "agent");
            asm volatile("s_waitcnt vmcnt(0)" ::: "memory");
            const unsigned og = xb_add(&bar[XB_TOP], 1u);
            const unsigned tg = og / nx;
            if (og + 1u == (tg + 1u) * nx) xb_add(&bar[XB_TOPGEN], 1u);
            else XB_SPIN(xb_ld(&bar[XB_TOPGEN]) == tg, bar);
            __builtin_amdgcn_fence(__ATOMIC_ACQUIRE, "agent");
            xb_add(&bar[XB_XGEN(b.x)], 1u);
            asm volatile("s_waitcnt vmcnt(0)" ::: "memory");
        } else {
            XB_SPIN(xb_ld(&bar[XB_XGEN(b.x)]) == gen, bar);
            __builtin_amdgcn_fence(__ATOMIC_ACQUIRE, "agent");
            asm volatile("s_waitcnt vmcnt(0)" ::: "memory");
        }
    }
    __syncthreads();
}

struct Params {
    const float* in[29];
    float* out;
    unsigned char* ws;
    int gp_lo, gp_hi;
    int use_bar, pad0;
};
extern __shared__ __attribute__((aligned(16))) unsigned char lds_raw[];
constexpr int LDS_PTRS = LDS_BARW + 64;
DI const float* pin_ld(int i) { const LAS unsigned* t = (const LAS unsigned*)((LAS unsigned char*)lds_raw + LDS_PTRS) + 2 * i;
    const unsigned lo = (unsigned)__builtin_amdgcn_readfirstlane((int)t[0]), hi = (unsigned)__builtin_amdgcn_readfirstlane((int)t[1]); return (const float*)(GAS const float*)(((uintptr_t)hi << 32) | (uintptr_t)lo); }
#define PIN(i) pin_ld(i)
DI unsigned long long rp_now() { return RPROBE ? __builtin_amdgcn_s_memrealtime() : 0ull; }
DI void rp_add(int id, unsigned long long t0) { if (RPROBE != 0 && RPROBE == id && threadIdx.x == 0) { LAS unsigned long long* a = (LAS unsigned long long*)((LAS unsigned char*)lds_raw + 512); *a += __builtin_amdgcn_s_memrealtime() - t0; } }
DI unsigned char* ws_ptr() {
    typedef __attribute__((address_space(4))) const unsigned char* kptr;
    kptr ka = (kptr)__builtin_amdgcn_kernarg_segment_ptr();
    unsigned off = (unsigned)__builtin_offsetof(Params, ws); asm volatile("" : "+s"(off));
    const unsigned long long v = *(__attribute__((address_space(4))) const unsigned long long*)(ka + off);
    return (unsigned char*)(GAS unsigned char*)v; }
enum { I_X = 0, I_C, I_CTX, I_CCTX, I_WMOD, I_BMOD, I_NORM1, I_NORM2, I_WIN, I_QNA, I_KNA, I_SINKA, I_QNB, I_KNB, I_RPB, I_WA2F, I_BAF, I_WA2B, I_BAB, I_GNC, I_WOA, I_WOB, I_WOC, I_WOUT, I_WPQ, I_PQG, I_SUBK, I_PU, I_PV };

namespace pg8 {
constexpr int BM = 256, BK = 64, HALF = 128, HTB = HALF * BK * 2, STAGE_BYTES = 8 * HTB, NXCD = 8, WGM = 8;
DI int lds_byte(int r, int c) { const int st = (r >> 4) * 2 + (c >> 5), rr = r & 15, cc = c & 31, ob = rr * 64 + cc * 2; return st * 1024 + (ob ^ (((ob >> 9) & 1) << 5)); }
DI void stage_rc(int b, int& R, int& C) { const int st = b / 1024, sb = b % 1024, swz = sb ^ (((sb >> 9) & 1) << 5); R = (st >> 1) * 16 + swz / 64; C = (st & 1) * 32 + (swz % 64) / 2; }
DI int perm32(int rho) { const int n = rho >> 4, i = rho & 15; return 8 * (i >> 2) + 4 * n + (i & 3); }
struct Unit { int pm, pn, seg; };
struct Gemm { const bf16_t* A; const bf16_t* Bt; int lda, ldb, K; int ac0, ac1, ac2, ac3; int k0, k1, k2, k3; size_t bseg; };
DI int gemm_kseg(const Gemm& g, int seg) { const int k = seg == 0 ? g.k0 : (seg == 1 ? g.k1 : (seg == 2 ? g.k2 : g.k3)); return k ? k : g.K; }
DI int gemm_acol(const Gemm& g, int seg) { return seg == 0 ? g.ac0 : (seg == 1 ? g.ac1 : (seg == 2 ? g.ac2 : g.ac3)); }
template <int NSEG> struct Order {
    int nM, nN, nwg, G, c;
    DI void init(int M, int N, int G_, int c_) { nM = M / BM; nN = N / BM; nwg = nM * nN; G = G_; c = c_; }
    DI bool next(int i, Unit& u) const {
        const int t = i / NSEG; u.seg = i - t * NSEG;
        const long L = (long)t * G + c; if (L >= nwg) return false;
        int wgid = (int)L; { const int q = nwg / NXCD, r = nwg % NXCD, xcd = wgid % NXCD, off = wgid / NXCD; wgid = (xcd < r ? xcd * (q + 1) : r * (q + 1) + (xcd - r) * q) + off; }
        const int nig = WGM * nN, gid = wgid / nig, fm = gid * WGM, gsz = (nM - fm) < WGM ? (nM - fm) : WGM;
        u.pm = fm + ((wgid % nig) % gsz); u.pn = (wgid % nig) / gsz; return true;
    }
};
DI unsigned cvt_pk_bf16(float lo, float hi) { unsigned r; asm volatile("v_cvt_pk_bf16_f32 %0, %1, %2" : "=v"(r) : "v"(lo), "v"(hi)); return r; }

template <int FP8, class Epi, class Sched>
DI void gemm_phase(LAS unsigned char* lds, const Gemm g, const Sched& S, const Epi& E, int rpid) {
    const int tid = otid(), wid = __builtin_amdgcn_readfirstlane(tid >> 6), lane = tid & 63, wr = wid >> 2, wc = wid & 3, fr = lane & 15, fq = lane >> 4;
    unsigned voffA[2], voffB[2];
#pragma unroll
    for (int i = 0; i < 2; ++i) { int R, C; stage_rc(tid * 16 + i * 8192, R, C); const int Rb = Epi::PERM ? ((R & ~31) + perm32(R & 31)) : R;
        voffA[i] = (unsigned)(R * g.lda + C) * 2u; voffB[i] = (unsigned)(Rb * g.ldb + C) * 2u; }
    const size_t kstep = (size_t)(BK * 2);
    const size_t hstepA = (size_t)HALF * g.lda * 2, hstepB = (size_t)HALF * g.ldb * 2;
    const unsigned ldsw = (unsigned)wid * 1024u;
    const int aoff = lds_byte(wr * 64 + fr, fq * 8), boff = lds_byte(wc * 32 + fr, fq * 8);
#define PG8_SA(b, h) (((b) * 2 + (h)) * HTB)
#define PG8_SB(b, h) ((4 + (b) * 2 + (h)) * HTB)
#define PG8_STAGE(bufoff, gbase, voff) do { _Pragma("unroll") for (int _i = 0; _i < 2; ++_i) \
        __builtin_amdgcn_global_load_lds((const unsigned*)((const char*)(gbase) + (voff)[_i]), (LAS unsigned*)(lds + (bufoff) + ldsw + _i * 8192), 16, 0, 0); } while (0)
#define PG8_FRAG(off) (*(const LAS bf16x8*)(lds + (off)))
#define PG8_LDA(dst, b, h) do { _Pragma("unroll") for (int m = 0; m < 4; ++m) { if (FP8) dst##8[m] = __builtin_shufflevector(__builtin_bit_cast(i32x4_, PG8_FRAG(PG8_SA(b, h) + aoff + m * 2048)), __builtin_bit_cast(i32x4_, PG8_FRAG(PG8_SA(b, h) + aoff + m * 2048 + 1024)), 0, 1, 2, 3, 4, 5, 6, 7); \
        else { _Pragma("unroll") for (int k = 0; k < 2; ++k) dst[m][k] = PG8_FRAG(PG8_SA(b, h) + aoff + m * 2048 + k * 1024); } } } while (0)
#define PG8_LDB(dst, b, h) do { _Pragma("unroll") for (int n = 0; n < 2; ++n) { if (FP8) dst##8[n] = __builtin_shufflevector(__builtin_bit_cast(i32x4_, PG8_FRAG(PG8_SB(b, h) + boff + n * 2048)), __builtin_bit_cast(i32x4_, PG8_FRAG(PG8_SB(b, h) + boff + n * 2048 + 1024)), 0, 1, 2, 3, 4, 5, 6, 7); \
        else { _Pragma("unroll") for (int k = 0; k < 2; ++k) dst[n][k] = PG8_FRAG(PG8_SB(b, h) + boff + n * 2048 + k * 1024); } } } while (0)
#define PG8_MMA(ai, bj, At, Bt) do { __builtin_amdgcn_s_setprio(1); _Pragma("unroll") for (int m = 0; m < 4; ++m) _Pragma("unroll") for (int n = 0; n < 2; ++n) { \
        if (FP8) asm volatile("v_mfma_scale_f32_16x16x128_f8f6f4 %0, %1, %2, %0, %3, %3 op_sel_hi:[0,0,0]" : "+v"(acc[ai][bj][m][n]) : "v"(Bt##8[n]), "v"(At##8[m]), "v"(sc127));   \
        else { _Pragma("unroll") for (int k = 0; k < 2; ++k) acc[ai][bj][m][n] = __builtin_amdgcn_mfma_f32_16x16x32_bf16(Bt[n][k], At[m][k], acc[ai][bj][m][n], 0, 0, 0); } } \
        __builtin_amdgcn_s_setprio(0); } while (0)
#define PG8_WAIT_V(n) asm volatile("s_waitcnt vmcnt(" #n ")" ::: "memory")
#define PG8_WAIT_L(n) asm volatile("s_waitcnt lgkmcnt(" #n ")" ::: "memory")
#define PG8_BAR __builtin_amdgcn_s_barrier()
#define PG8_SCHED __builtin_amdgcn_sched_barrier(0)
#define PG8_APTR(u) ((const char*)g.A + ((size_t)(u).pm * BM * g.lda + (size_t)gemm_acol(g, (u).seg)) * 2)
#define PG8_BPTR(u) ((const char*)g.Bt + ((size_t)(u).seg * g.bseg + (size_t)(u).pn * BM * g.ldb) * 2)
    Unit cur, nxt; int ui = 0;
    if (!S.next(0, cur)) return;
    f32x4 acc[2][2][4][2];
#pragma unroll
    for (int a = 0; a < 2; ++a)
#pragma unroll
        for (int b = 0; b < 2; ++b)
#pragma unroll
            for (int m = 0; m < 4; ++m)
#pragma unroll
                for (int n = 0; n < 2; ++n) acc[a][b][m][n] = (f32x4){0.f, 0.f, 0.f, 0.f};
    typedef int i32x4_ __attribute__((ext_vector_type(4))); typedef int i32x8_ __attribute__((ext_vector_type(8)));
    bf16x8 At[4][2], B0[2][2], B1[2][2];
    i32x8_ At8[4], B08[2], B18[2];
    int sc127 = 127; asm volatile("" : "+v"(sc127));
    const char* cA = PG8_APTR(cur); const char* cB = PG8_BPTR(cur);
    PG8_STAGE(PG8_SB(0, 0), cB, voffB); PG8_STAGE(PG8_SA(0, 0), cA, voffA); PG8_STAGE(PG8_SB(0, 1), cB + hstepB, voffB); PG8_STAGE(PG8_SA(0, 1), cA + hstepA, voffA);
    if (wr == 1) PG8_BAR;
    PG8_WAIT_V(4); PG8_BAR;
    PG8_STAGE(PG8_SB(1, 0), cB + kstep, voffB); PG8_STAGE(PG8_SA(1, 0), cA + kstep, voffA); PG8_STAGE(PG8_SB(1, 1), cB + hstepB + kstep, voffB);
    PG8_WAIT_V(6); PG8_BAR;
    for (;;) {
        const bool has_next = S.next(ui + 1, nxt);
        const int nt = gemm_kseg(g, cur.seg) / BK;
        const char* nA = has_next ? PG8_APTR(nxt) : cA; const char* nB = has_next ? PG8_BPTR(nxt) : cB;
        for (int t = 0; t < nt; t += 2) {
            const bool last = (t == nt - 2);
            const char* a1 = cA + (size_t)(t + 1) * kstep;
            const char* a2 = last ? nA : cA + (size_t)(t + 2) * kstep; const char* b2 = last ? nB : cB + (size_t)(t + 2) * kstep;
            const char* a3 = a2 + kstep; const char* b3 = b2 + kstep;
            PG8_LDB(B0, 0, 0); PG8_SCHED; PG8_LDA(At, 0, 0); PG8_STAGE(PG8_SA(1, 1), a1 + hstepA, voffA);
            PG8_WAIT_L(8); PG8_BAR; PG8_WAIT_L(0); PG8_MMA(0, 0, At, B0); PG8_BAR; PG8_SCHED;
            PG8_LDB(B1, 0, 1); PG8_STAGE(PG8_SB(0, 0), b2, voffB);
            PG8_BAR; PG8_WAIT_L(0); PG8_MMA(0, 1, At, B1); PG8_BAR;
            PG8_LDA(At, 0, 1); PG8_STAGE(PG8_SA(0, 0), a2, voffA);
            PG8_BAR; PG8_WAIT_L(0); PG8_MMA(1, 0, At, B0); PG8_BAR; PG8_SCHED;
            PG8_STAGE(PG8_SB(0, 1), b2 + hstepB, voffB);
            PG8_WAIT_V(6); PG8_BAR; PG8_MMA(1, 1, At, B1); PG8_BAR;
            PG8_LDB(B0, 1, 0); PG8_SCHED; PG8_LDA(At, 1, 0); PG8_STAGE(PG8_SA(0, 1), a2 + hstepA, voffA);
            PG8_WAIT_L(8); PG8_BAR; PG8_WAIT_L(0); PG8_MMA(0, 0, At, B0); PG8_BAR; PG8_SCHED;
            PG8_LDB(B1, 1, 1); PG8_STAGE(PG8_SB(1, 0), b3, voffB);
            PG8_BAR; PG8_WAIT_L(0); PG8_MMA(0, 1, At, B1); PG8_BAR;
            PG8_LDA(At, 1, 1); PG8_STAGE(PG8_SA(1, 0), a3, voffA);
            PG8_BAR; PG8_WAIT_L(0); PG8_MMA(1, 0, At, B0); PG8_BAR; PG8_SCHED;
            PG8_STAGE(PG8_SB(1, 1), b3 + hstepB, voffB);
            PG8_WAIT_V(6); PG8_BAR; PG8_MMA(1, 1, At, B1); PG8_BAR;
        }
        if (FP8) asm volatile("s_nop 15\n\ts_nop 15" ::: "memory");
        { const unsigned long long rt = rp_now(); E(acc, cur, wr, wc, fr, fq); if (RPROBE) asm volatile("s_waitcnt vmcnt(0)" ::: "memory"); rp_add(rpid, rt); }
        if (!has_next) break;
#pragma unroll
        for (int a = 0; a < 2; ++a)
#pragma unroll
            for (int b = 0; b < 2; ++b)
#pragma unroll
                for (int m = 0; m < 4; ++m)
#pragma unroll
                    for (int n = 0; n < 2; ++n) acc[a][b][m][n] = (f32x4){0.f, 0.f, 0.f, 0.f};
        cur = nxt; cA = nA; cB = nB; ++ui;
    }
    PG8_WAIT_V(0);
    if (wr == 0) PG8_BAR;
    PG8_BAR;
#undef PG8_SA
#undef PG8_SB
#undef PG8_STAGE
#undef PG8_FRAG
#undef PG8_LDA
#undef PG8_LDB
#undef PG8_MMA
#undef PG8_WAIT_V
#undef PG8_WAIT_L
#undef PG8_BAR
#undef PG8_SCHED
#undef PG8_APTR
#undef PG8_BPTR
}

struct EpiBf16 {
    static constexpr bool PERM = true;
    bf16_t* O; int ldc, ncols, gt0; float oscale;
    DI void operator()(const f32x4 (&acc)[2][2][4][2], const Unit& u, int wr, int wc, int fr, int fq) const {
        const int row0 = u.pm * BM + wr * 64 + fr, col0 = u.pn * BM + wc * 32 + 8 * fq;
#pragma unroll
        for (int ai = 0; ai < 2; ++ai)
#pragma unroll
            for (int m = 0; m < 4; ++m) { bf16_t* rowp = O + (size_t)(row0 + ai * HALF + m * 16) * ldc + col0;
#pragma unroll
                for (int bj = 0; bj < 2; ++bj) { const f32x4 v0 = acc[ai][bj][m][0] * oscale, v1 = acc[ai][bj][m][1] * oscale;
                    u32x4 w; w.x = cvt_pk_bf16(v0[0], v0[1]); w.y = cvt_pk_bf16(v0[2], v0[3]); w.z = cvt_pk_bf16(v1[0], v1[1]); w.w = cvt_pk_bf16(v1[2], v1[3]);
                    const int c = col0 + bj * HALF;
                    if (c >= gt0) { if (c < ncols) { const f32x4 a = v0 * GT8_SCALE, b = v1 * GT8_SCALE; const float L = 27.0f * GT8_SCALE;
                            u32x2 w8; w8.x = pack4_fp8(fminf(fmaxf(a[0], -L), L), fminf(fmaxf(a[1], -L), L), fminf(fmaxf(a[2], -L), L), fminf(fmaxf(a[3], -L), L));
                            w8.y = pack4_fp8(fminf(fmaxf(b[0], -L), L), fminf(fmaxf(b[1], -L), L), fminf(fmaxf(b[2], -L), L), fminf(fmaxf(b[3], -L), L));
                            *(u32x2*)((unsigned char*)(rowp - col0) + gt0 * 2 + (c - gt0)) = w8; } }
                    else if (c < ncols) *(u32x4*)(rowp + bj * HALF) = w; } }
    }
};
struct EpiMerge {
    static constexpr bool PERM = true;
    const bf16_t* proj; bf16_t* Mo; float oscale;
    DI void operator()(const f32x4 (&acc)[2][2][4][2], const Unit& u, int wr, int wc, int fr, int fq) const {
        const int row0 = u.pm * BM + wr * 64 + fr, col0 = u.pn * BM + wc * 32 + 8 * fq;
        const int gsel = u.seg;
        const unsigned char* gbase = (const unsigned char*)proj + (size_t)row0 * (PW * 2) + C_GT * 2 + gsel * 1024 + col0;
        bf16_t* mbase = Mo + (size_t)row0 * 1024 + col0;
        u32x2 gw[2][2][2]; u32x4 pw[2][2][2];
        auto ld = [&](int qd, int b) { const int ai = qd >> 1, mh = qd & 1;
#pragma unroll
            for (int m2 = 0; m2 < 2; ++m2)
#pragma unroll
                for (int bj = 0; bj < 2; ++bj) { const int rr = ai * HALF + (mh * 2 + m2) * 16;
                    gw[b][m2][bj] = *(const u32x2*)(gbase + (size_t)rr * (PW * 2) + bj * HALF);
                    pw[b][m2][bj] = u.seg > 0 ? *(const u32x4*)(mbase + (size_t)rr * 1024 + bj * HALF) : (u32x4){0u, 0u, 0u, 0u}; } };
        ld(0, 0);
#pragma unroll
        for (int qd = 0; qd < 4; ++qd) {
            const int ai = qd >> 1, mh = qd & 1, b = qd & 1;
            if (qd + 1 < 4) ld(qd + 1, b ^ 1);
#pragma unroll
            for (int m2 = 0; m2 < 2; ++m2)
#pragma unroll
                for (int bj = 0; bj < 2; ++bj) { const int m = mh * 2 + m2;
                    const u32x4 p4 = pw[b][m2][bj];
                    float gq[8]; unpack4_fp8(gw[b][m2][bj].x, gq[0], gq[1], gq[2], gq[3]); unpack4_fp8(gw[b][m2][bj].y, gq[4], gq[5], gq[6], gq[7]);
                    f32x4 v0 = acc[ai][bj][m][0] * oscale, v1 = acc[ai][bj][m][1] * oscale;
#pragma unroll
                    for (int i = 0; i < 4; ++i) { v0[i] *= sigmoidf_(gq[i] * (1.0f / GT8_SCALE)); v1[i] *= sigmoidf_(gq[4 + i] * (1.0f / GT8_SCALE)); }
                    if (DBG_ZERO & (1 << gsel)) { v0 *= 0.f; v1 *= 0.f; }
                    v0[0] += bf_lo(p4.x); v0[1] += bf_hi(p4.x); v0[2] += bf_lo(p4.y); v0[3] += bf_hi(p4.y); v1[0] += bf_lo(p4.z); v1[1] += bf_hi(p4.z); v1[2] += bf_lo(p4.w); v1[3] += bf_hi(p4.w);
                    u32x4 w; w.x = cvt_pk_bf16(v0[0], v0[1]); w.y = cvt_pk_bf16(v0[2], v0[3]); w.z = cvt_pk_bf16(v1[0], v1[1]); w.w = cvt_pk_bf16(v1[2], v1[3]);
                    *(u32x4*)(mbase + (size_t)(ai * HALF + m * 16) * 1024 + bj * HALF) = w;
                }
        }
    }
};
struct EpiResid {
    static constexpr bool PERM = true;
    const float* xin_f; const bf16_t* xin_b; float* xout_f; bf16_t* xout_b; const float* gate;
    DI void put(const f32x4& o0, const f32x4& o1, size_t eo) const {
        if (xout_b) *(u32x4*)(xout_b + eo) = (u32x4){pack2(o0[0], o0[1]), pack2(o0[2], o0[3]), pack2(o1[0], o1[1]), pack2(o1[2], o1[3])};
        else { *(f32x4*)(xout_f + eo) = o0; *(f32x4*)(xout_f + eo + 4) = o1; } }
    DI void operator()(const f32x4 (&acc)[2][2][4][2], const Unit& u, int wr, int wc, int fr, int fq) const {
        const int rowt = u.pm * BM, mv = rowt >> 14;
        const unsigned r0 = (unsigned)(rowt + wr * 64 + fr), colb = (unsigned)(u.pn * BM + wc * 32 + 8 * fq);
        const float* gp = gate + mv * 6144 + colb;
        f32x4 gv[2][2];
#pragma unroll
        for (int bj = 0; bj < 2; ++bj)
#pragma unroll
            for (int n = 0; n < 2; ++n) gv[bj][n] = *(const f32x4*)(gp + bj * HALF + 4 * n);
#pragma unroll
        for (int ai = 0; ai < 2; ++ai) {
            if (xin_b) {
                u32x4 xw[4][2];
#pragma unroll
                for (int m = 0; m < 4; ++m)
#pragma unroll
                    for (int bj = 0; bj < 2; ++bj) xw[m][bj] = *(const u32x4*)(xin_b + (size_t)(r0 + ai * HALF + m * 16) * 1024 + colb + bj * HALF);
#pragma unroll
                for (int m = 0; m < 4; ++m)
#pragma unroll
                    for (int bj = 0; bj < 2; ++bj) { const u32x4 w = xw[m][bj];
                        const f32x4 x0 = (f32x4){bf_lo(w.x), bf_hi(w.x), bf_lo(w.y), bf_hi(w.y)}, x1 = (f32x4){bf_lo(w.z), bf_hi(w.z), bf_lo(w.w), bf_hi(w.w)};
                        put(x0 + gv[bj][0] * acc[ai][bj][m][0], x1 + gv[bj][1] * acc[ai][bj][m][1], (size_t)(r0 + ai * HALF + m * 16) * 1024 + colb + bj * HALF); }
            } else {
#pragma unroll
                for (int mh = 0; mh < 2; ++mh) {
                    f32x4 xv[2][2][2];
#pragma unroll
                    for (int m2 = 0; m2 < 2; ++m2)
#pragma unroll
                        for (int bj = 0; bj < 2; ++bj)
#pragma unroll
                            for (int n = 0; n < 2; ++n) xv[m2][bj][n] = *(const f32x4*)(xin_f + (size_t)(r0 + ai * HALF + (mh * 2 + m2) * 16) * 1024 + colb + bj * HALF + 4 * n);
#pragma unroll
                    for (int m2 = 0; m2 < 2; ++m2)
#pragma unroll
                        for (int bj = 0; bj < 2; ++bj)
                            put(xv[m2][bj][0] + gv[bj][0] * acc[ai][bj][mh * 2 + m2][0], xv[m2][bj][1] + gv[bj][1] * acc[ai][bj][mh * 2 + m2][1], (size_t)(r0 + ai * HALF + (mh * 2 + m2) * 16) * 1024 + colb + bj * HALF);
                }
            }
        }
    }
};
}

DI f32x4 ctx_tile16(const bf16_t* A, int lda, const bf16_t* Bt, int ldb, int K, int lane) {
    const bf16_t* ap = A + (size_t)(lane & 15) * lda + 8 * (lane >> 4);
    const bf16_t* bp = Bt + (size_t)(lane & 15) * ldb + 8 * (lane >> 4);
    f32x4 acc0 = (f32x4){0.f, 0.f, 0.f, 0.f}, acc1 = acc0;
#pragma unroll 1
    for (int k = 0; k < K; k += 512) {
        bf16x8 a[16], b[16];
#pragma unroll
        for (int i = 0; i < 16; ++i) { a[i] = *(const bf16x8*)(ap + k + 32 * i); b[i] = *(const bf16x8*)(bp + k + 32 * i); }
#pragma unroll
        for (int i = 0; i < 16; i += 2) { acc0 = __builtin_amdgcn_mfma_f32_16x16x32_bf16(a[i], b[i], acc0, 0, 0, 0); acc1 = __builtin_amdgcn_mfma_f32_16x16x32_bf16(a[i + 1], b[i + 1], acc1, 0, 0, 0); }
    }
    return acc0 + acc1;
}
DI void phase_ctx_gemm(const Params& p, int l, int which, const float* xin_ctx) {
    unsigned char* const ws = ws_ptr();
    const int tid = otid(), lane = tid & 63, wid = tid >> 6;
    const bf16_t* proj = (const bf16_t*)(ws + WS_PROJ);
    bf16_t* Mo = (bf16_t*)(ws + WS_M);
    const int ncolt = which == 2 ? 128 : 64, ntile = 32 * ncolt;
    for (int wt = blockIdx.x * 8 + wid; wt < ntile; wt += gridDim.x * 8) {
        const int tr = wt / ncolt, tc = wt - tr * ncolt;
        const int r0 = NLAT + 16 * tr, c0 = 16 * tc;
        const int rowq = r0 + (lane >> 4) * 4, col = c0 + (lane & 15);
        if (which == 0) {
            f32x4 tot = (f32x4){0.f, 0.f, 0.f, 0.f};
#pragma unroll
            for (int seg = 0; seg < 3; ++seg) {
                const int acol = seg == 0 ? C_QA : (seg == 1 ? C_QB : C_RC), kk = seg == 2 ? 1024 : 512;
                const f32x4 acc = ctx_tile16(proj + (size_t)r0 * PW + acol, PW, (const bf16_t*)(ws + WS_WO) + (size_t)seg * 1024 * 1024 + (size_t)c0 * 1024, 1024, kk, lane);
#pragma unroll
                for (int q = 0; q < 4; ++q) tot[q] += sigmoidf_(__builtin_amdgcn_cvt_f32_fp8((int)((const unsigned char*)proj)[(size_t)(rowq + q) * (PW * 2) + C_GT * 2 + seg * 1024 + col], 0) * (1.0f / GT8_SCALE)) * acc[q];
            }
#pragma unroll
            for (int q = 0; q < 4; ++q) Mo[(size_t)(rowq + q) * 1024 + col] = f2bf(tot[q]);
        } else if (which == 1) {
            const f32x4 acc = ctx_tile16(Mo + (size_t)r0 * 1024, 1024, (const bf16_t*)(ws + WS_WOUT) + (size_t)c0 * 1024, 1024, 1024, lane);
            const float g1 = ((const float*)(ws + WS_MOD))[((size_t)l * 3 + 2) * 6144 + 2 * 1024 + col];
            float* xo = (float*)(ws + WS_CTX);
#pragma unroll
            for (int q = 0; q < 4; ++q) { const size_t o = (size_t)(rowq + q - NLAT) * 1024 + col; xo[o] = xin_ctx[o] + g1 * acc[q]; }
        } else {
            const f32x4 acc = ctx_tile16((const bf16_t*)(ws + WS_H2) + (size_t)r0 * 1024, 1024, (const bf16_t*)(ws + WS_WPQ) + (size_t)c0 * 1024, 1024, 1024, lane);
            bf16_t* pq = (bf16_t*)(ws + WS_PQ);
#pragma unroll
            for (int q = 0; q < 4; ++q) pq[(size_t)(rowq + q) * 2048 + col] = f2bf(acc[q]);
        }
    }
}

DI void phase_mod(const Params& p, LAS float* lds) {
    unsigned char* const ws = ws_ptr();
    const int tid = otid();
    LAS float* act = lds;
    LAS float* red = lds + 3072;
    for (int i = tid; i < 3072; i += 512) { const int v = i >> 10, k = i & 1023; const float x = v < 2 ? PIN(I_C)[v * 1024 + k] : PIN(I_CCTX)[k]; act[i] = x / (1.0f + __expf(-x)); }
    __syncthreads();
    float* mod = (float*)(ws + WS_MOD);
    const int c4 = tid & 7, kg = tid >> 3;
    for (int cb = blockIdx.x; cb < 768; cb += gridDim.x) {
        const int l = cb / 192, col0 = (cb - l * 192) * 32;
        const float* W = PIN(I_WMOD) + (size_t)l * 1024 * 6144 + col0 + 4 * c4;
        f32x4 a0 = (f32x4){0.f, 0.f, 0.f, 0.f}, a1 = a0, a2 = a0;
#pragma unroll 8
        for (int k = kg; k < 1024; k += 64) { const f32x4 w = *(const f32x4*)(W + (size_t)k * 6144); a0 += w * act[k]; a1 += w * act[1024 + k]; a2 += w * act[2048 + k]; }
        *(LAS f32x4*)(red + (kg * 3 + 0) * 32 + 4 * c4) = a0; *(LAS f32x4*)(red + (kg * 3 + 1) * 32 + 4 * c4) = a1; *(LAS f32x4*)(red + (kg * 3 + 2) * 32 + 4 * c4) = a2;
        __syncthreads();
        if (tid < 96) { const int v = tid >> 5, cc = tid & 31; float sm = 0.f;
#pragma unroll 16
            for (int q = 0; q < 64; ++q) sm += red[(q * 3 + v) * 32 + cc];
            const int cj = col0 + cc;
            mod[((size_t)l * 3 + v) * 6144 + cj] = sm + PIN(I_BMOD)[l * 6144 + cj]; }
        __syncthreads();
    }

}

DI void tcvt_load(const float* src, int N, int kt, int nt, int tid, f32x4 (&v)[2]) {
    const int r = tid >> 4, c4 = (tid & 15) * 4;
#pragma unroll
    for (int i = 0; i < 2; ++i) { const int kk = kt * 64 + r + 32 * i, nn = nt * 64 + c4;
        v[i] = (f32x4){0.f, 0.f, 0.f, 0.f};
        if (nn < N) v[i] = *(const f32x4*)(src + (size_t)kk * N + nn); }
}
DI void tcvt_job(const float* src, int K, int N, int Npad, bf16_t* dst, int ldd, LAS float* tile, int& base, float fp8scale = 0.f) {
    const int tid = otid();
    const int nkt = K / 64, nnt = Npad / 64, ntl = nkt * nnt, G = gridDim.x;
    const int first = ((int)blockIdx.x - (base % G) + G) % G;
    f32x4 v[2];
    if (first < ntl) tcvt_load(src, N, first % nkt, first / nkt, tid, v);
    for (int t = first; t < ntl; t += G) {
        const int kt = t % nkt, nt = t / nkt;
        { const int r = tid >> 4, c4 = (tid & 15) * 4;
#pragma unroll
            for (int i = 0; i < 2; ++i) { LAS float* tp = tile + (r + 32 * i) * 65 + c4; tp[0] = v[i][0]; tp[1] = v[i][1]; tp[2] = v[i][2]; tp[3] = v[i][3]; } }
        if (t + G < ntl) tcvt_load(src, N, (t + G) % nkt, (t + G) / nkt, tid, v);
        __syncthreads();
        { const int n = tid >> 3, kc = (tid & 7) * 8; float x[8];
#pragma unroll
            for (int jj = 0; jj < 8; ++jj) x[jj] = tile[(kc + jj) * 65 + n];
            if (fp8scale != 0.f) { u32x2 w8; w8.x = pack4_fp8(x[0] * fp8scale, x[1] * fp8scale, x[2] * fp8scale, x[3] * fp8scale); w8.y = pack4_fp8(x[4] * fp8scale, x[5] * fp8scale, x[6] * fp8scale, x[7] * fp8scale);
                *(u32x2*)((unsigned char*)dst + (size_t)(nt * 64 + n) * ldd + kt * 64 + kc) = w8; }
            else { u32x4 w; w.x = pack2(x[0], x[1]); w.y = pack2(x[2], x[3]); w.z = pack2(x[4], x[5]); w.w = pack2(x[6], x[7]);
                *(u32x4*)(dst + (size_t)(nt * 64 + n) * ldd + kt * 64 + kc) = w; } }
        __syncthreads();
    }
    base += ntl;
}
DI void cvt_copy(const float* src, bf16_t* dst, size_t n) {
    const size_t nth = (size_t)gridDim.x * 512;
    for (size_t i = ((size_t)blockIdx.x * 512 + otid()) * 8; i < n; i += nth * 8) {
        const f32x4 a = *(const f32x4*)(src + i), b = *(const f32x4*)(src + i + 4);
        u32x4 w; w.x = pack2(a[0], a[1]); w.y = pack2(a[2], a[3]); w.z = pack2(b[0], b[1]); w.w = pack2(b[2], b[3]);
        *(u32x4*)(dst + i) = w;
    }
}
typedef float f32x2 __attribute__((ext_vector_type(2)));
constexpr float PU_SCALE = 64.0f, PV_SCALE = 4.0f;
constexpr int PSL = 4;
DI unsigned fp4_code(float x) {
    const float a = fabsf(x);
    const unsigned c = (unsigned)(a > 0.25f) + (unsigned)(a > 0.75f) + (unsigned)(a > 1.25f) + (unsigned)(a > 1.75f) + (unsigned)(a > 2.5f) + (unsigned)(a > 3.5f) + (unsigned)(a > 5.0f);
    return c | ((__float_as_uint(x) >> 28) & 8u);
}
DI unsigned pack8_fp4(const f32x4& a, const f32x4& b) {
    unsigned w = 0u;
    w = __builtin_amdgcn_cvt_scalef32_pk_fp4_f32(w, a[0], a[1], 1.0f, 0); w = __builtin_amdgcn_cvt_scalef32_pk_fp4_f32(w, a[2], a[3], 1.0f, 1);
    w = __builtin_amdgcn_cvt_scalef32_pk_fp4_f32(w, b[0], b[1], 1.0f, 2); w = __builtin_amdgcn_cvt_scalef32_pk_fp4_f32(w, b[2], b[3], 1.0f, 3);
    return w;
}
DI void cvt_copy_fp4(const float* src, unsigned char* dst, size_t n, float scale) {
    const size_t nth = (size_t)gridDim.x * 512, pstep = nth * 8, stp = pstep * 4;
    f32x4 v[8], vn[8];
    size_t i = ((size_t)blockIdx.x * 512 + otid()) * 8;
    auto ld = [&](size_t i0, f32x4 (&vv)[8]) {
#pragma unroll
        for (int q = 0; q < 4; ++q) if (i0 + q * pstep < n) { vv[2 * q] = *(const f32x4*)(src + i0 + q * pstep); vv[2 * q + 1] = *(const f32x4*)(src + i0 + q * pstep + 4); } };
    ld(i, v);
    for (; i < n; i += stp) {
        ld(i + stp, vn);
#pragma unroll
        for (int q = 0; q < 4; ++q) { const size_t ii = i + q * pstep;
            if (ii < n) { const unsigned w = pack8_fp4(v[2 * q] * scale, v[2 * q + 1] * scale);
                const size_t e = ii >> 10, c0 = ii & 1023;
                *(unsigned*)(dst + (c0 >> 8) * ((size_t)16384 * 128) + e * 128 + ((c0 & 255) >> 1)) = w; } }
#pragma unroll
        for (int q = 0; q < 8; ++q) v[q] = vn[q];
    }
}
DI void phase_convert(const Params& p, int l, LAS float* lds) {
    unsigned char* const ws = ws_ptr();
    int base = 0;
    tcvt_job(PIN(I_WIN) + (size_t)l * 1024 * PW, 1024, PW, 8704, (bf16_t*)(ws + WS_WIN), 1024, lds, base, WIN8_SCALE);
    tcvt_job(PIN(I_WOA) + (size_t)l * 512 * 1024, 512, 1024, 1024, (bf16_t*)(ws + WS_WO), 1024, lds, base);
    tcvt_job(PIN(I_WOB) + (size_t)l * 512 * 1024, 512, 1024, 1024, (bf16_t*)(ws + WS_WO) + (size_t)1 * 1024 * 1024, 1024, lds, base);
    tcvt_job(PIN(I_WOC) + (size_t)l * 1024 * 1024, 1024, 1024, 1024, (bf16_t*)(ws + WS_WO) + (size_t)2 * 1024 * 1024, 1024, lds, base);
    tcvt_job(PIN(I_WOA) + (size_t)l * 512 * 1024, 512, 1024, 1024, (bf16_t*)(ws + WS_WO8), 1024, lds, base, WO8_SCALE);
    tcvt_job(PIN(I_WOB) + (size_t)l * 512 * 1024, 512, 1024, 1024, (bf16_t*)(ws + WS_WO8 + (size_t)1024 * 1024), 1024, lds, base, WO8_SCALE);
    tcvt_job(PIN(I_WOC) + (size_t)l * 1024 * 1024, 1024, 1024, 1024, (bf16_t*)(ws + WS_WO8 + (size_t)2 * 1024 * 1024), 1024, lds, base, WO8_SCALE);
    tcvt_job(PIN(I_WOUT) + (size_t)l * 1024 * 1024, 1024, 1024, 1024, (bf16_t*)(ws + WS_WOUT), 1024, lds, base);
    tcvt_job(PIN(I_WPQ) + (size_t)l * 1024 * 2048, 1024, 2048, 2048, (bf16_t*)(ws + WS_WPQ), 1024, lds, base);
    { const float* sk = PIN(I_SUBK) + (size_t)l * 262144; const float* pg = PIN(I_PQG) + l * 128; bf16_t* dst = (bf16_t*)(ws + WS_SUBK);
        for (int i = (blockIdx.x * 512 + otid()) * 2; i < 262144; i += gridDim.x * 1024) {
            const int d = i & 127; *(unsigned*)(dst + i) = pack2(sk[i] * pg[d], sk[i + 1] * pg[d + 1]); } }
    cvt_copy_fp4(PIN(I_PU) + (size_t)l * 16384 * 1024, ws + WS_TU, (size_t)16384 * 1024, PU_SCALE);
    cvt_copy_fp4(PIN(I_PV) + (size_t)l * 16384 * 1024, ws + WS_TV, (size_t)16384 * 1024, PV_SCALE);
}

DI void phase_norm(const Params& p, int l, int which, const float* xlat, const float* xctx, const bf16_t* xlat_b, bf16_t* dst, int nrows) {
    unsigned char* const ws = ws_ptr();
    const int tid = otid(), lane = tid & 63, wid = tid >> 6;
    const float* gain = PIN(which ? I_NORM2 : I_NORM1) + l * 1024;
    const float* mod = (const float*)(ws + WS_MOD) + (size_t)l * 3 * 6144;
    auto ldrows = [&](int r0, f32x4 (&v)[2][4]) {
#pragma unroll
        for (int rr = 0; rr < 2; ++rr) { const int r = r0 + rr;
            if (r < NLAT && xlat_b) { const bf16_t* xb = xlat_b + (size_t)r * 1024;
#pragma unroll
                for (int i = 0; i < 4; ++i) { const u32x2 w = *(const u32x2*)(xb + i * 256 + lane * 4); v[rr][i] = (f32x4){bf_lo(w.x), bf_hi(w.x), bf_lo(w.y), bf_hi(w.y)}; }
            } else { const float* x = r < NLAT ? xlat + (size_t)r * 1024 : xctx + (size_t)(r - NLAT) * 1024;
#pragma unroll
                for (int i = 0; i < 4; ++i) v[rr][i] = *(const f32x4*)(x + i * 256 + lane * 4); } } };
    const int rstep = gridDim.x * 16;
    int r0 = (blockIdx.x * 8 + wid) * 2, mvc = -1;
    f32x4 v[2][4], vn[2][4], GS[4], HS[4];
    if (r0 < nrows) ldrows(r0, v);
    for (; r0 < nrows; r0 += rstep) {
        if (r0 + rstep < nrows) ldrows(r0 + rstep, vn);
        const int mv = r0 < NLAT ? (r0 >> 14) : 2;
        if (mv != mvc) { mvc = mv; const float* sh = mod + mv * 6144 + (which ? 3 : 0) * 1024; const float* sc = sh + 1024;
#pragma unroll
            for (int i = 0; i < 4; ++i) { const int c = i * 256 + lane * 4; const f32x4 g4 = *(const f32x4*)(gain + c), s4 = *(const f32x4*)(sc + c); HS[i] = *(const f32x4*)(sh + c);
                GS[i] = (f32x4){g4[0] * (1.0f + s4[0]), g4[1] * (1.0f + s4[1]), g4[2] * (1.0f + s4[2]), g4[3] * (1.0f + s4[3])}; } }
#pragma unroll
        for (int rr = 0; rr < 2; ++rr) { const int r = r0 + rr;
            float ss = 0.f;
#pragma unroll
            for (int i = 0; i < 4; ++i) ss += v[rr][i][0] * v[rr][i][0] + v[rr][i][1] * v[rr][i][1] + v[rr][i][2] * v[rr][i][2] + v[rr][i][3] * v[rr][i][3];
            ss = wave_sum(ss);
            const float rstd = rsqrtf(ss * (1.0f / 1024.0f) + EPS);
#pragma unroll
            for (int i = 0; i < 4; ++i) { const int c = i * 256 + lane * 4;
                float y[4];
#pragma unroll
                for (int jj = 0; jj < 4; ++jj) y[jj] = v[rr][i][jj] * rstd * GS[i][jj] + HS[i][jj];
                if (which == 0) *(unsigned*)((unsigned char*)dst + (size_t)r * 1024 + c) = pack4_fp8(y[0] * H8_SCALE, y[1] * H8_SCALE, y[2] * H8_SCALE, y[3] * H8_SCALE);
                else { u32x2 w; w.x = pack2(y[0], y[1]); w.y = pack2(y[2], y[3]); *(u32x2*)(dst + (size_t)r * 1024 + c) = w;
                    *(unsigned*)(ws + WS_H2F8 + (size_t)r * 2048 + c) = pack4_fp8(y[0] * H2F8_SCALE, y[1] * H2F8_SCALE, y[2] * H2F8_SCALE, y[3] * H2F8_SCALE); } } }
#pragma unroll
        for (int rr = 0; rr < 2; ++rr)
#pragma unroll
            for (int i = 0; i < 4; ++i) v[rr][i] = vn[rr][i];
    }
}

DI void phase_post(const Params& p, int l, LAS unsigned char* lds) {
    unsigned char* const ws = ws_ptr();
    const int tid = otid(), lane = tid & 63, wid = tid >> 6;
    bf16_t* proj = (bf16_t*)(ws + WS_PROJ);
    {
        LAS float* tab = (LAS float*)lds;
        LAS float* gn = (LAS float*)(lds + 32768);
        for (int i = tid; i < 4096; i += 512) { const int pos = i >> 4, f = i & 15;
            const float inv = exp2f(-(float)f * (13.287712379549449f / 16.0f));
            const float ang = (float)pos * inv;
            const float n = rintf(ang * 0.15915494309189535f); float rr = fmaf(-n, 6.28125f, ang); rr = fmaf(-n, 1.9353071795864769e-3f, rr);
            tab[2 * i] = __cosf(rr); tab[2 * i + 1] = __sinf(rr); }
        if (tid < 256) { const int w = tid >> 6, d = tid & 63; gn[tid] = PIN(w == 0 ? I_QNA : (w == 1 ? I_QNB : (w == 2 ? I_KNB : I_KNA)))[l * 64 + d]; }
        __syncthreads();
        const int c8 = lane & 7;
        const float sgn = (c8 & 2) ? 1.0f : -1.0f;
        auto ldrow = [&](int r, u32x4 (&w)[4]) { const bf16_t* rw = proj + (size_t)r * PW;
#pragma unroll
            for (int ps = 0; ps < 4; ++ps) { const int col = (ps == 0 ? C_QA : (ps == 1 ? C_QB : (ps == 2 ? C_KB : C_KA))) + 8 * (ps == 3 ? (lane & 15) : lane); w[ps] = *(const u32x4*)(rw + col); } };
        u32x4 wpre[4], wnx[4];
        { const int rf = blockIdx.x * 8 + wid; if (rf < NROW) ldrow(rf, wpre); }
        for (int r = blockIdx.x * 8 + wid; r < NROW; r += gridDim.x * 8) {
            bf16_t* row = proj + (size_t)r * PW;
            const bool lat = r < NLAT;
            const int t = r & (S - 1);
            const int pos = (c8 < 4) ? (t >> 6) : (t & 63);
            { const int rn = r + (int)gridDim.x * 8; if (rn < NROW) ldrow(rn, wnx); }
#pragma unroll
            for (int ps = 0; ps < 4; ++ps) {
                const int col = (ps == 0 ? C_QA : (ps == 1 ? C_QB : (ps == 2 ? C_KB : C_KA))) + 8 * lane;
                if (ps == 3 && lane >= 16) continue;
                const u32x4 w = wpre[ps];
                float v[8] = {bf_lo(w.x), bf_hi(w.x), bf_lo(w.y), bf_hi(w.y), bf_lo(w.z), bf_hi(w.z), bf_lo(w.w), bf_hi(w.w)};
                float ss = 0.f;
#pragma unroll
                for (int i = 0; i < 8; ++i) ss += v[i] * v[i];
                ss = sum8(ss);
                const float rstd = rsqrtf(ss * (1.0f / 64.0f) + EPS);
#pragma unroll
                for (int i = 0; i < 8; ++i) v[i] *= rstd * gn[ps * 64 + 8 * c8 + i];
                if ((ps == 0 || ps == 3) && lat) {
#pragma unroll
                    for (int i = 0; i < 8; ++i) { const float vi = v[i]; const float yp = DPPF(vi, 0x4E); const int f = 8 * (c8 & 1) + i;
                        const float cs = tab[(pos * 16 + f) * 2], sn = tab[(pos * 16 + f) * 2 + 1];
                        v[i] = v[i] * cs + sgn * yp * sn; }
                }
                u32x4 o; o.x = pack2(v[0], v[1]); o.y = pack2(v[2], v[3]); o.z = pack2(v[4], v[5]); o.w = pack2(v[6], v[7]);
                *(u32x4*)(row + col) = o;
            }
#pragma unroll
            for (int ps = 0; ps < 4; ++ps) wpre[ps] = wnx[ps];
        }
        __syncthreads();
    }
    {
        bf16_t* vt = (bf16_t*)(ws + WS_VT);
        const int ntl = (NROW / 64) * 13;
        const int rr = tid >> 3, ch = (tid & 7) * 16;
        auto src_of = [&](int it) -> const bf16_t* {
            const int tt = it / 13, cg = it - tt * 13;
            const int row0 = tt < 512 ? ((tt >> 8) * S + (tt & 255) * 64) : (NLAT + ((tt - 512) >> 2) * LC + ((tt - 512) & 3) * 64);
            const int vr0 = cg * 128;
            const int scol = vr0 < 128 ? C_VA + vr0 : (vr0 < 640 ? C_VB + (vr0 - 128) : C_VC + (vr0 - 640));
            return proj + (size_t)(row0 + rr) * PW + scol + ch; };
        int par = 0;
        u32x4 w0 = (u32x4){0u, 0u, 0u, 0u}, w1 = w0, x0 = w0, x1 = w0;
        if ((int)blockIdx.x < ntl) { const bf16_t* sp = src_of(blockIdx.x); w0 = *(const u32x4*)sp; w1 = *(const u32x4*)(sp + 8); }
        if ((int)(blockIdx.x + gridDim.x) < ntl) { const bf16_t* sp = src_of(blockIdx.x + gridDim.x); x0 = *(const u32x4*)sp; x1 = *(const u32x4*)(sp + 8); }
        for (int it = blockIdx.x; it < ntl; it += gridDim.x, par ^= 1) {
            LAS bf16_t* tile = (LAS bf16_t*)(lds + par * 17408);
            const int tt = it / 13, cg = it - tt * 13;
            int b, tok0;
            if (tt < 512) { b = tt >> 8; tok0 = (tt & 255) * 64; } else { b = (tt - 512) >> 2; tok0 = S + ((tt - 512) & 3) * 64; }
            const int vr0 = cg * 128;
            *(LAS u32x4*)(tile + rr * 136 + ch) = w0; *(LAS u32x4*)(tile + rr * 136 + ch + 8) = w1;
            u32x4 y0, y1;
            { const int nx = it + 2 * (int)gridDim.x; if (nx < ntl) { const bf16_t* sp = src_of(nx); y0 = *(const u32x4*)sp; y1 = *(const u32x4*)(sp + 8); } else { y0 = (u32x4){0u, 0u, 0u, 0u}; y1 = y0; } }
            __syncthreads();
            {
                typedef short s16x4 __attribute__((ext_vector_type(4)));
                const int ln = tid & 63, wv = tid >> 6, gq = ln >> 4, i16 = ln & 15;
                const LAS unsigned char* rb = (const LAS unsigned char*)tile + (16 * gq + (i16 >> 2)) * 272 + (16 * wv + 4 * (i16 & 3)) * 2;
                u32x2 r4[4];
#pragma unroll
                for (int r = 0; r < 4; ++r) r4[r] = __builtin_bit_cast(u32x2, __builtin_amdgcn_ds_read_tr16_b64_v4i16((LAS s16x4*)(rb + r * 4 * 272)));
                bf16_t* dp = vt + ((size_t)b * VTR + vr0 + 16 * wv + i16) * TOKB + tok0 + 16 * gq;
                *(u32x4*)dp = (u32x4){r4[0].x, r4[0].y, r4[1].x, r4[1].y}; *(u32x4*)(dp + 8) = (u32x4){r4[2].x, r4[2].y, r4[3].x, r4[3].y}; }
            w0 = x0; w1 = x1; x0 = y0; x1 = y1;
        }
        __syncthreads();
    }
}

struct AttnState { bf16x8 Q[2][4]; f32x16 O[2][2]; float m[2], l[2]; };
struct TileRef { unsigned ku, vu; int kpos0; const LAS float* brow; };
struct AttnLane { const char* pb; const char* vb;
    unsigned ksrc, vsrc;
    LAS unsigned char* kbuf; LAS unsigned char* vbuf;
    unsigned krd, vrd; };
DI void attn_dma_k(const AttnLane& al, unsigned ku, int par) {
    const char* src = al.pb + (size_t)(ku + al.ksrc);
#pragma unroll
    for (int q = 0; q < 4; ++q) __builtin_amdgcn_global_load_lds((const unsigned*)(src + (size_t)q * (8 * PW * 2)), (LAS unsigned*)(al.kbuf + par * 8192 + q * 1024), 16, 0, 0);
}
DI void attn_dma_v(const AttnLane& al, unsigned vu, int par) {
    const char* src = al.vb + (size_t)(vu + al.vsrc);
#pragma unroll
    for (int q = 0; q < 4; ++q) __builtin_amdgcn_global_load_lds((const unsigned*)(src + (size_t)q * (16 * TOKB * 2)), (LAS unsigned*)(al.vbuf + par * 8192 + q * 1024), 16, 0, 0);
}
template <int MODE, bool FIXED>
DI void attn_tile(AttnState& st, const AttnLane& al, int par, const TileRef& tr, unsigned kunext, unsigned vunext, int qpos0, int g, bool domask) {
    asm volatile("s_waitcnt vmcnt(12)" ::: "memory");
    f32x16 sc[2];
    {
        bf16x8 Kf[4];
#pragma unroll
        for (int s = 0; s < 4; ++s) Kf[s] = *(const LAS bf16x8*)(al.kbuf + par * 8192 + (al.krd ^ (unsigned)(s << 4)));
#pragma unroll
        for (int u = 0; u < 2; ++u) {
            sc[u] = zero16();
#pragma unroll
            for (int s = 0; s < 4; ++s) sc[u] = MFMA32(Kf[s], st.Q[u][s], sc[u]);
        }
    }
    asm volatile("s_waitcnt lgkmcnt(0)" ::: "memory");
    attn_dma_k(al, kunext, par);
    const int kpos0 = tr.kpos0;
    bf16x8 Vf[2][2];
#pragma unroll
    for (int u = 0; u < 2; ++u) {
        const int qp = qpos0 + 32 * u;
        if (MODE == 1 && domask) {
            const int base = kpos0 + 8 * g - qp + 128;
#pragma unroll
            for (int r = 0; r < 16; ++r) sc[u][r] = ((unsigned)(base + 16 * (r >> 3) + (r & 7)) <= 256u) ? sc[u][r] : -INFINITY;
        } else if (MODE == 2 && domask) {
            int cs = qp - 8; cs = cs < 0 ? 0 : (cs > 48 ? 48 : cs);
            const int vb = kpos0 + 8 * g - cs;
            const LAS float* bp = tr.brow + (kpos0 + 8 * g - qp + 15);
            float bv[16];
#pragma unroll
            for (int r = 0; r < 16; ++r) bv[r] = bp[16 * (r >> 3) + (r & 7)];
            asm volatile("" ::: "memory");
#pragma unroll
            for (int r = 0; r < 16; ++r) { const int o = 16 * (r >> 3) + (r & 7); const float t = sc[u][r] + bv[r]; sc[u][r] = ((unsigned)(vb + o) < 16u) ? t : -INFINITY; }
        }
        if (FIXED) {
            float rs = 0.f;
#pragma unroll
            for (int r = 0; r < 16; ++r) { const float pv = __builtin_amdgcn_exp2f(sc[u][r]); rs += pv; sc[u][r] = pv; }
            st.l[u] += rs;
        } else {
        float mx = sc[u][0];
#pragma unroll
        for (int r = 1; r < 16; ++r) mx = fmaxf(mx, sc[u][r]);
        mx = fmaxf(mx, shx(mx, 32));
        const float mn = fmaxf(st.m[u], mx);
        float rs = 0.f;
#pragma unroll
        for (int r = 0; r < 16; ++r) { const float pv = __builtin_amdgcn_exp2f(sc[u][r] - mn); rs += pv; sc[u][r] = pv; }
        if (__builtin_amdgcn_ballot_w64(mn > st.m[u]) != 0ull) {
            const float alpha = __builtin_amdgcn_exp2f(st.m[u] - mn);
            st.l[u] *= alpha;
#pragma unroll
            for (int r = 0; r < 16; ++r) { st.O[0][u][r] *= alpha; st.O[1][u][r] *= alpha; }
        }
        st.m[u] = mn;
        st.l[u] += rs;
        }
        bf16x8 P[2];
#pragma unroll
        for (int s = 0; s < 2; ++s) { u32x4 w; w.x = pack2(sc[u][8 * s], sc[u][8 * s + 1]); w.y = pack2(sc[u][8 * s + 2], sc[u][8 * s + 3]); w.z = pack2(sc[u][8 * s + 4], sc[u][8 * s + 5]); w.w = pack2(sc[u][8 * s + 6], sc[u][8 * s + 7]);
            P[s] = __builtin_bit_cast(bf16x8, w); }
        if (u == 0) {
            asm volatile("s_waitcnt vmcnt(12)" ::: "memory");
#pragma unroll
            for (int dt = 0; dt < 2; ++dt)
#pragma unroll
                for (int s = 0; s < 2; ++s) Vf[dt][s] = *(const LAS bf16x8*)(al.vbuf + par * 8192 + dt * 2048 + (al.vrd ^ (unsigned)(s << 5)));
        }
#pragma unroll
        for (int dt = 0; dt < 2; ++dt)
#pragma unroll
            for (int s = 0; s < 2; ++s) st.O[dt][u] = MFMA32(Vf[dt][s], P[s], st.O[dt][u]);
    }
    asm volatile("s_waitcnt lgkmcnt(0)" ::: "memory");
    attn_dma_v(al, vunext, par);
}
DI void attn_load_q(AttnState& st, const bf16_t* proj, int qrow0, int qcol, int j, int g) {
    const float qs = 0.125f * LOG2E;
#pragma unroll
    for (int u = 0; u < 2; ++u) {
        const bf16_t* qp = proj + (size_t)(qrow0 + 32 * u + j) * PW + qcol + 32 * g;
#pragma unroll
        for (int s = 0; s < 4; ++s) { const u32x4 w = *(const u32x4*)(qp + 8 * s); u32x4 o;
            o.x = pack2(bf_lo(w.x) * qs, bf_hi(w.x) * qs); o.y = pack2(bf_lo(w.y) * qs, bf_hi(w.y) * qs); o.z = pack2(bf_lo(w.z) * qs, bf_hi(w.z) * qs); o.w = pack2(bf_lo(w.w) * qs, bf_hi(w.w) * qs);
            st.Q[u][s] = __builtin_bit_cast(bf16x8, o); }
        st.O[0][u] = zero16(); st.O[1][u] = zero16();
    }
}
DI void attn_store(const AttnState& st, bf16_t* proj, int qrow0, int ocol, int j, int g) {
#pragma unroll
    for (int u = 0; u < 2; ++u) {
        const float lt = st.l[u] + shx(st.l[u], 32);
        const float inv = 1.0f / lt;
        bf16_t* op = proj + (size_t)(qrow0 + 32 * u + j) * PW + ocol + 4 * g;
#pragma unroll
        for (int dt = 0; dt < 2; ++dt)
#pragma unroll
            for (int q = 0; q < 4; ++q) { u32x2 w; w.x = pack2(st.O[dt][u][4 * q] * inv, st.O[dt][u][4 * q + 1] * inv); w.y = pack2(st.O[dt][u][4 * q + 2] * inv, st.O[dt][u][4 * q + 3] * inv);
                *(u32x2*)(op + 32 * dt + 8 * q) = w; }
    }
}
DI void attn_store8(const AttnState& st, unsigned char* o8, int qrow0, int obyte, int j, int g) {
#pragma unroll
    for (int u = 0; u < 2; ++u) {
        const float lt = st.l[u] + shx(st.l[u], 32);
        const float inv = O8_SCALE / lt;
        unsigned char* op = o8 + (size_t)(qrow0 + 32 * u + j) * 2048 + obyte + 4 * g;
#pragma unroll
        for (int dt = 0; dt < 2; ++dt)
#pragma unroll
            for (int q = 0; q < 4; ++q) *(unsigned*)(op + 32 * dt + 8 * q) = pack4_fp8(st.O[dt][u][4 * q] * inv, st.O[dt][u][4 * q + 1] * inv, st.O[dt][u][4 * q + 2] * inv, st.O[dt][u][4 * q + 3] * inv);
    }
}
struct CtxTiles { unsigned k0, v0;
    DI TileRef operator()(int t) const { TileRef r; r.ku = k0 + (unsigned)(32 * t) * (PW * 2); r.vu = v0 + 64 * t; r.kpos0 = 0; r.brow = nullptr; return r; } };
struct LocATiles { unsigned k0, v0; int p0;
    DI TileRef operator()(int t) const { TileRef r; const int kp0 = p0 + 32 * t; r.ku = k0 + (unsigned)kp0 * (PW * 2); r.vu = v0 + 2 * kp0; r.kpos0 = kp0; r.brow = nullptr; return r; } };
struct LocBTiles { unsigned k0, v0; int rs; const LAS float* rpbh; int r;
    DI TileRef operator()(int t) const { TileRef q; const int kr = rs + (t >> 1), c0 = (t & 1) * 32; q.ku = k0 + (unsigned)(kr * 64 + c0) * (PW * 2); q.vu = v0 + 2 * (kr * 64 + c0); q.kpos0 = c0; q.brow = rpbh + (kr - r + 7) * 31; return q; } };
struct NoTiles { DI TileRef operator()(int) const { TileRef r; r.ku = 0; r.vu = 0; r.kpos0 = 0; r.brow = nullptr; return r; } };
template <int MODE, bool FIXED, class LT>
DI void attn_run(AttnState& st, const AttnLane& al, const CtxTiles& ct, const LT& lt, int lo, int hi, int ulo, int uhi, int qpos0, int g) {
    const int ntot = 8 + (hi - lo);
    TileRef cur = ct(0), n1 = ct(1);
    attn_dma_k(al, cur.ku, 0); attn_dma_v(al, cur.vu, 0); attn_dma_k(al, n1.ku, 1); attn_dma_v(al, n1.vu, 1);
#pragma unroll 1
    for (int tt = 0; tt < ntot; ++tt) {
        int t2 = tt + 2; if (t2 > ntot - 1) t2 = ntot - 1;
        TileRef n2; if (t2 < 8) n2 = ct(t2); else n2 = lt(lo + t2 - 8);
        const int tl = lo + tt - 8;
        const bool domask = (tt >= 8) && !(tl >= ulo && tl < uhi);
        attn_tile<MODE, FIXED>(st, al, tt & 1, cur, n2.ku, n2.vu, qpos0, g, domask);
        cur = n1; n1 = n2;
    }
}
DI void phase_attn(const Params& p, int l, LAS unsigned char* lds, int part) {
    const int xg3 = (NB * NCH * 4) % (int)gridDim.x;
    if (part == 1 && (l == DEPTH - 1 || (int)blockIdx.x < xg3 || ((int)blockIdx.x - xg3) * 8 >= 128)) return;
    unsigned char* const ws = ws_ptr();
    const int tid = otid(), lane = tid & 63, wid = tid >> 6, j = lane & 31, g = lane >> 5;
    bf16_t* proj = (bf16_t*)(ws + WS_PROJ);
    LAS float* rpb = (LAS float*)(lds + 256);
    float bmx = 0.f;
    if (part == 0) for (int i = tid; i < 8 * 15 * 31; i += 512) { const float v = PIN(I_RPB)[l * 3720 + i] * LOG2E; rpb[i] = v; bmx = fmaxf(bmx, fabsf(v)); }
    bool fixed_ok;
    { auto wmax = [&](float v) { for (int o = 32; o > 0; o >>= 1) v = fmaxf(v, shx(v, o)); return v; };
        const float gqa = wmax(fabsf(PIN(I_QNA)[l * 64 + lane])), gka = wmax(fabsf(PIN(I_KNA)[l * 64 + lane])), gqb = wmax(fabsf(PIN(I_QNB)[l * 64 + lane])), gkb = wmax(fabsf(PIN(I_KNB)[l * 64 + lane]));
        const float snk = wmax(fabsf(PIN(I_SINKA)[l * 8 + (lane & 7)]) * LOG2E);
        bmx = wmax(bmx);
        if (lane == 0) ((LAS float*)lds)[wid] = bmx;
        __syncthreads();
        float ball = 0.f;
#pragma unroll
        for (int w = 0; w < 8; ++w) ball = fmaxf(ball, ((const LAS float*)lds)[w]);
        const float bnd = fmaxf(fmaxf(8.0f * LOG2E * gqa * gka, 8.0f * LOG2E * gqb * gkb + ball), snk);
        fixed_ok = __builtin_amdgcn_readfirstlane((int)(bnd <= 96.0f)) != 0; }
    __syncthreads();
    const bool last = (l == DEPTH - 1);
    const int nitems = 8192 + (last ? 0 : 128);
    AttnLane al; al.pb = (const char*)(ws + WS_PROJ); al.vb = (const char*)(ws + WS_VT);
    { const int kr = lane >> 3, kc = (lane & 7) ^ (kr & 7); al.ksrc = (unsigned)(kr * PW * 2 + kc * 16);
        const int vr = lane >> 2, vc = (lane & 3) ^ ((vr >> 2) & 3); al.vsrc = (unsigned)(vr * TOKB * 2 + vc * 16);
        const int wu = __builtin_amdgcn_readfirstlane(wid);
        al.kbuf = lds + 16384 + wu * 16384; al.vbuf = lds + 16384 + wu * 16384 + 4096;
        const int rho = pi32(j); al.krd = (unsigned)(rho * 128 + (((4 * g) ^ (rho & 7)) << 4));
        al.vrd = (unsigned)(j * 64 + ((g ^ ((j >> 2) & 3)) << 4)); }
    const int it_first = part == 0 ? (int)blockIdx.x * 8 + wid : 8192 + ((int)blockIdx.x - xg3) * 8 + wid;
    const int it_end = part == 0 ? 8192 : nitems;
    const int it_step = part == 0 ? (int)gridDim.x * 8 : ((int)gridDim.x - xg3) * 8;
    for (int it = it_first; it < it_end; it += it_step) {
        AttnState st;
        if (it < 4096) {
            const int half = it & 1, hh = (it >> 1) & 7, n_ = (it >> 4) & 127, b = it >> 11;
            const int n = ((n_ & 3) << 5) | (n_ >> 2);
            const int q0 = n * 128 + half * 64, qrow0 = b * S + q0, g2 = hh >> 2;
            attn_load_q(st, proj, qrow0, C_QA + hh * 64, j, g);
            const float sk = PIN(I_SINKA)[l * 8 + hh] * LOG2E;
            st.m[0] = st.m[1] = sk; st.l[0] = st.l[1] = (g == 0) ? 1.0f : 0.0f;
            CtxTiles ct; ct.k0 = (unsigned)((NLAT + b * LC) * PW + C_KA + g2 * 64) * 2u; ct.v0 = (unsigned)((b * VTR + g2 * 64) * TOKB + S) * 2u;
            LocATiles la; la.k0 = (unsigned)(b * S * PW + C_KA + g2 * 64) * 2u; la.v0 = (unsigned)((b * VTR + g2 * 64) * TOKB) * 2u; la.p0 = (n - 1) * 128;
            int lo = half ? 2 : 0, hi = half ? 12 : 10;
            if (n == 0 && lo < 4) lo = 4;
            if (n == 127 && hi > 8) hi = 8;
            if (fixed_ok) { st.l[0] = st.l[1] = (g == 0) ? __builtin_amdgcn_exp2f(sk) : 0.0f; attn_run<1, true>(st, al, ct, la, lo, hi, 2 + 2 * half, 8 + 2 * half, q0 + j, g); }
            else attn_run<1, false>(st, al, ct, la, lo, hi, 2 + 2 * half, 8 + 2 * half, q0 + j, g);
            attn_store8(st, ws + WS_O8, qrow0, hh * 64, j, g);
        } else if (it < 8192) {
            const int i2 = it - 4096, h = i2 & 7, r_ = (i2 >> 3) & 255, b = i2 >> 11;
            const int r = ((r_ & 7) << 5) | (r_ >> 3);
            const int qrow0 = b * S + r * 64;
            attn_load_q(st, proj, qrow0, C_QB + h * 64, j, g);
            st.m[0] = st.m[1] = -INFINITY; st.l[0] = st.l[1] = 0.f;
            CtxTiles ct; ct.k0 = (unsigned)((NLAT + b * LC) * PW + C_KB + h * 64) * 2u; ct.v0 = (unsigned)((b * VTR + 128 + h * 64) * TOKB + S) * 2u;
            int rs = r - 4; rs = rs < 0 ? 0 : (rs > 248 ? 248 : rs);
            LocBTiles lb; lb.k0 = (unsigned)(b * S * PW + C_KB + h * 64) * 2u; lb.v0 = (unsigned)((b * VTR + 128 + h * 64) * TOKB) * 2u; lb.rs = rs; lb.rpbh = rpb + h * 15 * 31; lb.r = r;
            if (fixed_ok) attn_run<2, true>(st, al, ct, lb, 0, 16, 0, 0, j, g); else attn_run<2, false>(st, al, ct, lb, 0, 16, 0, 0, j, g);
            attn_store8(st, ws + WS_O8, qrow0, 512 + h * 64, j, g);
        } else {
            const int i2 = it - 8192, qt = i2 & 3, h = (i2 >> 2) & 7, b = (i2 >> 5) & 1, mixer = i2 >> 6;
            const int qrow0 = NLAT + b * LC + qt * 64;
            const int qcol = mixer == 0 ? C_QA + h * 64 : C_QB + h * 64;
            const int kcol = mixer == 0 ? C_KA + (h >> 2) * 64 : C_KB + h * 64;
            const int vr0 = mixer == 0 ? (h >> 2) * 64 : 128 + h * 64;
            attn_load_q(st, proj, qrow0, qcol, j, g);
            const float sk = PIN(I_SINKA)[l * 8 + h] * LOG2E;
            st.m[0] = st.m[1] = mixer == 0 ? sk : -INFINITY; st.l[0] = st.l[1] = (mixer == 0 && g == 0) ? 1.0f : 0.0f;
            CtxTiles ct; ct.k0 = (unsigned)((NLAT + b * LC) * PW + kcol) * 2u; ct.v0 = (unsigned)((b * VTR + vr0) * TOKB + S) * 2u;
            NoTiles nt;
            if (fixed_ok) { st.l[0] = st.l[1] = (mixer == 0 && g == 0) ? __builtin_amdgcn_exp2f(sk) : 0.0f; attn_run<0, true>(st, al, ct, nt, 0, 0, 0, 0, 0, g); }
            else attn_run<0, false>(st, al, ct, nt, 0, 0, 0, 0, 0, g);
            attn_store(st, proj, qrow0, qcol, j, g);
        }
    }
}

DI void gla_chunk_rows(int b, int ci, int& row0, int& tok0) {
    if (ci < 256) { tok0 = ci * 64; row0 = b * S + tok0; } else { const int cc = ci - 256; tok0 = S + cc * 64; row0 = NLAT + b * LC + cc * 64; }
}
constexpr int GL_A = 0;
constexpr int GL_W = 8192;
constexpr int GL_B = 24576;
constexpr int GL_QT = 27648;
constexpr int GL_SSQ = 25600;
constexpr int GL_LA = 30720;
constexpr int GL_QH = 63488;
constexpr int GL_KT = 79872;
constexpr int GL_SB = 96256;
constexpr int GL_OUT = GL_QH + 18432;
constexpr int GL_ATT = GL_LA;
DI u32x4 gla_load_a(const bf16_t* proj, int row0, int) {
    const int tid = otid();
    u32x4 w = (u32x4){0u, 0u, 0u, 0u};
    if (tid < 256) w = *(const u32x4*)(proj + (size_t)(row0 + (tid >> 2)) * PW + C_AC + (tid & 3) * 8);
    return w;
}
DI void gla_stage_gate(const Params& p, int l, const u32x4& w, int h, LAS unsigned char* lds, int& cur_h) {
    const int tid = otid();
    LAS float* a_s = (LAS float*)(lds + GL_A); LAS float* w_s = (LAS float*)(lds + GL_W); LAS float* b_s = (LAS float*)(lds + GL_B);
    if (tid < 256) { const int tok = tid >> 2, c8 = (tid & 3) * 8;
        LAS float* d = a_s + tok * 32 + c8; d[0] = bf_lo(w.x); d[1] = bf_hi(w.x); d[2] = bf_lo(w.y); d[3] = bf_hi(w.y); d[4] = bf_lo(w.z); d[5] = bf_hi(w.z); d[6] = bf_lo(w.w); d[7] = bf_hi(w.w); }
    if (h != cur_h) {
        cur_h = h;
#pragma unroll
        for (int q = 0; q < 8; ++q) { const int i = tid + q * 512, dir = i >> 11, rr = (i >> 7) & 15, ch = i & 127;
            w_s[i] = PIN(dir ? I_WA2B : I_WA2F)[(size_t)l * 16 * 512 + rr * 512 + h * 128 + ch]; }
        if (tid < 256) { const int dir = tid >> 7, ch = tid & 127; b_s[tid] = PIN(dir ? I_BAB : I_BAF)[l * 512 + h * 128 + ch]; }
    }
}
DI void gla_logdecay(int dir, LAS unsigned char* lds) {
    const int tid = otid();
    const LAS float* a_s = (const LAS float*)(lds + GL_A); const LAS float* w_s = (const LAS float*)(lds + GL_W) + dir * 2048; const LAS float* b_s = (const LAS float*)(lds + GL_B) + dir * 128;
    LAS float* la = (LAS float*)(lds + GL_LA);
    LAS float* qt = (LAS float*)(lds + GL_QT);
    const int ch = tid & 127, tq = tid >> 7; float w[16];
#pragma unroll
    for (int i = 0; i < 16; ++i) w[i] = w_s[i * 128 + ch];
    const float bb = b_s[ch];
    float run = 0.f;
#pragma unroll 4
    for (int t = 0; t < 16; ++t) { const int tok = tq * 16 + (dir ? 15 - t : t); float z = bb;
        const LAS f32x4* ap = (const LAS f32x4*)(a_s + tok * 32 + dir * 16);
#pragma unroll
        for (int i = 0; i < 4; ++i) { const f32x4 av = ap[i]; z += av[0] * w[4 * i] + av[1] * w[4 * i + 1] + av[2] * w[4 * i + 2] + av[3] * w[4 * i + 3]; }
        run += (fminf(z, 0.f) - __logf(1.0f + __expf(-fabsf(z)))) * (1.0f / 16.0f);
        la[tok * 128 + ch] = run; }
    qt[tq * 128 + ch] = run;
    __syncthreads();
    float off = 0.f;
#pragma unroll
    for (int q = 0; q < 4; ++q) { const float v = qt[q * 128 + ch]; off += (dir ? (q > tq) : (q < tq)) ? v : 0.f; }
#pragma unroll
    for (int t = 0; t < 16; ++t) la[(tq * 16 + t) * 128 + ch] += off;
    __syncthreads();
}
DI void phase_gla1(const Params& p, int l, LAS unsigned char* lds) {
    unsigned char* const ws = ws_ptr();
    const int tid = otid(), lane = tid & 63, wid = tid >> 6, j = lane & 31, g = lane >> 5;
    const bf16_t* proj = (const bf16_t*)(ws + WS_PROJ);
    const bf16_t* vt = (const bf16_t*)(ws + WS_VT);
    unsigned char* stt = ws + WS_ST; float* dec = (float*)(ws + WS_DEC);
    const LAS float* la = (const LAS float*)(lds + GL_LA);
    LAS bf16_t* ktT = (LAS bf16_t*)(lds + GL_QH);
    int cur_h = -1;
    u32x4 a_pre = (u32x4){0u, 0u, 0u, 0u};
    if ((int)blockIdx.x < NB * NCH * 4) { int r0_, t0_; gla_chunk_rows(((int)blockIdx.x >> 2) / NCH, ((int)blockIdx.x >> 2) % NCH, r0_, t0_); a_pre = gla_load_a(proj, r0_, tid); }
    for (int un = blockIdx.x; un < NB * NCH * 4; un += gridDim.x) {
        const int h = un & 3, ci = (un >> 2) % NCH, b = (un >> 2) / NCH;
        int row0, tok0; gla_chunk_rows(b, ci, row0, tok0);
        gla_stage_gate(p, l, a_pre, h, lds, cur_h);
        { const int un2 = un + gridDim.x; if (un2 < NB * NCH * 4) { int r0_, t0_; gla_chunk_rows((un2 >> 2) / NCH, (un2 >> 2) % NCH, r0_, t0_); a_pre = gla_load_a(proj, r0_, tid); } }
        bf16x8 Vf[4];
#pragma unroll
        for (int s = 0; s < 4; ++s) Vf[s] = *(const bf16x8*)(vt + ((size_t)b * VTR + 640 + h * 256 + 32 * wid + j) * TOKB + tok0 + 16 * s + 8 * g);
        const u32x4 k0 = *(const u32x4*)(proj + (size_t)(row0 + (tid >> 3)) * PW + C_KC + h * 128 + (tid & 7) * 16), k1 = *(const u32x4*)(proj + (size_t)(row0 + (tid >> 3)) * PW + C_KC + h * 128 + (tid & 7) * 16 + 8);
        __syncthreads();
        for (int dir = 0; dir < 2; ++dir) {
            gla_logdecay(dir, lds);
            const int chain = (b * 4 + h) * 2 + dir;
            { const int tok = tid >> 3, cc = (tid & 7) * 16;
                const unsigned kw[8] = {k0.x, k0.y, k0.z, k0.w, k1.x, k1.y, k1.z, k1.w};
                const int te = dir ? 0 : 63;
#pragma unroll
                for (int q = 0; q < 8; ++q) { const int ch = cc + 2 * q;
                    const float w0 = __expf(la[te * 128 + ch] - la[tok * 128 + ch]), w1 = __expf(la[te * 128 + ch + 1] - la[tok * 128 + ch + 1]);
                    const int tr_ = (tok + 8 * (ch >> 4)) & 63;
                    ktT[ch * 72 + tr_] = f2bf(bf_lo(kw[q]) * w0); ktT[(ch + 1) * 72 + tr_] = f2bf(bf_hi(kw[q]) * w1); } }
            if (tid < 128) dec[((size_t)chain * NCH + ci) * 128 + tid] = __expf(la[(dir ? 0 : 63) * 128 + tid]);
            __syncthreads();
            unsigned char* so = stt + ((size_t)chain * NCH + ci) * 32768 + (size_t)(32 * wid) * 128;
            LAS unsigned char* ob = lds + GL_OUT + wid * 8704;
            const int prow = 16 * ((j >> 2) & 1) + 4 * (j >> 3) + (j & 3);
#pragma unroll
            for (int dk = 0; dk < 4; ++dk) {
                f32x16 acc = zero16();
                const int krow = 32 * dk + prow;
#pragma unroll
                for (int s = 0; s < 4; ++s) { const bf16x8 Af = *(const LAS bf16x8*)(ktT + krow * 72 + (((2 * s + g + (krow >> 4)) & 7) << 3)); acc = MFMA32(Af, Vf[s], acc); }
                u32x4 w0;
                w0.x = pack4_fp8(acc[0], acc[1], acc[2], acc[3]); w0.y = pack4_fp8(acc[4], acc[5], acc[6], acc[7]); w0.z = pack4_fp8(acc[8], acc[9], acc[10], acc[11]); w0.w = pack4_fp8(acc[12], acc[13], acc[14], acc[15]);
                *(LAS u32x4*)(ob + j * 144 + 32 * dk + 16 * g) = w0;
            }
#pragma unroll
            for (int q = 0; q < 4; ++q) { const int row = 8 * q + (lane >> 3), chk = lane & 7;
                *(u32x4*)(so + (size_t)row * 128 + chk * 16) = *(const LAS u32x4*)(ob + row * 144 + chk * 16); }
            __syncthreads();
        }
    }
}
DI void phase_gla2(const Params& p) {
    unsigned char* const ws = ws_ptr();
    const char* sb = (const char*)(ws + WS_ST); const char* db = (const char*)(ws + WS_DEC);
    for (int gt = blockIdx.x * 512 + otid(); gt < 16 * 8192; gt += gridDim.x * 512) {
        const int chain = gt >> 13, e = gt & 8191, dv = e >> 5, dk0 = (e & 31) * 4, dir = chain & 1;
        const unsigned so = (unsigned)(chain * NCH * 32768 + dv * 128 + dk0), dof = (unsigned)((chain * NCH * 128 + dk0) * 4);
        float s0, s1, s2, s3;
        asm volatile("v_mov_b32 %0, 0\n\tv_mov_b32 %1, 0\n\tv_mov_b32 %2, 0\n\tv_mov_b32 %3, 0" : "=v"(s0), "=v"(s1), "=v"(s2), "=v"(s3));
        auto chunk_of = [&](int step) -> int { return dir ? (NCH - 1 - step) : (step < 4 ? 256 + step : step - 4); };
        unsigned dS[4], dSn[4]; f32x4 dd[4], ddn[4];
#pragma unroll
        for (int q = 0; q < 4; ++q) { const unsigned c = (unsigned)chunk_of(q); dS[q] = *(const unsigned*)(sb + (size_t)(so + c * 32768u)); dd[q] = *(const f32x4*)(db + (size_t)(dof + c * 512u)); }
        for (int st = 0; st < NCH; st += 4) {
            const int sn = st + 4 < NCH ? st + 4 : st;
#pragma unroll
            for (int q = 0; q < 4; ++q) { const unsigned c = (unsigned)chunk_of(sn + q); dSn[q] = *(const unsigned*)(sb + (size_t)(so + c * 32768u)); ddn[q] = *(const f32x4*)(db + (size_t)(dof + c * 512u)); }
#pragma unroll
            for (int q = 0; q < 4; ++q) {
                *(unsigned*)((char*)sb + (size_t)(so + (unsigned)chunk_of(st + q) * 32768u)) = pack4_fp8(s0, s1, s2, s3);
                float e0, e1, e2, e3; unpack4_fp8(dS[q], e0, e1, e2, e3);
                s0 = dd[q][0] * s0 + e0; s1 = dd[q][1] * s1 + e1; s2 = dd[q][2] * s2 + e2; s3 = dd[q][3] * s3 + e3;
            }
#pragma unroll
            for (int q = 0; q < 4; ++q) { dS[q] = dSn[q]; dd[q] = ddn[q]; }
        }
    }
}
DI int gl_swz(int tok, int chunk) { return tok * 256 + ((chunk ^ (tok & 15)) << 4); }
template <int DIR>
DI void gla3_dir(const Params& p, LAS unsigned char* lds, const u32x4 (&qk)[4], const unsigned char* state, const bf16x8 (&Vf)[2][2], f32x16 (&O)[2]) {
    const int tid = otid(), lane = tid & 63, wid = tid >> 6, j = lane & 31, g = lane >> 5;
    LAS unsigned char* sb = lds + GL_SB + __builtin_amdgcn_readfirstlane(wid) * 8192;
    { const char* src = (const char*)(state + (size_t)(32 * wid) * 128);
#pragma unroll
        for (int q = 0; q < 4; ++q) { const int r = 8 * q + (lane >> 3), c = (lane & 7) ^ (r & 7);
            __builtin_amdgcn_global_load_lds((const unsigned*)(src + r * 128 + c * 16), (LAS unsigned*)(sb + q * 1024), 16, 0, 0); } }
    gla_logdecay(DIR, lds);

    const LAS float* la = (const LAS float*)(lds + GL_LA);
    { const int tok = tid >> 3, cc = (tid & 7) * 16;
        u32x4 q0 = qk[0], q1 = qk[1], k0 = qk[2], k1 = qk[3];
        asm volatile("" : "+v"(q0), "+v"(q1), "+v"(k0), "+v"(k1));
        const unsigned qw[8] = {q0.x, q0.y, q0.z, q0.w, q1.x, q1.y, q1.z, q1.w}, kw[8] = {k0.x, k0.y, k0.z, k0.w, k1.x, k1.y, k1.z, k1.w};
        unsigned qo[8], ko[8];
#pragma unroll
        for (int q = 0; q < 8; ++q) { const float b0 = la[tok * 128 + cc + 2 * q], b1 = la[tok * 128 + cc + 2 * q + 1];
            qo[q] = pack2(bf_lo(qw[q]) * 0.08838834764831845f * __expf(b0), bf_hi(qw[q]) * 0.08838834764831845f * __expf(b1));
            ko[q] = pack2(bf_lo(kw[q]) * __expf(fminf(-b0, 80.f)), bf_hi(kw[q]) * __expf(fminf(-b1, 80.f))); }
        const int c0 = (tid & 7) * 2;
        *(LAS u32x4*)(lds + GL_QH + gl_swz(tok, c0)) = (u32x4){qo[0], qo[1], qo[2], qo[3]}; *(LAS u32x4*)(lds + GL_QH + gl_swz(tok, c0 + 1)) = (u32x4){qo[4], qo[5], qo[6], qo[7]};
        *(LAS u32x4*)(lds + GL_KT + gl_swz(tok, c0)) = (u32x4){ko[0], ko[1], ko[2], ko[3]}; *(LAS u32x4*)(lds + GL_KT + gl_swz(tok, c0 + 1)) = (u32x4){ko[4], ko[5], ko[6], ko[7]}; }
    __syncthreads();
    if (wid < 4) {
        const int tj = wid >> 1, ti = wid & 1;
        const bool skip = DIR == 0 ? (tj > ti) : (tj < ti);
        if (!skip) {
            f32x16 acc = zero16();
            const int ktok = 32 * tj + pi32(j), qtok = 32 * ti + j;
#pragma unroll
            for (int s = 0; s < 8; ++s) { const bf16x8 Af = *(const LAS bf16x8*)(lds + GL_KT + gl_swz(ktok, 2 * s + g)), Bf = *(const LAS bf16x8*)(lds + GL_QH + gl_swz(qtok, 2 * s + g)); acc = MFMA32(Af, Bf, acc); }
#pragma unroll
            for (int r = 0; r < 16; ++r) { const int kt = 32 * tj + 16 * (r >> 3) + 8 * g + (r & 7); const bool keep = DIR == 0 ? (kt <= qtok) : (kt >= qtok); acc[r] = keep ? acc[r] : 0.f; }
            asm volatile("s_waitcnt lgkmcnt(0)" ::: "memory");
#pragma unroll
            for (int s = 0; s < 2; ++s) { u32x4 w; w.x = pack2(acc[8 * s], acc[8 * s + 1]); w.y = pack2(acc[8 * s + 2], acc[8 * s + 3]); w.z = pack2(acc[8 * s + 4], acc[8 * s + 5]); w.w = pack2(acc[8 * s + 6], acc[8 * s + 7]);
                *(LAS u32x4*)(lds + GL_ATT + ((wid * 2 + s) * 64 + lane) * 16) = w; }
        }
    }
    asm volatile("s_waitcnt vmcnt(0)" ::: "memory");
    u32x2 S8[8];
    { const int r = 16 * ((j >> 2) & 1) + 4 * (j >> 3) + (j & 3);
#pragma unroll
        for (int s = 0; s < 8; ++s) S8[s] = *(const LAS u32x2*)(sb + r * 128 + ((s ^ (r & 7)) << 4) + 8 * g); }
    __syncthreads();
#pragma unroll
    for (int ti = 0; ti < 2; ++ti) {
#pragma unroll
        for (int tj = 0; tj < 2; ++tj) {
            const bool skip = DIR == 0 ? (tj > ti) : (tj < ti);
            if (!skip) {
#pragma unroll
                for (int s = 0; s < 2; ++s) { const bf16x8 Bf = *(const LAS bf16x8*)(lds + GL_ATT + (((tj * 2 + ti) * 2 + s) * 64 + lane) * 16); O[ti] = MFMA32(Vf[tj][s], Bf, O[ti]); }
            }
        }
#pragma unroll
        for (int s = 0; s < 8; ++s) { const bf16x8 Bf = *(const LAS bf16x8*)(lds + GL_QH + gl_swz(32 * ti + j, 2 * s + g));
            float e[8]; unpack4_fp8(S8[s].x, e[0], e[1], e[2], e[3]); unpack4_fp8(S8[s].y, e[4], e[5], e[6], e[7]);
            const u32x4 wb = (u32x4){pack2(e[0], e[1]), pack2(e[2], e[3]), pack2(e[4], e[5]), pack2(e[6], e[7])};
            O[ti] = MFMA32(__builtin_bit_cast(bf16x8, wb), Bf, O[ti]); }
    }
    __syncthreads();
}
DI void phase_gla3(const Params& p, int l, LAS unsigned char* lds) {
    unsigned char* const ws = ws_ptr();
    const int tid = otid(), lane = tid & 63, wid = tid >> 6, j = lane & 31, g = lane >> 5;
    bf16_t* proj = (bf16_t*)(ws + WS_PROJ);
    const bf16_t* vt = (const bf16_t*)(ws + WS_VT);
    const unsigned char* stt = ws + WS_ST;
    LAS float* ssq = (LAS float*)(lds + GL_SSQ);
    const bool last = (l == DEPTH - 1);
    int cur_h = -1, a_for = -1;
    u32x4 a_pre = (u32x4){0u, 0u, 0u, 0u};
    for (int un = blockIdx.x; un < NB * NCH * 4; un += gridDim.x) {
        const int h = un & 3, ci = (un >> 2) % NCH, b = (un >> 2) / NCH;
        if (last && ci >= 256) continue;
        int row0, tok0; gla_chunk_rows(b, ci, row0, tok0);
        const int prow = 16 * ((j >> 2) & 1) + 4 * (j >> 3) + (j & 3);
        if (a_for != un) a_pre = gla_load_a(proj, row0, tid);
        gla_stage_gate(p, l, a_pre, h, lds, cur_h);
        { const int un2 = un + gridDim.x; if (un2 < NB * NCH * 4) { int r0_, t0_; gla_chunk_rows((un2 >> 2) / NCH, (un2 >> 2) % NCH, r0_, t0_); a_pre = gla_load_a(proj, r0_, tid); a_for = un2; } }
        bf16x8 Vf[2][2];
        const int t2 = otid(), vrow = 32 * (t2 >> 6) + 16 * ((t2 >> 2) & 1) + 4 * ((t2 & 31) >> 3) + (t2 & 3), vg8 = 8 * ((t2 >> 5) & 1);
#pragma unroll
        for (int tj = 0; tj < 2; ++tj)
#pragma unroll
            for (int s = 0; s < 2; ++s) Vf[tj][s] = *(const bf16x8*)(vt + ((size_t)b * VTR + 640 + h * 256 + vrow) * TOKB + tok0 + 32 * tj + 16 * s + vg8);
        f32x16 O[2]; O[0] = zero16(); O[1] = zero16();
        u32x4 qk[4];
        { const int t3 = otid();
            const bf16_t* rp = proj + (size_t)(row0 + (t3 >> 3)) * PW + h * 128 + (t3 & 7) * 16;
            qk[0] = *(const u32x4*)(rp + C_QC); qk[1] = *(const u32x4*)(rp + C_QC + 8); qk[2] = *(const u32x4*)(rp + C_KC); qk[3] = *(const u32x4*)(rp + C_KC + 8); }
        __syncthreads();
        const size_t chain0 = (size_t)(b * 4 + h) * 2;
        gla3_dir<0>(p, lds, qk, stt + ((chain0 + 0) * NCH + ci) * 32768, Vf, O);
        gla3_dir<1>(p, lds, qk, stt + ((chain0 + 1) * NCH + ci) * 32768, Vf, O);
#pragma unroll
        for (int ti = 0; ti < 2; ++ti) { float s = 0.f;
#pragma unroll
            for (int r = 0; r < 16; ++r) s += O[ti][r] * O[ti][r];
            s += shx(s, 32);
            { const int t5 = otid(); if (((t5 >> 5) & 1) == 0) ssq[(32 * ti + (t5 & 31)) * 8 + (t5 >> 6)] = s; } }
        u32x4 rpre[2][2];
#pragma unroll
        for (int ti = 0; ti < 2; ++ti) { const int t4 = otid(); const bf16_t* rq = proj + (size_t)(row0 + 32 * ti + (t4 & 31)) * PW + C_RC + h * 256 + 32 * (t4 >> 6) + 16 * ((t4 >> 5) & 1); rpre[ti][0] = *(const u32x4*)rq; rpre[ti][1] = *(const u32x4*)(rq + 8); }
        __syncthreads();
        const float* gn = PIN(I_GNC) + l * 256;
#pragma unroll
        for (int ti = 0; ti < 2; ++ti) {
            float tot = 0.f;
            { const int j5 = otid() & 31;
#pragma unroll
                for (int w = 0; w < 8; ++w) tot += ssq[(32 * ti + j5) * 8 + w]; }
            const float rstd = rsqrtf(tot * (1.0f / 256.0f) + EPS);
            const int t6 = otid(), j6 = t6 & 31, cw6 = 32 * (t6 >> 6) + 16 * ((t6 >> 5) & 1);
            bf16_t* rp = proj + (size_t)(row0 + 32 * ti + j6) * PW + C_RC + h * 256 + cw6;
            const u32x4 ra = rpre[ti][0], rb = rpre[ti][1];
            const unsigned rw[8] = {ra.x, ra.y, ra.z, ra.w, rb.x, rb.y, rb.z, rb.w};
            float yv[16];
#pragma unroll
            for (int q = 0; q < 8; ++q) {
                const float r0 = bf_lo(rw[q]), r1 = bf_hi(rw[q]);
                const float g0 = gn[cw6 + 2 * q], g1 = gn[cw6 + 2 * q + 1];
                yv[2 * q] = O[ti][2 * q] * rstd * g0 * r0 * sigmoidf_(r0); yv[2 * q + 1] = O[ti][2 * q + 1] * rstd * g1 * r1 * sigmoidf_(r1);
            }
            if (ci < 256) {
                u32x4 w8;
#pragma unroll
                for (int q = 0; q < 4; ++q) w8[q] = pack4_fp8(yv[4 * q] * O8_SCALE, yv[4 * q + 1] * O8_SCALE, yv[4 * q + 2] * O8_SCALE, yv[4 * q + 3] * O8_SCALE);
                *(u32x4*)(ws + WS_O8 + (size_t)(row0 + 32 * ti + j6) * 2048 + 1024 + h * 256 + cw6) = w8;
            } else {
                unsigned ow[8];
#pragma unroll
                for (int q = 0; q < 8; ++q) ow[q] = pack2(yv[2 * q], yv[2 * q + 1]);
                *(u32x4*)rp = (u32x4){ow[0], ow[1], ow[2], ow[3]}; *(u32x4*)(rp + 8) = (u32x4){ow[4], ow[5], ow[6], ow[7]}; }
        }
        __syncthreads();
    }
}

#define CE_DESC(a, b) do { const float _hi = fmaxf(a, b), _lo = fminf(a, b); a = _hi; b = _lo; } while (0)
template <int N> DI void sort_desc(float (&v)[N]) {
#pragma unroll
    for (int k = 2; k <= N; k <<= 1)
#pragma unroll
        for (int jj = k >> 1; jj > 0; jj >>= 1)
#pragma unroll
            for (int i = 0; i < N; ++i) { const int x = i ^ jj; if (x > i) { if ((i & k) == 0) CE_DESC(v[i], v[x]); else CE_DESC(v[x], v[i]); } }
}
DI void merge_top16(float (&a)[16], const float (&b)[16]) {
#pragma unroll
    for (int i = 0; i < 16; ++i) a[i] = fmaxf(a[i], b[15 - i]);
#pragma unroll
    for (int jj = 8; jj > 0; jj >>= 1)
#pragma unroll
        for (int i = 0; i < 16; ++i) { const int x = i ^ jj; if (x > i) CE_DESC(a[i], a[x]); }
}
DI void merge_partner16(float (&a)[16]) {
    float b[16];
#pragma unroll
    for (int i = 0; i < 16; ++i) b[i] = shx(a[i], 32);
    merge_top16(a, b);
}
DI void top16_of_64(float (&v)[64], float (&o)[16]) {
    float a[16], b[16];
#pragma unroll
    for (int i = 0; i < 16; ++i) { a[i] = v[i]; b[i] = v[16 + i]; }
    sort_desc<16>(a); sort_desc<16>(b); merge_top16(a, b);
#pragma unroll
    for (int i = 0; i < 16; ++i) { o[i] = v[32 + i]; b[i] = v[48 + i]; }
    sort_desc<16>(o); sort_desc<16>(b); merge_top16(o, b);
    merge_top16(o, a);
}
DI float bsel(int c, float a, float b) { const unsigned m = (unsigned)-(c != 0); return __uint_as_float((__float_as_uint(a) & m) | (__float_as_uint(b) & ~m)); }
DI float msel(unsigned long long m, float a, float b) { float r; asm("v_cndmask_b32 %0, %1, %2, %3" : "=v"(r) : "v"(b), "v"(a), "s"(m)); return r; }
DI float set_low(float f, unsigned mask, unsigned val) { return __uint_as_float((__float_as_uint(f) & ~mask) | val); }

DI void phase_peer_select(const Params& p, int l, LAS unsigned char* lds) {
    unsigned char* const ws = ws_ptr();
    const int tid = otid(), lane = tid & 63, wid = tid >> 6, j = lane & 31, g = lane >> 5;
    const bf16_t* pq = (const bf16_t*)(ws + WS_PQ);
    const bf16_t* subk = (const bf16_t*)(ws + WS_SUBK);
    unsigned short* pidx = (unsigned short*)(ws + WS_PIDX); float* pgw = (float*)(ws + WS_PG);
    LAS unsigned* tab = (LAS unsigned*)lds + wid * 2048;
    LAS unsigned char* kimg = lds + 65536;
    const int ngroups = (l == DEPTH - 1 ? NLAT : NROW) / 32, noct = (ngroups + 7) / 8;
    int cur_ph = -1;
    u32x4 wq0[8], wq1[8]; int pre_w = -1;
    auto ld_half = [&](int w_, int half_, u32x4 (&dst)[8]) -> bool {
        const int ph_ = w_ & 7, grp_ = (w_ >> 3) * 8 + wid;
        if (w_ >= 8 * noct || grp_ >= ngroups) return false;
        const bf16_t* qp = pq + (size_t)(grp_ * 32 + j) * 2048 + ph_ * 256 + half_ * 128 + 8 * g;
#pragma unroll
        for (int s = 0; s < 8; ++s) dst[s] = *(const u32x4*)(qp + 16 * s);
        return true; };
    if (ld_half(blockIdx.x, 0, wq0)) pre_w = blockIdx.x;
    for (int w = blockIdx.x; w < 8 * noct; w += gridDim.x) {
        const int ph = w & 7, grp = (w >> 3) * 8 + wid;
        if (ph != cur_ph) {
            __syncthreads();
#pragma unroll
            for (int k = 0; k < 8; ++k) { const int pc = tid + 512 * k, row = pc >> 4, c = pc & 15;
                *(LAS u32x4*)(kimg + row * 256 + ((c ^ (row & 15)) << 4)) = *(const u32x4*)(subk + (size_t)(ph * 256 + row) * 128 + c * 8); }
            __syncthreads();
            cur_ph = ph;
        }
        if (grp >= ngroups) continue;
        const int r0 = grp * 32;
        if (pre_w != w) ld_half(w, 0, wq0);
        ld_half(w, 1, wq1);
        float top[2][16];
#pragma unroll
        for (int half = 0; half < 2; ++half) {
            bf16x8 Bq[8]; float ss = 0.f;
#pragma unroll
            for (int s = 0; s < 8; ++s) { const u32x4 w4 = half == 0 ? wq0[s] : wq1[s]; Bq[s] = __builtin_bit_cast(bf16x8, w4);
                const float e0 = bf_lo(w4.x), e1 = bf_hi(w4.x), e2 = bf_lo(w4.y), e3 = bf_hi(w4.y), e4 = bf_lo(w4.z), e5 = bf_hi(w4.z), e6 = bf_lo(w4.w), e7 = bf_hi(w4.w);
                ss += e0 * e0 + e1 * e1 + e2 * e2 + e3 * e3 + e4 * e4 + e5 * e5 + e6 * e6 + e7 * e7; }
            if (half == 1) { const int wn = w + (int)gridDim.x; if (ld_half(wn, 0, wq0)) pre_w = wn; }
            ss += shx(ss, 32);
            const float rstd = rsqrtf(ss * (1.0f / 128.0f) + EPS);
#pragma unroll
            for (int r = 0; r < 16; ++r) top[half][r] = -INFINITY;
#pragma unroll 1
            for (int kt = 0; kt < 4; ++kt) {
                f32x16 acc = zero16();
#pragma unroll
                for (int s = 0; s < 8; ++s) { const int row = half * 128 + kt * 32 + j; const bf16x8 Af = *(const LAS bf16x8*)(kimg + row * 256 + (((2 * s + g) ^ (row & 15)) << 4)); acc = MFMA32(Af, Bq[s], acc); }
                float sc[16];
#pragma unroll
                for (int r = 0; r < 16; ++r) sc[r] = set_low(acc[r] * rstd, 127u, (unsigned)(32 * kt + (r & 3) + 8 * (r >> 2) + 4 * g));
                sort_desc<16>(sc);
                merge_top16(top[half], sc);
            }
            __builtin_amdgcn_sched_barrier(0);
            merge_partner16(top[half]);
        }
        float va[16], vb[16];
#pragma unroll
        for (int i = 0; i < 16; ++i) { va[i] = set_low(top[0][i], 127u, 0u); vb[i] = set_low(top[1][i], 127u, 0u);
            tab[i * 64 + lane] = __float_as_uint(top[0][i]) & 127u; tab[(16 + i) * 64 + lane] = __float_as_uint(top[1][i]) & 127u; }
        float cand[32];
#pragma unroll
        for (int i = 0; i < 27; ++i) {
            const int a = i < 16 ? 0 : (i < 23 ? 1 : (i < 26 ? 2 : 3));
            const int bb = i < 16 ? i : (i < 23 ? i - 15 : (i < 26 ? i - 21 : 3));
            const float s0 = va[a] + vb[bb], s1 = va[bb] + vb[a];
            float c = g ? s1 : s0;
            c = set_low(c, 255u, g ? (unsigned)(bb * 16 + a) : (unsigned)(a * 16 + bb));
            if (a == bb) c = g ? -INFINITY : c;
            cand[i] = c;
        }
#pragma unroll
        for (int i = 27; i < 32; ++i) cand[i] = -INFINITY;
        float ca[16], cb[16];
#pragma unroll
        for (int i = 0; i < 16; ++i) { ca[i] = cand[i]; cb[i] = cand[16 + i]; }
        sort_desc<16>(ca); sort_desc<16>(cb); merge_top16(ca, cb);
        merge_partner16(ca);
        const float mx = set_low(ca[0], 255u, 0u);
        float ev[16], sum = 0.f;
#pragma unroll
        for (int i = 0; i < 16; ++i) { ev[i] = __expf(set_low(ca[i], 255u, 0u) - mx); sum += ev[i]; }
        const float inv = 1.0f / sum;
        const size_t ob = (size_t)(r0 + j) * 128 + ph * 16 + 8 * g;
#pragma unroll
        for (int k = 0; k < 8; ++k) {
            const float cv = bsel(g, ca[8 + k], ca[k]); const float e = bsel(g, ev[8 + k], ev[k]);
            const unsigned pos = __float_as_uint(cv) & 255u;
            const unsigned i1 = tab[(pos >> 4) * 64 + lane], i2 = tab[(16 + (pos & 15)) * 64 + lane];
            pidx[ob + k] = (unsigned short)(i1 * 128u + i2); pgw[ob + k] = e * inv;
        }
    }
}

DI void phase_peer_u(const Params& p, int l, LAS unsigned char* lds) {
    typedef int i32x8 __attribute__((ext_vector_type(8)));
    typedef int i32x4 __attribute__((ext_vector_type(4)));
    unsigned char* const ws = ws_ptr();
    const int tid = otid(), lane = tid & 63, wid = tid >> 6;
    const int pi = lane & 15, kg = lane >> 4, r8 = lane >> 3, sl = lane & 7;
    const unsigned char* h2f8 = ws + WS_H2F8; const unsigned char* tabl = ws + WS_TU;
    const unsigned short* pidx = (const unsigned short*)(ws + WS_PIDX);
    bf16_t* part = (bf16_t*)(ws + WS_PART);
    const bool last = (l == DEPTH - 1);
    const int nrows = last ? NLAT : NROW;
    const int wu = __builtin_amdgcn_readfirstlane(wid);
    const long long nw = (long long)gridDim.x * 8;
    const long long W = (gridDim.x & 3) == 0 ? (long long)(blockIdx.x & 3) * (nw >> 2) + (long long)(blockIdx.x >> 2) * 8 + wu : (long long)blockIdx.x * 8 + wu;
    const int i0 = (int)((W * (nrows * 4)) / nw), n = (int)(((W + 1) * (nrows * 4)) / nw) - i0;
    LAS unsigned char* wb = lds + 4096 + wu * 19456;
    const unsigned fsw = (unsigned)((r8 & 2) << 1);
    const unsigned a0 = (unsigned)((pi & 3) * 1024 + (pi >> 2) * 128), ax = (unsigned)((pi & 3) | (((pi >> 3) & 1) << 2));
    auto loc = [&](int T, int& sli, int& row) { const int idx = i0 + T; sli = last ? idx / NLAT : idx / NROW; row = idx - sli * nrows; };
    auto tokdma = [&](int T, int b3) { int sli, row; loc(T, sli, row);
        const unsigned char* src = lane < 32 ? h2f8 + (size_t)row * 2048 + 256 * sli + 16 * (lane & 15) : (const unsigned char*)(pidx + (size_t)row * 128) + 16 * (lane & 15);
        __builtin_amdgcn_global_load_lds((const unsigned*)src, (LAS unsigned*)(wb + 16384 + b3 * 1024), 16, 0, 0); };
    auto rdidx = [&](int b3, int q) -> u32x2 { return *(const LAS u32x2*)(wb + 16384 + b3 * 1024 + 512 + (32 * q + 4 * r8) * 2); };
    auto dma = [&](const u32x2& iw, int sli, int bq) {
        const unsigned char* tb = tabl + (size_t)sli * ((size_t)16384 * 128);
        LAS unsigned char* bb = wb + bq * 4096;
#pragma unroll
        for (int q = 0; q < 4; ++q) { const unsigned e = (q & 1) ? (iw[q >> 1] >> 16) : (iw[q >> 1] & 0xffffu); const unsigned c = (unsigned)sl ^ ((unsigned)q | fsw);
            __builtin_amdgcn_global_load_lds((const unsigned*)(tb + (size_t)((e << 7) | (c << 4))), (LAS unsigned*)(bb + q * 1024), 16, 0, 0); } };
    auto putout = [&](const f32x4 (&acc)[2], bf16_t* prow, int q) {
        bf16_t* pp = prow + 32 * q + 4 * kg;
#pragma unroll
        for (int m = 0; m < 2; ++m) { f32x4 o;
#pragma unroll
            for (int r = 0; r < 4; ++r) o[r] = acc[m][r] * (1.0f / H2F8_SCALE);
            asm volatile("" : "+v"(o));
            if (pi == 0) *(u32x2*)(pp + 16 * m) = (u32x2){pack2(o[0], o[1]), pack2(o[2], o[3])}; } };
    if (n <= 0) return;
    const bool tiny = n < 3;
    tokdma(0, 0); if (n > 1) tokdma(1, 1);
    asm volatile("s_waitcnt vmcnt(0)" ::: "memory");
    int sc, rc; loc(0, sc, rc);
    dma(rdidx(0, 0), sc, 0); dma(rdidx(0, 1), sc, 1); dma(rdidx(0, 2), sc, 2);
    u32x2 iwn = rdidx(0, 3);
    int b3 = 0;
    bf16_t* ppc = part + ((size_t)sc * NROW + rc) * 128; bf16_t* ppp = ppc;
    i32x8 B0, B1;
    f32x4 accp[2];
    for (int T = 0; T < n; ++T) {
        const bool more = T + 1 < n;
        int sn = sc, rn = rc; if (more) loc(T + 1, sn, rn);
        const int b3n = b3 == 2 ? 0 : b3 + 1, b3nn = b3n == 2 ? 0 : b3n + 1;
#pragma unroll
        for (int qt = 0; qt < 4; ++qt) {
            if (tiny) asm volatile("s_waitcnt vmcnt(0) lgkmcnt(0)" ::: "memory");
            else if (T == 0) asm volatile("s_waitcnt vmcnt(8) lgkmcnt(0)" ::: "memory");
            else if (!more && qt >= 2) asm volatile("s_waitcnt vmcnt(6) lgkmcnt(0)" ::: "memory");
            else asm volatile("s_waitcnt vmcnt(14) lgkmcnt(0)" ::: "memory");
            if (qt == 1 && T + 2 < n) tokdma(T + 2, b3nn);
            if (qt == 0) dma(iwn, sc, 3); else if (more) dma(iwn, sn, qt - 1);
            if (more) iwn = rdidx(b3n, qt);
            if (qt == 0) { const LAS unsigned char* tk = wb + 16384 + b3 * 1024 + (pi & 1) * 256 + 16 * kg;
                const u32x4 b0 = *(const LAS u32x4*)tk, b1 = *(const LAS u32x4*)(tk + 64), b2 = *(const LAS u32x4*)(tk + 128), b3v = *(const LAS u32x4*)(tk + 192);
                B0 = (i32x8){(int)b0.x, (int)b0.y, (int)b0.z, (int)b0.w, (int)b1.x, (int)b1.y, (int)b1.z, (int)b1.w};
                B1 = (i32x8){(int)b2.x, (int)b2.y, (int)b2.z, (int)b2.w, (int)b3v.x, (int)b3v.y, (int)b3v.z, (int)b3v.w}; }
            const LAS unsigned char* bb = wb + qt * 4096;
            i32x4 av[2][2];
#pragma unroll
            for (int m = 0; m < 2; ++m) {
                av[m][0] = __builtin_bit_cast(i32x4, *(const LAS u32x4*)(bb + a0 + m * 512 + ((((unsigned)kg) ^ ax) << 4)));
                av[m][1] = __builtin_bit_cast(i32x4, *(const LAS u32x4*)(bb + a0 + m * 512 + ((((unsigned)(4 + kg)) ^ ax) << 4))); }
            if (T > 0 || qt > 0) putout(accp, qt == 0 ? ppp : ppc, (qt + 3) & 3);
            f32x4 acc[2];
#pragma unroll
            for (int m = 0; m < 2; ++m) { const i32x8 A0 = __builtin_shufflevector(av[m][0], av[m][0], 0, 1, 2, 3, -1, -1, -1, -1);
                acc[m] = __builtin_amdgcn_mfma_scale_f32_16x16x128_f8f6f4(A0, B0, (f32x4){0.f, 0.f, 0.f, 0.f}, 4, 0, 0, 127, 0, 127); }
#pragma unroll
            for (int m = 0; m < 2; ++m) { const i32x8 A1 = __builtin_shufflevector(av[m][1], av[m][1], 0, 1, 2, 3, -1, -1, -1, -1);
                acc[m] = __builtin_amdgcn_mfma_scale_f32_16x16x128_f8f6f4(A1, B1, acc[m], 4, 0, 0, 127, 0, 127); }
            accp[0] = acc[0]; accp[1] = acc[1];
        }
        ppp = ppc; ppc = part + ((size_t)sn * NROW + rn) * 128; sc = sn; rc = rn; b3 = b3n;
    }
    putout(accp, ppp, 3);
    asm volatile("s_waitcnt vmcnt(0) lgkmcnt(0)" ::: "memory");
}
DI void phase_peer_v(const Params& p, int l, LAS unsigned char* lds, float* xo_lat, float* xo_ctx, bf16_t* xo_b) {
    typedef int i32x8 __attribute__((ext_vector_type(8)));
    typedef int i32x4 __attribute__((ext_vector_type(4)));
    typedef int i32x2 __attribute__((ext_vector_type(2)));
    unsigned char* const ws = ws_ptr();
    const int tid = otid(), lane = tid & 63, wid = tid >> 6;
    const int q16 = lane & 15, kg = lane >> 4, r8 = lane >> 3, sl = lane & 7;
    const unsigned char* w8 = ws + WS_W8; const unsigned char* tabl = ws + WS_TV;
    const unsigned short* pidx = (const unsigned short*)(ws + WS_PIDX);
    const float* mod = (const float*)(ws + WS_MOD) + (size_t)l * 3 * 6144;
    const bool last = (l == DEPTH - 1);
    const int nrows = last ? NLAT : NROW;
    const int wu = __builtin_amdgcn_readfirstlane(wid);
    const long long nw = (long long)gridDim.x * 8;
    const long long W = (gridDim.x & 3) == 0 ? (long long)(blockIdx.x & 3) * (nw >> 2) + (long long)(blockIdx.x >> 2) * 8 + wu : (long long)blockIdx.x * 8 + wu;
    const int i0 = (int)((W * (nrows * 4)) / nw), n = (int)(((W + 1) * (nrows * 4)) / nw) - i0;
    LAS unsigned char* wb = lds + 4096 + wu * 19456;
    const unsigned fsw = (unsigned)((r8 & 2) << 1);
    const unsigned trb = (unsigned)((q16 & 3) * 1024 + (q16 >> 2) * 128 + 8 * (kg & 1)), trx = (unsigned)(((q16 & 3) | (((q16 >> 3) & 1) << 2)) ^ (kg >> 1));
    const int ap = (q16 >> 1) & 3;
    const bool a_on = (kg >> 1) == (ap & 1), a_hi = ap >= 2;
    const unsigned aoff = (unsigned)(16 * (kg & 1));
    auto loc = [&](int T, int& sli, int& row) { const int idx = i0 + T; sli = last ? idx / NLAT : idx / NROW; row = idx - sli * nrows; };
    auto tokdma = [&](int T, int b3) { int sli, row; loc(T, sli, row);
        const unsigned char* src = lane < 16 ? w8 + (size_t)row * 256 + 16 * (lane & 7) : (const unsigned char*)(pidx + (size_t)row * 128) + 16 * (lane & 15);
        __builtin_amdgcn_global_load_lds((const unsigned*)src, (LAS unsigned*)(wb + 16384 + b3 * 1024), 16, 0, 0); };
    auto rdidx = [&](int b3, int q) -> u32x2 { return *(const LAS u32x2*)(wb + 16384 + b3 * 1024 + 256 + (32 * q + 4 * r8) * 2); };
    auto dma = [&](const u32x2& iw, int sli, int bq) {
        const unsigned char* tb = tabl + (size_t)sli * ((size_t)16384 * 128);
        LAS unsigned char* bb = wb + bq * 4096;
#pragma unroll
        for (int q = 0; q < 4; ++q) { const unsigned e = (q & 1) ? (iw[q >> 1] >> 16) : (iw[q >> 1] & 0xffffu); const unsigned c = (unsigned)sl ^ ((unsigned)q | fsw);
            __builtin_amdgcn_global_load_lds((const unsigned*)(tb + (size_t)((e << 7) | (c << 4))), (LAS unsigned*)(bb + q * 1024), 16, 0, 0); } };
    if (n <= 0) return;
    const bool tiny = n < 3;
    tokdma(0, 0); if (n > 1) tokdma(1, 1);
    asm volatile("s_waitcnt vmcnt(0)" ::: "memory");
    int sc, rc; loc(0, sc, rc);
    dma(rdidx(0, 0), sc, 0); dma(rdidx(0, 1), sc, 1); dma(rdidx(0, 2), sc, 2);
    u32x2 iwn = rdidx(0, 3);
    int b3 = 0, g2for = -1;
    float g2[8];
#pragma unroll
    for (int i = 0; i < 8; ++i) g2[i] = 0.f;
    f32x4 acc[4];
    for (int T = 0; T < n; ++T) {
        const bool more = T + 1 < n;
        int sn = sc, rn = rc; if (more) loc(T + 1, sn, rn);
        const int b3n = b3 == 2 ? 0 : b3 + 1, b3nn = b3n == 2 ? 0 : b3n + 1;
        const bool lat = rc < NLAT;
        const int mv = lat ? (rc >> 14) : 2;
        if (g2for != mv * 4 + sc) { g2for = mv * 4 + sc;
            const float* gp = mod + mv * 6144 + 5 * 1024 + 256 * sc + 16 * (2 * (kg & 1)) + q16;
#pragma unroll
            for (int m = 0; m < 4; ++m) { g2[2 * m] = gp[64 * m] * (1.0f / (W8_SCALE * PV_SCALE)); g2[2 * m + 1] = gp[64 * m + 16] * (1.0f / (W8_SCALE * PV_SCALE)); } }
        const bool b16 = lat && xo_b != nullptr;
        float* xrow = (lat ? xo_lat + (size_t)rc * 1024 : xo_ctx + (size_t)(rc - NLAT) * 1024) + 256 * sc + 16 * (2 * (kg & 1)) + q16;
        bf16_t* xrb = xo_b + (size_t)rc * 1024 + 256 * sc + 16 * (2 * (kg & 1)) + q16;
#pragma unroll
        for (int qt = 0; qt < 4; ++qt) {
            if (tiny || (!more && qt >= 2)) asm volatile("s_waitcnt vmcnt(0) lgkmcnt(0)" ::: "memory");
            else if (T == 0 || qt == 3) asm volatile("s_waitcnt vmcnt(8) lgkmcnt(0)" ::: "memory");
            else asm volatile("s_waitcnt vmcnt(16) lgkmcnt(0)" ::: "memory");
            const i32x4 Wq = __builtin_bit_cast(i32x4, *(const LAS u32x4*)(wb + 16384 + b3 * 1024 + aoff + 32 * qt));
            i32x2 Bl[4], Bh[4];
            const unsigned bba = (unsigned)(size_t)(wb + qt * 4096) + trb;
#pragma unroll
            for (int m = 0; m < 4; ++m) { const unsigned o = bba + ((((unsigned)(2 * m)) ^ trx) << 4);
                asm volatile("ds_read_b64_tr_b4 %0, %2\n\tds_read_b64_tr_b4 %1, %2 offset:512" : "=&v"(Bl[m]), "=&v"(Bh[m]) : "v"(o) : "memory"); }
            if (qt == 1 && T + 2 < n) tokdma(T + 2, b3nn);
            if (qt == 0) dma(iwn, sc, 3); else if (more) dma(iwn, sn, qt - 1);
            if (more) iwn = rdidx(b3n, qt);
            asm volatile("s_waitcnt lgkmcnt(0)" : "+v"(Bl[0]), "+v"(Bl[1]), "+v"(Bl[2]), "+v"(Bl[3]), "+v"(Bh[0]), "+v"(Bh[1]), "+v"(Bh[2]), "+v"(Bh[3]) :: "memory");
            const int z = 0;
            const i32x8 A = (i32x8){(a_on && !a_hi) ? Wq.x : z, (a_on && !a_hi) ? Wq.y : z, (a_on && !a_hi) ? Wq.z : z, (a_on && !a_hi) ? Wq.w : z,
                                    (a_on && a_hi) ? Wq.x : z, (a_on && a_hi) ? Wq.y : z, (a_on && a_hi) ? Wq.z : z, (a_on && a_hi) ? Wq.w : z};
#pragma unroll
            for (int m = 0; m < 4; ++m) { const i32x8 B = __builtin_shufflevector(Bl[m], Bh[m], 0, 1, 2, 3, -1, -1, -1, -1);
                acc[m] = __builtin_amdgcn_mfma_scale_f32_16x16x128_f8f6f4(A, B, qt == 0 ? (f32x4){0.f, 0.f, 0.f, 0.f} : acc[m], 0, 4, 0, 127, 0, 127); }
            if (qt == 3) {
                float o[8];
#pragma unroll
                for (int m = 0; m < 4; ++m) { o[2 * m] = acc[m][0] * g2[2 * m]; o[2 * m + 1] = acc[m][2] * g2[2 * m + 1]; }
                asm volatile("" : "+v"(o[0]), "+v"(o[1]), "+v"(o[2]), "+v"(o[3]), "+v"(o[4]), "+v"(o[5]), "+v"(o[6]), "+v"(o[7]));
                if (b16) {
                    typedef short s16x2 __attribute__((ext_vector_type(2)));
                    unsigned pk[8];
#pragma unroll
                    for (int i = 0; i < 8; ++i) { const float x = o[i]; const float nb = __int_as_float(__builtin_amdgcn_update_dpp(0, __float_as_int(x), 0xB1, 0xf, 0xf, true)); pk[i] = pack2(x, nb); }
                    if (kg < 2 && (q16 & 1) == 0) {
#pragma unroll
                        for (int m = 0; m < 4; ++m) {
                            __builtin_amdgcn_global_atomic_fadd_v2bf16((GAS s16x2*)(xrb + 64 * m), __builtin_bit_cast(s16x2, pk[2 * m]));
                            __builtin_amdgcn_global_atomic_fadd_v2bf16((GAS s16x2*)(xrb + 64 * m + 16), __builtin_bit_cast(s16x2, pk[2 * m + 1])); } }
                } else if (kg < 2) {
#pragma unroll
                    for (int m = 0; m < 4; ++m) { unsafeAtomicAdd(xrow + 64 * m, o[2 * m]); unsafeAtomicAdd(xrow + 64 * m + 16, o[2 * m + 1]); } }
            }
        }
        sc = sn; rc = rn; b3 = b3n;
    }
    asm volatile("s_waitcnt vmcnt(0) lgkmcnt(0)" ::: "memory");
}
DI float erf_as(float x) { const float a = fabsf(x), t = __builtin_amdgcn_rcpf(1.0f + 0.3275911f * a);
    const float pl = t * (0.254829592f + t * (-0.284496736f + t * (1.421413741f + t * (-1.453152027f + t * 1.061405429f))));
    const float r = 1.0f - pl * __builtin_amdgcn_exp2f(-a * a * LOG2E); return x < 0.f ? -r : r; }
DI void phase_peer_w(const Params& p, int l) {
    unsigned char* const ws = ws_ptr();
    const bf16_t* part = (const bf16_t*)(ws + WS_PART);
    float* pgw = (float*)(ws + WS_PG);
    const int n = (l == DEPTH - 1 ? NLAT : NROW) * 128, step = gridDim.x * 2048;
    auto ld = [&](int i, u32x2 (&pw)[PSL], f32x4& g) {
#pragma unroll
        for (int x = 0; x < PSL; ++x) pw[x] = *(const u32x2*)(part + (size_t)x * NROW * 128 + i);
        g = *(const f32x4*)(pgw + i); };
    u32x2 pw[PSL], pn[PSL]; f32x4 g, gnx;
    int i = (blockIdx.x * 512 + otid()) * 4;
    if (i < n) ld(i, pw, g);
    for (; i < n; i += step) {
        if (i + step < n) ld(i + step, pn, gnx);
        f32x4 sm = (f32x4){0.f, 0.f, 0.f, 0.f};
#pragma unroll
        for (int x = 0; x < PSL; ++x) { sm[0] += bf_lo(pw[x].x); sm[1] += bf_hi(pw[x].x); sm[2] += bf_lo(pw[x].y); sm[3] += bf_hi(pw[x].y); }
        f32x4 o;
#pragma unroll
        for (int q = 0; q < 4; ++q) { const float t = sm[q] * (1.0f / PU_SCALE); o[q] = g[q] * 0.5f * t * (1.0f + erf_as(t * 0.70710678118654752f)) * W8_SCALE; }
        *(unsigned*)(ws + WS_W8 + (size_t)(i >> 7) * 256 + (i & 127)) = pack4_fp8(o[0], o[1], o[2], o[3]);
#pragma unroll
        for (int x = 0; x < PSL; ++x) pw[x] = pn[x];
        g = gnx;
    }
}

__global__ void __launch_bounds__(512, 2) hybrid_fwd(Params p) {
    LAS unsigned char* const ldsc = (LAS unsigned char*)lds_raw;
    LAS unsigned char* lds = ldsc + LDS_CTRL;
    if (threadIdx.x == 0) { *(LAS u32x4*)(ldsc + LDS_BARW) = (u32x4){0u, 0u, 0u, 0u}; *(LAS unsigned long long*)(ldsc + 512) = 0ull;
        LAS unsigned long long* pt = (LAS unsigned long long*)(ldsc + LDS_PTRS);
#pragma unroll
        for (int i = 0; i < 29; ++i) pt[i] = (unsigned long long)(uintptr_t)p.in[i]; }
    __syncthreads();
    XcdBarrier bar; bar.bar = (unsigned*)(p.ws + WS_CTL); bar.x = 0; bar.st = (volatile LAS unsigned*)(ldsc + LDS_BARW);
    if (p.use_bar) bar = xcd_barrier_post((unsigned*)(p.ws + WS_CTL), (volatile LAS unsigned*)(ldsc + LDS_BARW));
#define IN(ph) ((ph) >= p.gp_lo && (ph) < p.gp_hi)
#define SEAM() do { if (p.use_bar) { XcdBarrier b2; b2.bar = (unsigned*)(ws_ptr() + WS_CTL); b2.x = bar.x; b2.st = (volatile LAS unsigned*)(ldsc + LDS_BARW); xcd_barrier(b2); } else __syncthreads(); } while (0)
    unsigned long long pr_acc = 0, pr_t0 = 0;
#define PT0() do { if (PROBE_MASK) pr_t0 = __builtin_amdgcn_s_memrealtime(); } while (0)
#define PT1(k) do { if (PROBE_MASK & (1 << (k))) pr_acc += __builtin_amdgcn_s_memrealtime() - pr_t0; } while (0)
    if (IN(0)) { PT0(); phase_mod(p, (LAS float*)lds); SEAM(); PT1(15); }
    for (int l = 0; l < DEPTH; ++l) {
        const int gb = 1 + l * NPH;
        unsigned char* const ws = ws_ptr();
        float* const outp = (float*)(GAS float*)p.out;
        bf16_t* const proj = (bf16_t*)(ws + WS_PROJ);
        float* const ctxr = (float*)(ws + WS_CTX);
        const float* xin_lat = l == 0 ? PIN(I_X) : outp;
        bf16_t* const xb = (bf16_t*)(ws + WS_XB);
        const bool lastl = (l == DEPTH - 1);
        const float* xin_ctx = l == 0 ? PIN(I_CTX) : ctxr;
        if (IN(gb + 0)) { PT0(); phase_convert(p, l, (LAS float*)lds); phase_norm(p, l, 0, xin_lat, xin_ctx, l == 0 ? (const bf16_t*)nullptr : xb, (bf16_t*)(ws + WS_H), NROW); SEAM(); PT1(0); }
        if (IN(gb + 1)) { PT0();
            pg8::Gemm g{}; g.A = (const bf16_t*)(ws + WS_H); g.Bt = (const bf16_t*)(ws + WS_WIN); g.lda = 512; g.ldb = 512; g.K = 512; g.bseg = 0;
            pg8::Order<1> so; so.init(NROW, 8704, gridDim.x, blockIdx.x);
            pg8::EpiBf16 e; e.O = proj; e.ldc = PW; e.ncols = PW; e.gt0 = C_GT; e.oscale = 1.0f / (H8_SCALE * WIN8_SCALE);
            pg8::gemm_phase<1>(lds, g, so, e, 1); SEAM(); PT1(1);
        }
        if (IN(gb + 2)) { PT0(); phase_post(p, l, lds); SEAM(); PT1(2); }
        if (IN(gb + 3)) { PT0(); phase_gla1(p, l, lds); __syncthreads(); phase_attn(p, l, lds, 0); SEAM(); PT1(3); }
        if (IN(gb + 5)) { PT0(); phase_gla2(p); SEAM(); PT1(5); }
        if (IN(gb + 6)) { PT0(); phase_gla3(p, l, lds); __syncthreads(); phase_attn(p, l, lds, 1); SEAM(); PT1(6); }
        if (IN(gb + 7)) { PT0();
            pg8::Gemm g{}; g.A = (const bf16_t*)(ws + WS_O8); g.Bt = (const bf16_t*)(ws + WS_WO8); g.lda = 1024; g.ldb = 512; g.K = 256; g.bseg = (size_t)1024 * 512;
            g.ac0 = 0; g.ac1 = 256; g.ac2 = 512; g.ac3 = 0; g.k0 = 256; g.k1 = 256; g.k2 = 512; g.k3 = 0;
            if (l != DEPTH - 1) phase_ctx_gemm(p, l, 0, xin_ctx);
            pg8::Order<3> so; so.init(NLAT, 1024, gridDim.x, blockIdx.x);
            pg8::EpiMerge e; e.proj = proj; e.Mo = (bf16_t*)(ws + WS_M); e.oscale = 1.0f / (O8_SCALE * WO8_SCALE);
            pg8::gemm_phase<1>(lds, g, so, e, 2); SEAM(); PT1(7);
        }
        if (IN(gb + 8)) { PT0();
            pg8::Gemm g{}; g.A = (const bf16_t*)(ws + WS_M); g.Bt = (const bf16_t*)(ws + WS_WOUT); g.lda = 1024; g.ldb = 1024; g.K = 1024; g.bseg = 0;
            if (l != DEPTH - 1) phase_ctx_gemm(p, l, 1, xin_ctx);
            pg8::Order<1> so; so.init(NLAT, 1024, gridDim.x, blockIdx.x);
            pg8::EpiResid e; e.xin_f = l == 0 ? xin_lat : (const float*)nullptr; e.xin_b = l == 0 ? (const bf16_t*)nullptr : xb; e.xout_f = lastl ? outp : (float*)nullptr; e.xout_b = lastl ? (bf16_t*)nullptr : xb; e.gate = (const float*)(ws + WS_MOD) + (size_t)l * 3 * 6144 + 2 * 1024;
            pg8::gemm_phase<0>(lds, g, so, e, 3); SEAM(); PT1(8);
        }
        if (IN(gb + 9)) { PT0(); phase_norm(p, l, 1, outp, ctxr, lastl ? (const bf16_t*)nullptr : xb, (bf16_t*)(ws + WS_H2), l == DEPTH - 1 ? NLAT : NROW); SEAM(); PT1(9); }
        if (IN(gb + 10)) { PT0();
            pg8::Gemm g{}; g.A = (const bf16_t*)(ws + WS_H2); g.Bt = (const bf16_t*)(ws + WS_WPQ); g.lda = 1024; g.ldb = 1024; g.K = 1024; g.bseg = 0;
            pg8::Order<1> so; so.init(l == DEPTH - 1 ? NLAT : NROW, 2048, gridDim.x, blockIdx.x);
            pg8::EpiBf16 e; e.O = (bf16_t*)(ws + WS_PQ); e.ldc = 2048; e.ncols = 2048; e.gt0 = 1 << 30; e.oscale = 1.0f;
            pg8::gemm_phase<0>(lds, g, so, e, 4); SEAM(); PT1(10);
        }
        if (IN(gb + 11)) { PT0(); phase_peer_select(p, l, lds); SEAM(); PT1(11); }
        if (IN(gb + 12)) { PT0(); phase_peer_u(p, l, lds); SEAM(); PT1(12); }
        if (IN(gb + 13)) { PT0(); phase_peer_w(p, l); SEAM(); PT1(13); }
        if (IN(gb + 14)) { PT0(); phase_peer_v(p, l, lds, outp, ctxr, lastl ? (bf16_t*)nullptr : xb); SEAM(); PT1(14); }
    }
    if (RPROBE && blockIdx.x == 0) { __syncthreads(); const unsigned long long acc_t = *(LAS unsigned long long*)(ldsc + 512); const unsigned long long t0 = __builtin_amdgcn_s_memrealtime(); while (__builtin_amdgcn_s_memrealtime() - t0 < acc_t) __builtin_amdgcn_s_sleep(16); }
    if (PROBE_MASK && blockIdx.x == 0) { const unsigned long long t0 = __builtin_amdgcn_s_memrealtime(); while (__builtin_amdgcn_s_memrealtime() - t0 < pr_acc * PROBE_MULT) __builtin_amdgcn_s_sleep(16); }
#undef IN
#undef SEAM
}

#ifndef MK_LAUNCHES
#define MK_LAUNCHES 0
#endif
extern "C" void kernel_launch(void* const* d_in, const int* in_sizes, int n_in, void* d_out, int out_size, void* d_ws, size_t ws_size, hipStream_t stream) {
    static int grid = 0;
    if (grid == 0) {
        if (n_in != 29 || in_sizes[0] != NLAT * D || out_size != NLAT * D || ws_size < WS_END) {
            fprintf(stderr, "kernel_launch: unexpected problem (n_in %d, in0 %d, out %d, ws %zu, need %zu); nothing launched\n", n_in, n_in > 0 ? in_sizes[0] : -1, out_size, ws_size, (size_t)WS_END); grid = -1; return; }
        int dev = 0, cus = 0, per_cu = 0;
        if (hipGetDevice(&dev) != hipSuccess || hipDeviceGetAttribute(&cus, hipDeviceAttributeMultiprocessorCount, dev) != hipSuccess) { grid = -1; return; }
        if (hipFuncSetAttribute((const void*)hybrid_fwd, hipFuncAttributeMaxDynamicSharedMemorySize, LDS_BYTES) != hipSuccess) { fprintf(stderr, "kernel_launch: hipFuncSetAttribute failed\n"); grid = -1; return; }
        if (hipOccupancyMaxActiveBlocksPerMultiprocessor(&per_cu, (const void*)hybrid_fwd, 512, LDS_BYTES) != hipSuccess || per_cu < 1) { fprintf(stderr, "kernel_launch: occupancy query says %d\n", per_cu); grid = -1; return; }
        (void)hipGetLastError();
        grid = cus;
    }
    if (grid < 0) return;
    (void)hipMemsetAsync((char*)d_ws + WS_CTL, 0, 65536, stream);
    Params p{};
    for (int i = 0; i < 29; ++i) p.in[i] = (const float*)d_in[i];
    p.out = (float*)d_out; p.ws = (unsigned char*)d_ws; p.pad0 = 0;
#if MK_LAUNCHES == 0
    p.gp_lo = 0; p.gp_hi = NGPH; p.use_bar = 1;
    hipLaunchKernelGGL(hybrid_fwd, dim3(grid), dim3(512), LDS_BYTES, stream, p);
#else
    p.use_bar = 0;
    for (int gp = 0; gp < NGPH; ++gp) { p.gp_lo = gp; p.gp_hi = gp + 1; hipLaunchKernelGGL(hybrid_fwd, dim3(grid), dim3(512), LDS_BYTES, stream, p); }
#endif
}
```
